# Optimizing an MI355X kernel written in HIP

```python
import math
import jax, jax.numpy as jnp
from jax import lax
import numpy as np

D_MODEL = 1024
BATCH = 2
SEQ = 8192
DEPTH = 2

GRID_W = 64
CTX_LEN = 256
HEAD_DIM = 64
H_A = D_MODEL // (4 * HEAD_DIM)
H_B = D_MODEL // (4 * HEAD_DIM)
H_C = D_MODEL // (2 * HEAD_DIM)
D_A = H_A * HEAD_DIM
D_B = H_B * HEAD_DIM
D_C = H_C * HEAD_DIM
D_MIX = D_A + D_B + D_C
PROJ_SIZES = (D_A, D_A, D_A, D_A, D_A,
              D_B, D_B, D_B, D_B,
              H_B, H_B, H_B, H_B,
              D_C, D_C, D_C)
D_PROJ = sum(PROJ_SIZES)
CHUNK = 64
CONV_K = 5
WIN_R = 8
WIN_C = 16
ROPE_BASE = 10000.0
D_FF = 3584
N_EXPERTS = 8
TOP_K = 2
MOE_BLOCK = 256
N_DENSE = (DEPTH + 1) // 2
N_MOE = DEPTH // 2
EPS = 1e-6

kernel_name = 'hybrid_hgrn2_gdn_natten_moe_dit_block'


def rms_norm(x, g):
    xf = x.astype(jnp.float32)
    y = xf * lax.rsqrt(jnp.mean(xf * xf, axis=-1, keepdims=True) + EPS)
    return (y * g.astype(jnp.float32)).astype(x.dtype)


def modulate(x, g, shift, scale):
    return rms_norm(x, g) * (1.0 + scale) + shift


def l2_normalize(x):
    return x * lax.rsqrt(jnp.sum(x * x, axis=-1, keepdims=True) + EPS)


def split_cols(a, sizes):
    return jnp.split(a, np.cumsum(sizes)[:-1].tolist(), axis=-1)


def to_heads(a, n_heads):
    b, t, _ = a.shape
    return a.reshape(b, t, n_heads, -1).transpose(0, 2, 1, 3)


def merge_heads(a):
    b, h, t, d = a.shape
    return a.transpose(0, 2, 1, 3).reshape(b, t, h * d)


def depthwise_conv(x, w):
    return lax.conv_general_dilated(
        x, w.astype(x.dtype)[:, None, :], window_strides=(1,),
        padding=[(CONV_K // 2, CONV_K // 2)],
        dimension_numbers=('NWC', 'WIO', 'NWC'), feature_group_count=x.shape[-1])


def axial_rope(n_tok):
    t = jnp.arange(n_tok)
    row = (t // GRID_W).astype(jnp.float32)
    col = (t % GRID_W).astype(jnp.float32)
    n_freq = HEAD_DIM // 4
    inv = ROPE_BASE ** (-jnp.arange(n_freq, dtype=jnp.float32) / n_freq)
    ang = jnp.concatenate([row[:, None] * inv, col[:, None] * inv], axis=-1)
    return jnp.cos(ang), jnp.sin(ang)


def apply_rope(x, cos, sin):
    x1, x2 = jnp.split(x, 2, axis=-1)
    return jnp.concatenate([x1 * cos - x2 * sin, x1 * sin + x2 * cos], axis=-1)


def masked_exp(d, mask):
    return jnp.where(mask, jnp.exp(jnp.where(mask, d, 0.0)), 0.0)


def to_chunks(a):
    b, h, t = a.shape[:3]
    return jnp.moveaxis(a.reshape(b, h, t // CHUNK, CHUNK, *a.shape[3:]), 2, 0)


def from_chunks(a):
    n, b, h, c, d = a.shape
    return jnp.moveaxis(a, 0, 2).reshape(b, h, n * c, d)


def hgrn2_chunk_scan(q, k, v, log_f, state):
    tril = jnp.tril(jnp.ones((CHUNK, CHUNK), bool))

    def step(s, inp):
        qc, kc, vc, lfc = inp
        b = jnp.cumsum(lfc, axis=2)
        diff = b[:, :, :, None, :] - b[:, :, None, :, :]
        dec = masked_exp(diff, tril[:, :, None])
        att = jnp.einsum('bhtd,bhsd,bhtsd->bhts', qc, kc, dec)
        o = jnp.einsum('bhts,bhsv->bhtv', att, vc) + jnp.einsum('bhtd,bhdv->bhtv', qc * jnp.exp(b), s)
        b_end = b[:, :, -1:, :]
        s = s * jnp.exp(b_end[:, :, 0, :, None]) + jnp.einsum('bhsd,bhsv->bhdv', kc * jnp.exp(b_end - b), vc)
        return s, o

    s, o = lax.scan(step, state, (to_chunks(q), to_chunks(k), to_chunks(v), to_chunks(log_f)))
    return from_chunks(o), s


def gdn_chunk_scan(q, k, v, log_alpha, beta, state):
    tril = jnp.tril(jnp.ones((CHUNK, CHUNK), bool))
    strict = jnp.tril(jnp.ones((CHUNK, CHUNK), bool), -1)
    eye = jnp.eye(CHUNK, dtype=jnp.float32)

    def step(s, inp):
        qc, kc, vc, lac, bc = inp
        g = jnp.cumsum(lac, axis=-1)
        gam = masked_exp(g[..., :, None] - g[..., None, :], tril)
        kk = jnp.einsum('bhtd,bhsd->bhts', kc, kc)
        m = eye + jnp.where(strict, bc[..., :, None] * kk * gam, 0.0)
        rhs = bc[..., None] * (vc - jnp.exp(g)[..., None] * jnp.einsum('bhtd,bhdv->bhtv', kc, s))
        u = lax.linalg.triangular_solve(m, rhs, left_side=True, lower=True, unit_diagonal=True)
        qk = jnp.einsum('bhtd,bhsd->bhts', qc, kc) * gam
        o = jnp.einsum('bhtd,bhdv->bhtv', qc * jnp.exp(g)[..., None], s) + jnp.einsum('bhts,bhsv->bhtv', qk, u)
        g_end = g[..., -1:]
        s = s * jnp.exp(g_end)[..., None] + jnp.einsum('bhsd,bhsv->bhdv', kc * jnp.exp(g_end - g)[..., None], u)
        return s, o

    s, o = lax.scan(step, state, (to_chunks(q), to_chunks(k), to_chunks(v),
                                  to_chunks(log_alpha), to_chunks(beta)))
    return from_chunks(o), s


def bidirectional_scan(scan_fn, lat_fwd, ctx_fwd, lat_bwd, ctx_bwd, state_shape):
    flip = lambda seqs: tuple(jnp.flip(a, axis=2) for a in seqs)
    s0 = jnp.zeros(state_shape, jnp.float32)
    o_ctx_f, s_ctx_f = scan_fn(*ctx_fwd, s0)
    o_lat_f, _ = scan_fn(*lat_fwd, s_ctx_f)
    o_ctx_b, s_ctx_b = scan_fn(*flip(ctx_bwd), s0)
    o_lat_b, _ = scan_fn(*flip(lat_bwd), s_ctx_b)
    return o_lat_f + jnp.flip(o_lat_b, axis=2), o_ctx_f + jnp.flip(o_ctx_b, axis=2)


def hgrn2_inputs(parts, lb_fwd, lb_bwd):
    q = to_heads(parts[0], H_A).astype(jnp.float32) * HEAD_DIM ** -0.5
    v = to_heads(parts[3], H_A).astype(jnp.float32)

    def forget(z, lb):
        z = to_heads(z, H_A).astype(jnp.float32)
        lb = lb.reshape(H_A, 1, HEAD_DIM)
        log_f = jax.nn.log_sigmoid(z) + jnp.log1p(lb * jnp.exp(-z))
        return (1.0 - lb) * jax.nn.sigmoid(-z), log_f

    k_f, lf_f = forget(parts[1], lb_fwd)
    k_b, lf_b = forget(parts[2], lb_bwd)
    return (q, k_f, v, lf_f), (q, k_b, v, lf_b)


def gdn_inputs(parts, conv_w, a_log, dt_bias, rope):
    qkv = jax.nn.silu(depthwise_conv(jnp.concatenate(parts[5:8], axis=-1), conv_w)).astype(jnp.float32)
    q, k, v = [to_heads(t, H_B) for t in jnp.split(qkv, 3, axis=-1)]
    q, k = l2_normalize(q), l2_normalize(k)
    if rope is not None:
        q, k = apply_rope(q, *rope), apply_rope(k, *rope)
    q = q * HEAD_DIM ** -0.5

    def gates(a, b, d):
        log_alpha = -jnp.exp(a_log[d].astype(jnp.float32)) * jax.nn.softplus(
            a.astype(jnp.float32) + dt_bias[d].astype(jnp.float32))
        beta = jax.nn.sigmoid(b.astype(jnp.float32))
        return log_alpha.transpose(0, 2, 1), beta.transpose(0, 2, 1)

    la_f, be_f = gates(parts[9], parts[11], 0)
    la_b, be_b = gates(parts[10], parts[12], 1)
    return (q, k, v, la_f, be_f), (q, k, v, la_b, be_b)


def gated_head_norm(o, g, gate):
    return merge_heads(rms_norm(o, g)).astype(gate.dtype) * jax.nn.silu(gate)


def neighbourhood_attention(q, k, v, k_ctx, v_ctx, rpb):
    b, t, h, dh = q.shape
    rows = t // GRID_W
    kr = min(WIN_R, rows)
    q = q.reshape(b, rows, GRID_W, h, dh)
    k = k.reshape(b, rows, GRID_W, h, dh)
    v = v.reshape(b, rows, GRID_W, h, dh)
    cols = jnp.arange(GRID_W)
    col_idx = jnp.clip(cols - WIN_C // 2, 0, GRID_W - WIN_C)[:, None] + jnp.arange(WIN_C)
    rpb_cols = rpb[:, :, col_idx - cols[:, None] + WIN_C - 1]
    n_loc = kr * WIN_C

    def row_block(r):
        r0 = jnp.clip(r - WIN_R // 2, 0, rows - kr)
        q_r = lax.dynamic_index_in_dim(q, r, axis=1, keepdims=False)
        k_w = lax.dynamic_slice_in_dim(k, r0, kr, axis=1)[:, :, col_idx]
        v_w = lax.dynamic_slice_in_dim(v, r0, kr, axis=1)[:, :, col_idx]
        bias = rpb_cols[:, r0 + jnp.arange(kr) - r + WIN_R - 1]
        s_loc = jnp.einsum('bjhd,bajchd->bhjac', q_r, k_w).astype(jnp.float32) \
            + bias.transpose(0, 2, 1, 3)[None].astype(jnp.float32)
        s_ctx = jnp.einsum('bjhd,blhd->bhjl', q_r, k_ctx).astype(jnp.float32)
        p = jax.nn.softmax(jnp.concatenate([s_loc.reshape(b, h, GRID_W, n_loc), s_ctx], axis=-1), axis=-1)
        p = p.astype(v.dtype)
        p_loc = p[..., :n_loc].reshape(b, h, GRID_W, kr, WIN_C)
        return jnp.einsum('bhjac,bajchd->bjhd', p_loc, v_w) + jnp.einsum('bhjl,blhd->bjhd', p[..., n_loc:], v_ctx)

    out = lax.map(row_block, jnp.arange(rows))
    return jnp.moveaxis(out, 0, 1).reshape(b, t, h, dh)


def context_attention(q, k, v):
    s = jnp.einsum('blhd,bmhd->bhlm', q, k).astype(jnp.float32)
    p = jax.nn.softmax(s, axis=-1).astype(v.dtype)
    return jnp.einsum('bhlm,bmhd->blhd', p, v)


def token_mixers(p_lat, p_ctx, rope, lb_fwd, lb_bwd, hgrn_g, conv_w, a_log, dt_bias, gdn_g,
                 qn_g, kn_g, rpb, with_ctx_out):
    b, t, _ = p_lat[0].shape
    l = p_ctx[0].shape[1]
    a_lat_f, a_lat_b = hgrn2_inputs(p_lat, lb_fwd, lb_bwd)
    a_ctx_f, a_ctx_b = hgrn2_inputs(p_ctx, lb_fwd, lb_bwd)
    oa_lat, oa_ctx = bidirectional_scan(hgrn2_chunk_scan, a_lat_f, a_ctx_f, a_lat_b, a_ctx_b,
                                        (b, H_A, HEAD_DIM, HEAD_DIM))
    g_lat_f, g_lat_b = gdn_inputs(p_lat, conv_w, a_log, dt_bias, rope)
    g_ctx_f, g_ctx_b = gdn_inputs(p_ctx, conv_w, a_log, dt_bias, None)
    ob_lat, ob_ctx = bidirectional_scan(gdn_chunk_scan, g_lat_f, g_ctx_f, g_lat_b, g_ctx_b,
                                        (b, H_B, HEAD_DIM, HEAD_DIM))

    def na_qkv(parts):
        q, k, v = [a.reshape(a.shape[0], a.shape[1], H_C, HEAD_DIM) for a in parts[13:16]]
        return rms_norm(q, qn_g) * HEAD_DIM ** -0.5, rms_norm(k, kn_g), v

    q_lat, k_lat, v_lat = na_qkv(p_lat)
    q_ctx, k_ctx, v_ctx = na_qkv(p_ctx)
    oc_lat = neighbourhood_attention(q_lat, k_lat, v_lat, k_ctx, v_ctx, rpb).reshape(b, t, D_C)
    y_lat = jnp.concatenate([gated_head_norm(oa_lat, hgrn_g, p_lat[4]),
                             gated_head_norm(ob_lat, gdn_g, p_lat[8]), oc_lat], axis=-1)
    if not with_ctx_out:
        return y_lat, None
    oc_ctx = context_attention(q_ctx, k_ctx, v_ctx).reshape(b, l, D_C)
    y_ctx = jnp.concatenate([gated_head_norm(oa_ctx, hgrn_g, p_ctx[4]),
                             gated_head_norm(ob_ctx, gdn_g, p_ctx[8]), oc_ctx], axis=-1)
    return y_lat, y_ctx


def swiglu(h, w1, w3, w2):
    return (jax.nn.silu(h @ w1) * (h @ w3)) @ w2


def moe_swiglu(h, w_router, b_router, w1, w3, w2):
    shape = h.shape
    hf = h.reshape(-1, shape[-1])
    n = hf.shape[0]
    logits = (hf @ w_router).astype(jnp.float32) + b_router.astype(jnp.float32)
    top_logit, top_e = lax.top_k(logits, TOP_K)
    gate = jax.nn.softmax(top_logit, axis=-1)
    e_flat = top_e.reshape(-1)
    tok_flat = jnp.repeat(jnp.arange(n, dtype=jnp.int32), TOP_K)
    order = jnp.argsort(e_flat)
    e_sorted = e_flat[order]
    counts = jnp.bincount(e_flat, length=N_EXPERTS)
    padded = (counts + MOE_BLOCK - 1) // MOE_BLOCK * MOE_BLOCK
    pad_end = jnp.cumsum(padded)
    pad_start = pad_end - padded
    grp_start = jnp.cumsum(counts) - counts
    slot = pad_start[e_sorted] + jnp.arange(n * TOP_K) - grp_start[e_sorted]
    n_blocks = -(-(n * TOP_K) // MOE_BLOCK) + N_EXPERTS
    n_slots = n_blocks * MOE_BLOCK
    slot_tok = jnp.full((n_slots,), n, jnp.int32).at[slot].set(tok_flat[order])
    slot_gate = jnp.zeros((n_slots,), jnp.float32).at[slot].set(gate.reshape(-1)[order])
    block_e = jnp.minimum(jnp.searchsorted(pad_end, jnp.arange(n_blocks) * MOE_BLOCK, side='right'),
                          N_EXPERTS - 1)
    h_pad = jnp.concatenate([hf, jnp.zeros((1, shape[-1]), hf.dtype)], axis=0)
    xb = h_pad[slot_tok].reshape(n_blocks, MOE_BLOCK, shape[-1])
    yb = lax.map(lambda a: swiglu(a[0], w1[a[1]], w3[a[1]], w2[a[1]]), (xb, block_e))
    y = yb.reshape(n_slots, shape[-1]) * slot_gate[:, None].astype(hf.dtype)
    out = jnp.zeros_like(h_pad).at[slot_tok].add(y)[:n]
    return out.reshape(shape)


def setup_inputs(seed: int = 0) -> dict:
    key = jax.random.key(seed)
    ks = jax.random.split(key, 27)
    f32 = jnp.float32
    d = D_MODEL

    def nrm(k, shape, scale):
        return jax.random.normal(k, shape, f32) * scale

    dt = jnp.exp(jax.random.uniform(ks[14], (DEPTH, 2, H_B), f32, math.log(1e-3), math.log(1e-1)))
    return {
        'x': nrm(ks[0], (BATCH, SEQ, d), 1.0),
        'c': nrm(ks[1], (BATCH, d), 1.0),
        'ctx': nrm(ks[2], (BATCH, CTX_LEN, d), 1.0),
        'c_ctx': nrm(ks[3], (d,), 1.0),
        'ada_w': nrm(ks[4], (DEPTH, d, 6 * d), 0.5 * d ** -0.5),
        'ada_b': nrm(ks[5], (DEPTH, 6 * d), 0.02),
        'norm1_g': 1.0 + nrm(ks[6], (DEPTH, d), 0.02),
        'norm2_g': 1.0 + nrm(ks[7], (DEPTH, d), 0.02),
        'w_in': nrm(ks[8], (DEPTH, d, D_PROJ), d ** -0.5),
        'w_out': nrm(ks[9], (DEPTH, D_MIX, d), D_MIX ** -0.5),
        'hgrn_lb_raw': nrm(ks[10], (2, DEPTH, D_A), 1.0),
        'hgrn_onorm_g': 1.0 + nrm(ks[11], (DEPTH, HEAD_DIM), 0.02),
        'gdn_conv_w': nrm(ks[12], (DEPTH, CONV_K, 3 * D_B), CONV_K ** -0.5),
        'gdn_a_log': jnp.log(jax.random.uniform(ks[13], (DEPTH, 2, H_B), f32, 1.0, 16.0)),
        'gdn_dt_bias': dt + jnp.log(-jnp.expm1(-dt)),
        'gdn_onorm_g': 1.0 + nrm(ks[15], (DEPTH, HEAD_DIM), 0.02),
        'na_qnorm_g': 1.0 + nrm(ks[16], (DEPTH, HEAD_DIM), 0.02),
        'na_knorm_g': 1.0 + nrm(ks[17], (DEPTH, HEAD_DIM), 0.02),
        'na_rpb': nrm(ks[18], (DEPTH, H_C, 2 * WIN_R - 1, 2 * WIN_C - 1), 0.1),
        'ffn_w1': nrm(ks[19], (N_DENSE, d, D_FF), d ** -0.5),
        'ffn_w3': nrm(ks[20], (N_DENSE, d, D_FF), d ** -0.5),
        'ffn_w2': nrm(ks[21], (N_DENSE, D_FF, d), D_FF ** -0.5),
        'moe_router_w': nrm(ks[22], (N_MOE, d, N_EXPERTS), d ** -0.5),
        'moe_router_b': nrm(ks[23], (N_MOE, N_EXPERTS), 0.01),
        'moe_w1': nrm(ks[24], (N_MOE, N_EXPERTS, d, D_FF), d ** -0.5),
        'moe_w3': nrm(ks[25], (N_MOE, N_EXPERTS, d, D_FF), d ** -0.5),
        'moe_w2': nrm(ks[26], (N_MOE, N_EXPERTS, D_FF, d), D_FF ** -0.5),
    }


def reference(x, c, ctx, c_ctx, ada_w, ada_b, norm1_g, norm2_g, w_in, w_out, hgrn_lb_raw,
              hgrn_onorm_g, gdn_conv_w, gdn_a_log, gdn_dt_bias, gdn_onorm_g, na_qnorm_g, na_knorm_g,
              na_rpb, ffn_w1, ffn_w3, ffn_w2, moe_router_w, moe_router_b, moe_w1, moe_w3, moe_w2):
    rope = axial_rope(x.shape[1])
    lb_soft = jax.nn.softmax(hgrn_lb_raw.astype(jnp.float32), axis=1)
    lower_bound = jnp.cumsum(lb_soft, axis=1) - lb_soft[:, :1]
    silu_c = jax.nn.silu(c)
    silu_cc = jax.nn.silu(c_ctx)[None]
    xc = ctx
    for l in range(DEPTH):
        last = l == DEPTH - 1
        sh1, sc1, g1, sh2, sc2, g2 = [m[:, None] for m in
                                      jnp.split(silu_c @ ada_w[l] + ada_b[l], 6, axis=-1)]
        sh1c, sc1c, g1c, sh2c, sc2c, g2c = [m[:, None] for m in
                                            jnp.split(silu_cc @ ada_w[l] + ada_b[l], 6, axis=-1)]
        p_lat = split_cols(modulate(x, norm1_g[l], sh1, sc1) @ w_in[l], PROJ_SIZES)
        p_ctx = split_cols(modulate(xc, norm1_g[l], sh1c, sc1c) @ w_in[l], PROJ_SIZES)
        y_lat, y_ctx = token_mixers(p_lat, p_ctx, rope, lower_bound[0, l], lower_bound[1, l],
                                    hgrn_onorm_g[l], gdn_conv_w[l], gdn_a_log[l], gdn_dt_bias[l],
                                    gdn_onorm_g[l], na_qnorm_g[l], na_knorm_g[l], na_rpb[l],
                                    not last)
        x = x + g1 * (y_lat @ w_out[l])
        i = l // 2
        if l % 2 == 0:
            ffn = lambda h: swiglu(h, ffn_w1[i], ffn_w3[i], ffn_w2[i])
        else:
            ffn = lambda h: moe_swiglu(h, moe_router_w[i], moe_router_b[i], moe_w1[i], moe_w3[i], moe_w2[i])
        x = x + g2 * ffn(modulate(x, norm2_g[l], sh2, sc2))
        if not last:
            xc = xc + g1c * (y_ctx @ w_out[l])
            xc = xc + g2c * ffn(modulate(xc, norm2_g[l], sh2c, sc2c))
    return x
```

```cpp
#include <hip/hip_runtime.h>
#include <hip/hip_cooperative_groups.h>
#include <cstdio>
#include <cstdint>
namespace cg = cooperative_groups;

#define LAS __attribute__((address_space(3)))
typedef unsigned short bf16_t;
typedef short bf16x8 __attribute__((ext_vector_type(8)));
typedef float f32x4 __attribute__((ext_vector_type(4)));
typedef float f32x2 __attribute__((ext_vector_type(2)));
typedef unsigned u32x4 __attribute__((ext_vector_type(4)));
typedef unsigned u32x2 __attribute__((ext_vector_type(2)));

constexpr int D = 1024, NB = 2, SEQ = 8192, CTXL = 256, NLAT = NB * SEQ, NCTX = NB * CTXL, MTOK = NLAT + NCTX;
constexpr int NP = 3840;
constexpr int C_HQ = 0, C_HFF = 256, C_HFB = 512, C_HI = 768, C_HG = 1024, C_GQ = 1280, C_GK = 1536, C_GV = 1792, C_GG = 2048, C_NQ = 2304, C_NK = 2816, C_NV = 3328;
constexpr int DPROJ = 3856, DFF = 3584, NEXP = 8;
constexpr int NCH = 132;
constexpr int NSLOT_TILES = 136, NSLOTS = NSLOT_TILES * 256, HALF_TILES = 68;
constexpr int VT_LD = 8448;
constexpr float EPS = 1e-6f;

constexpr size_t KiB = 1024, MiB = 1024 * 1024;
constexpr size_t WS_CTL = 0, CTL_BYTES = 64 * KiB;
constexpr size_t WS_MOD = 64 * KiB;
constexpr size_t WS_ROPE = 256 * KiB;
constexpr size_t WS_WG = 320 * KiB;
constexpr size_t WS_WR = 448 * KiB;
constexpr size_t WS_TOKE = 512 * KiB, WS_TOKG = 640 * KiB, WS_TOKS = 768 * KiB, WS_SLOTTOK = 896 * KiB;
constexpr size_t WS_TILEE = 1040 * KiB;
constexpr size_t WS_GATES = 2 * MiB;
constexpr size_t WS_XC = 4 * MiB;
constexpr size_t WS_WIN = 6 * MiB;
constexpr size_t WS_WOUT = 21 * MiB;
constexpr size_t WS_W13 = 25 * MiB;
constexpr size_t WS_W2 = 39 * MiB;
constexpr size_t WS_H = 46 * MiB;
constexpr size_t WS_P = 80 * MiB;
constexpr size_t WS_SCR = 204 * MiB;
constexpr size_t NITEM = 16 * NCH;
constexpr size_t WS_GA = WS_SCR;
constexpr size_t WS_GB = WS_GA + NITEM * 8192;
constexpr size_t WS_GW = WS_GB + NITEM * 16384;
constexpr size_t WS_GU = WS_GW + NITEM * 8192;
constexpr size_t WS_GS = WS_GU + NITEM * 8192;
constexpr size_t WS_GQKV = WS_GS + NITEM * 8192;
constexpr size_t WS_HB = WS_GQKV + (size_t)3 * MTOK * 256 * 2;
constexpr size_t WS_HA = WS_HB + NITEM * 16384;
constexpr size_t WS_VT = WS_HA + NITEM * 256;
constexpr size_t WS_SCR_END = WS_VT + (size_t)NB * 8 * 64 * VT_LD * 2;
constexpr size_t WS_MOEW13 = WS_SCR;
constexpr size_t WS_MOEW2 = WS_MOEW13 + (size_t)8 * 7168 * 1024 * 2;
constexpr size_t WS_YP = 396 * MiB;
constexpr size_t WS_END = WS_YP + (size_t)NSLOTS * 1024 * 2;
static_assert(WS_SCR_END <= WS_YP && WS_MOEW2 + (size_t)8 * 1024 * 3584 * 2 <= WS_YP, "ws map");
static_assert(WS_P + (size_t)MTOK * NP * 2 <= WS_SCR && WS_H + (size_t)MTOK * D * 2 <= WS_P, "ws map");
constexpr int CW_CNT = 64, CW_CUR = 128, CW_NAQ = 192;

constexpr int LDS_BYTES = 147456;
constexpr int LDS_CTLOFF = 135168;

__device__ __forceinline__ float bf2f(unsigned short b) { return __uint_as_float((unsigned)b << 16); }
__device__ __forceinline__ unsigned f2bf(float f) { unsigned u = __float_as_uint(f); return (u + 0x7fffu + ((u >> 16) & 1u)) >> 16; }
__device__ __forceinline__ unsigned pk2(float lo, float hi) { return f2bf(lo) | (f2bf(hi) << 16); }
__device__ __forceinline__ void unpack8(const u32x4 v, float (&f)[8]) {
#pragma unroll
    for (int i = 0; i < 4; ++i) { f[2 * i] = __uint_as_float(v[i] << 16); f[2 * i + 1] = __uint_as_float(v[i] & 0xffff0000u); }
}
__device__ __forceinline__ u32x4 pack8(const float (&f)[8]) { u32x4 v; v.x = pk2(f[0], f[1]); v.y = pk2(f[2], f[3]); v.z = pk2(f[4], f[5]); v.w = pk2(f[6], f[7]); return v; }
__device__ __forceinline__ float wave_sum(float v) {
#pragma unroll
    for (int o = 1; o < 64; o <<= 1) v += __shfl_xor(v, o);
    return v;
}
__device__ __forceinline__ float sigmoidf_(float x) { return 1.f / (1.f + __expf(-x)); }
__device__ __forceinline__ float siluf_(float x) { return x / (1.f + __expf(-x)); }
__device__ __forceinline__ float softplusf_(float x) { return x > 20.f ? x : log1pf(expf(x)); }
__device__ __forceinline__ float logsigmoidf_(float z) { return fminf(z, 0.f) - log1pf(expf(-fabsf(z))); }
__device__ __forceinline__ int chunk_row(int b, int cid) { return cid < 128 ? b * SEQ + cid * 64 : NLAT + b * CTXL + (cid - 128) * 64; }
__device__ __forceinline__ int seq_cid(int dir, int step) { return dir == 0 ? (step < 4 ? 128 + step : step - 4) : (step < 4 ? 131 - step : 131 - step); }

__device__ __forceinline__ f32x4 mm16(const bf16_t* As, int lda, const bf16_t* Bs, int ldb, f32x4 acc, int lane) {
    const int r = lane & 15, g = lane >> 4;
#pragma unroll
    for (int kk = 0; kk < 2; ++kk) {
        const bf16x8 a = *(const bf16x8*)(As + r * lda + kk * 32 + g * 8);
        const bf16x8 b = *(const bf16x8*)(Bs + r * ldb + kk * 32 + g * 8);
        acc = __builtin_amdgcn_mfma_f32_16x16x32_bf16(a, b, acc, 0, 0, 0);
    }
    return acc;
}
constexpr int LDP = 72;

struct Params {
    const float* in[27];
    float* out;
    unsigned char* ws;
    int ph_lo, ph_hi;
};
namespace pg8 {
constexpr int BM = 256, BK = 64, HALF = 128, HTB = HALF * BK * 2, STAGE_BYTES = 8 * HTB, NXCD = 8, WGM = 8;
__host__ __device__ __forceinline__ int lds_byte(int r, int c) { const int st = (r >> 4) * 2 + (c >> 5), rr = r & 15, cc = c & 31, ob = rr * 64 + cc * 2; return st * 1024 + (ob ^ (((ob >> 9) & 1) << 5)); }
__host__ __device__ __forceinline__ void stage_rc(int b, int& R, int& C) { const int st = b / 1024, sb = b % 1024, swz = sb ^ (((sb >> 9) & 1) << 5); R = (st >> 1) * 16 + swz / 64; C = (st & 1) * 32 + (swz % 64) / 2; }
__host__ __device__ __forceinline__ int perm32(int rho) { const int n = rho >> 4, i = rho & 15; return 8 * (i >> 2) + 4 * n + (i & 3); }

struct Unit { int pm, pn; };
struct Gemm { const bf16_t* A; const bf16_t* Bt; int K, nM, nN; const int* rowmap; int arow0; const int* tile_e; int tile0; size_t estride; };

__device__ __forceinline__ bool next_unit(int nM, int nN, int G, int c, int i, Unit& u) {
    const int nwg = nM * nN; const long L = (long)i * G + c; if (L >= nwg) return false;
    int wgid = (int)L; { const int q = nwg / NXCD, r = nwg % NXCD, xcd = wgid % NXCD, off = wgid / NXCD; wgid = (xcd < r ? xcd * (q + 1) : r * (q + 1) + (xcd - r) * q) + off; }
    const int nig = WGM * nN, gid = wgid / nig, fm = gid * WGM, gsz = (nM - fm) < WGM ? (nM - fm) : WGM;
    u.pm = fm + ((wgid % nig) % gsz); u.pn = (wgid % nig) / gsz; return true;
}
__device__ __forceinline__ unsigned cvt_pk_bf16(float lo, float hi) { unsigned r; asm volatile("v_cvt_pk_bf16_f32 %0, %1, %2" : "=v"(r) : "v"(lo), "v"(hi)); return r; }

struct EpiBf16 {
    static constexpr bool PERM = true;
    bf16_t* O; int ldc; int row0;
    __device__ __forceinline__ void operator()(const f32x4 (&acc)[2][2][4][2], const Unit& u, int wr, int wc, int fr, int fq) const {
        const int rowb = row0 + u.pm * BM + wr * 64 + fr; const int col0 = u.pn * BM + wc * 32 + 8 * fq;
#pragma unroll
        for (int ai = 0; ai < 2; ++ai)
#pragma unroll
            for (int m = 0; m < 4; ++m) { bf16_t* rowp = O + (size_t)(rowb + ai * HALF + m * 16) * ldc + col0;
#pragma unroll
                for (int bj = 0; bj < 2; ++bj) { const f32x4 v0 = acc[ai][bj][m][0], v1 = acc[ai][bj][m][1];
                    u32x4 w; w.x = cvt_pk_bf16(v0[0], v0[1]); w.y = cvt_pk_bf16(v0[2], v0[3]); w.z = cvt_pk_bf16(v1[0], v1[1]); w.w = cvt_pk_bf16(v1[2], v1[3]);
                    *(u32x4*)(rowp + bj * HALF) = w; } }
    }
};
struct EpiSwiGLU {
    static constexpr bool PERM = true;
    bf16_t* O; int ldc;
    __device__ __forceinline__ void operator()(const f32x4 (&acc)[2][2][4][2], const Unit& u, int wr, int wc, int fr, int fq) const {
        const int rowb = u.pm * BM + wr * 64 + fr; const int col0 = (u.pn * BM + wc * 32 + 8 * fq) >> 1;
#pragma unroll
        for (int ai = 0; ai < 2; ++ai)
#pragma unroll
            for (int m = 0; m < 4; ++m) { bf16_t* rowp = O + (size_t)(rowb + ai * HALF + m * 16) * ldc + col0;
#pragma unroll
                for (int bj = 0; bj < 2; ++bj) { const f32x4 g = acc[ai][bj][m][0], v = acc[ai][bj][m][1];
                    float a[4];
#pragma unroll
                    for (int e = 0; e < 4; ++e) a[e] = g[e] / (1.f + __expf(-g[e])) * v[e];
                    u32x2 w; w.x = cvt_pk_bf16(a[0], a[1]); w.y = cvt_pk_bf16(a[2], a[3]);
                    *(u32x2*)(rowp + bj * (HALF / 2)) = w; } }
    }
};
struct EpiResid {
    static constexpr bool PERM = false;
    const float* base_lat; const float* base_ctx; float* out_lat; float* out_ctx; const float* gate;
    __device__ __forceinline__ void operator()(const f32x4 (&acc)[2][2][4][2], const Unit& u, int wr, int wc, int fr, int fq) const {
        const bool isctx = u.pm >= 64; const int s = isctx ? 2 : (u.pm >> 5);
        const float* bp = isctx ? base_ctx : base_lat; float* op = isctx ? out_ctx : out_lat;
        const int rowb = (isctx ? (u.pm - 64) : u.pm) * BM + wr * 64 + fr; const int col0 = u.pn * BM + wc * 32 + 4 * fq;
        f32x4 gv[2][2];
#pragma unroll
        for (int bj = 0; bj < 2; ++bj)
#pragma unroll
            for (int n = 0; n < 2; ++n) gv[bj][n] = *(const f32x4*)(gate + s * 6144 + col0 + bj * HALF + n * 16);
#pragma unroll
        for (int ai = 0; ai < 2; ++ai)
#pragma unroll
            for (int m = 0; m < 4; ++m) { const size_t off = (size_t)(rowb + ai * HALF + m * 16) * D + col0;
#pragma unroll
                for (int bj = 0; bj < 2; ++bj)
#pragma unroll
                    for (int n = 0; n < 2; ++n) { const f32x4 b = *(const f32x4*)(bp + off + bj * HALF + n * 16); *(f32x4*)(op + off + bj * HALF + n * 16) = b + gv[bj][n] * acc[ai][bj][m][n]; } }
    }
};

__device__ __forceinline__ void a_offsets(const Gemm& g, const Unit& u, int tid, unsigned (&o)[2][2]) {
#pragma unroll
    for (int h = 0; h < 2; ++h)
#pragma unroll
        for (int i = 0; i < 2; ++i) {
            int R, C; stage_rc(tid * 16 + i * 8192, R, C);
            const int lr = u.pm * BM + h * HALF + R;
            const int row = g.rowmap ? g.rowmap[g.tile0 * BM + lr] : g.arow0 + lr;
            o[h][i] = ((unsigned)row * (unsigned)g.K + (unsigned)C) * 2u;
        }
}
__device__ __forceinline__ const char* b_base(const Gemm& g, const Unit& u) {
    const size_t e = g.tile_e ? (size_t)g.tile_e[g.tile0 + u.pm] * g.estride : 0;
    return (const char*)(g.Bt + e + (size_t)u.pn * BM * g.K);
}

template <class Epi>
__device__ __forceinline__ void gemm_phase(LAS unsigned char* lds, const Gemm g, const Epi& E) {
    const int tid = threadIdx.x, wid = __builtin_amdgcn_readfirstlane(tid >> 6), lane = tid & 63, wr = wid >> 2, wc = wid & 3, fr = lane & 15, fq = lane >> 4;
    const int K = g.K, nt = K / BK, G = gridDim.x, cidx = blockIdx.x;
    unsigned voffB[2];
#pragma unroll
    for (int i = 0; i < 2; ++i) { int R, C; stage_rc(tid * 16 + i * 8192, R, C); const int Rb = Epi::PERM ? ((R & ~31) + perm32(R & 31)) : R; voffB[i] = (unsigned)(Rb * K + C) * 2u; }
    const size_t kstep = (size_t)(BK * 2);
    const size_t hstep = (size_t)HALF * K * 2;
    const unsigned ldsw = (unsigned)wid * 1024u;
    const int aoff = lds_byte(wr * 64 + fr, fq * 8), boff = lds_byte(wc * 32 + fr, fq * 8);
#define PG8_SA(b, h) (((b) * 2 + (h)) * HTB)
#define PG8_SB(b, h) ((4 + (b) * 2 + (h)) * HTB)
#define PG8_STAGE(bufoff, gbase, voff) do { _Pragma("unroll") for (int _i = 0; _i < 2; ++_i) \
        __builtin_amdgcn_global_load_lds((const unsigned*)((const char*)(gbase) + (voff)[_i]), (LAS unsigned*)(lds + (bufoff) + ldsw + _i * 8192), 16, 0, 0); } while (0)
#define PG8_LDA(dst, b, h) do { _Pragma("unroll") for (int m = 0; m < 4; ++m) _Pragma("unroll") for (int k = 0; k < 2; ++k) dst[m][k] = *(const LAS bf16x8*)(lds + PG8_SA(b, h) + aoff + m * 2048 + k * 1024); } while (0)
#define PG8_LDB(dst, b, h) do { _Pragma("unroll") for (int n = 0; n < 2; ++n) _Pragma("unroll") for (int k = 0; k < 2; ++k) dst[n][k] = *(const LAS bf16x8*)(lds + PG8_SB(b, h) + boff + n * 2048 + k * 1024); } while (0)
#define PG8_MMA(ai, bj, At, Bt) do { __builtin_amdgcn_s_setprio(1); _Pragma("unroll") for (int m = 0; m < 4; ++m) _Pragma("unroll") for (int n = 0; n < 2; ++n) _Pragma("unroll") for (int k = 0; k < 2; ++k) \
        acc[ai][bj][m][n] = __builtin_amdgcn_mfma_f32_16x16x32_bf16(Bt[n][k], At[m][k], acc[ai][bj][m][n], 0, 0, 0); __builtin_amdgcn_s_setprio(0); } while (0)
#define PG8_WAIT_V(n) asm volatile("s_waitcnt vmcnt(" #n ")" ::: "memory")
#define PG8_WAIT_L(n) asm volatile("s_waitcnt lgkmcnt(" #n ")" ::: "memory")
#define PG8_BAR __builtin_amdgcn_s_barrier()
#define PG8_SCHED __builtin_amdgcn_sched_barrier(0)
    Unit cur, nxt; int ui = 0;
    if (!next_unit(g.nM, g.nN, G, cidx, 0, cur)) return;
    f32x4 acc[2][2][4][2];
#pragma unroll
    for (int a = 0; a < 2; ++a)
#pragma unroll
        for (int b = 0; b < 2; ++b)
#pragma unroll
            for (int m = 0; m < 4; ++m)
#pragma unroll
                for (int n = 0; n < 2; ++n) acc[a][b][m][n] = (f32x4){0.f, 0.f, 0.f, 0.f};
    bf16x8 At[4][2], B0[2][2], B1[2][2];
    const char* const Ab = (const char*)g.A;
    unsigned oc[2][2];
    a_offsets(g, cur, tid, oc);
    const char* cB = b_base(g, cur);
    PG8_STAGE(PG8_SB(0, 0), cB, voffB); PG8_STAGE(PG8_SB(0, 1), cB + hstep, voffB); PG8_STAGE(PG8_SA(0, 0), Ab, oc[0]); PG8_STAGE(PG8_SA(0, 1), Ab, oc[1]);
    if (wr == 1) PG8_BAR;
    PG8_WAIT_V(2); PG8_BAR;
    PG8_STAGE(PG8_SB(1, 0), cB + kstep, voffB); PG8_STAGE(PG8_SA(1, 0), Ab + kstep, oc[0]); PG8_STAGE(PG8_SB(1, 1), cB + hstep + kstep, voffB);
    PG8_WAIT_V(6); PG8_BAR;
    for (;;) {
        bool has_next = false; const char* nB = cB;
        for (int t = 0; t < nt; t += 2) {
            const bool last = (t == nt - 2);
            const char* a1 = Ab + (size_t)(t + 1) * kstep;
            PG8_LDB(B0, 0, 0); PG8_LDB(B1, 0, 1); PG8_SCHED; PG8_LDA(At, 0, 0); PG8_STAGE(PG8_SA(1, 1), a1, oc[1]);
            PG8_WAIT_V(8); PG8_WAIT_L(0); PG8_BAR; PG8_MMA(0, 0, At, B0); PG8_MMA(0, 1, At, B1); PG8_BAR; PG8_SCHED;
            if (last) { has_next = next_unit(g.nM, g.nN, G, cidx, ui + 1, nxt); if (has_next) { a_offsets(g, nxt, tid, oc); nB = b_base(g, nxt); } }
            const char* a2 = last ? Ab : Ab + (size_t)(t + 2) * kstep; const char* b2 = last ? nB : cB + (size_t)(t + 2) * kstep;
            const char* a3 = a2 + kstep; const char* b3 = b2 + kstep;
            PG8_LDA(At, 0, 1); PG8_STAGE(PG8_SB(0, 0), b2, voffB); PG8_STAGE(PG8_SB(0, 1), b2 + hstep, voffB); PG8_STAGE(PG8_SA(0, 0), a2, oc[0]);
            PG8_WAIT_V(8); PG8_WAIT_L(0); PG8_BAR; PG8_MMA(1, 0, At, B0); PG8_MMA(1, 1, At, B1); PG8_BAR; PG8_SCHED;
            PG8_LDB(B0, 1, 0); PG8_LDB(B1, 1, 1); PG8_SCHED; PG8_LDA(At, 1, 0); PG8_STAGE(PG8_SA(0, 1), a2, oc[1]);
            PG8_WAIT_V(8); PG8_WAIT_L(0); PG8_BAR; PG8_MMA(0, 0, At, B0); PG8_MMA(0, 1, At, B1); PG8_BAR; PG8_SCHED;
            PG8_LDA(At, 1, 1); PG8_STAGE(PG8_SB(1, 0), b3, voffB); PG8_STAGE(PG8_SB(1, 1), b3 + hstep, voffB); PG8_STAGE(PG8_SA(1, 0), a3, oc[0]);
            PG8_WAIT_V(8); PG8_WAIT_L(0); PG8_BAR; PG8_MMA(1, 0, At, B0); PG8_MMA(1, 1, At, B1); PG8_BAR; PG8_SCHED;
        }
        if (wr == 0) PG8_BAR;
        E(acc, cur, wr, wc, fr, fq);
        if (!has_next) break;
#pragma unroll
        for (int a = 0; a < 2; ++a)
#pragma unroll
            for (int b = 0; b < 2; ++b)
#pragma unroll
                for (int m = 0; m < 4; ++m)
#pragma unroll
                    for (int n = 0; n < 2; ++n) acc[a][b][m][n] = (f32x4){0.f, 0.f, 0.f, 0.f};
        cur = nxt; cB = nB; ++ui;
        if (wr == 1) PG8_BAR;
    }
    PG8_WAIT_V(0);
    PG8_BAR;
#undef PG8_SA
#undef PG8_SB
#undef PG8_STAGE
#undef PG8_LDA
#undef PG8_LDB
#undef PG8_MMA
#undef PG8_WAIT_V
#undef PG8_WAIT_L
#undef PG8_BAR
#undef PG8_SCHED
}
}
struct Ctx {
    const Params* p;
    unsigned char* lds;
    unsigned char* ws;
    int tid, lane, wave, bid, G;
};
#define INP(i) (c.p->in[i])
#define WSP(T, off) ((T*)(c.ws + (off)))

__device__ __forceinline__ void cvt_item(const Ctx& c, const float* s0, const float* s1, int ldsrc, int mode, int k0, int n0, bf16_t* dst, int Kdst) {
    float* tile = (float*)c.lds;
#pragma unroll
    for (int i = 0; i < 8; ++i) {
        const int idx = c.tid + 512 * i, kk = idx >> 6, nn = idx & 63, n = n0 + nn;
        const float* sp = s0; int col = n; float sc = 1.f;
        if (mode == 0) { col = n + (n >= 2304 ? 16 : 0); sc = n < 256 ? 0.125f : 1.f; }
        else if (mode == 2) { const int q = n >> 3, e = n & 7; sp = e < 4 ? s0 : s1; col = 4 * q + (e & 3); }
        tile[kk * 65 + nn] = sp[(size_t)(k0 + kk) * ldsrc + col] * sc;
    }
    __syncthreads();
    {
        const int r = c.tid >> 3, ch = c.tid & 7; float f[8];
#pragma unroll
        for (int e = 0; e < 8; ++e) f[e] = tile[(8 * ch + e) * 65 + r];
        *(u32x4*)(dst + (size_t)(n0 + r) * Kdst + k0 + 8 * ch) = pack8(f);
    }
    __syncthreads();
}
constexpr int CI_WIN = 16 * 60, CI_WOUT = 16 * 16, CI_W13 = 16 * 112, CI_W2 = 56 * 16;
constexpr int CI_DENSE = 2 * CI_WIN + 2 * CI_WOUT + CI_W13 + CI_W2;
__device__ __forceinline__ void cvt_dense_item(const Ctx& c, int it) {
    if (it < 2 * CI_WIN) { const int l = it / CI_WIN, r = it % CI_WIN; cvt_item(c, INP(8) + (size_t)l * D * DPROJ, nullptr, DPROJ, 0, (r / 60) * 64, (r % 60) * 64, WSP(bf16_t, WS_WIN) + (size_t)l * NP * D, D); return; }
    it -= 2 * CI_WIN;
    if (it < 2 * CI_WOUT) { const int l = it / CI_WOUT, r = it % CI_WOUT; cvt_item(c, INP(9) + (size_t)l * D * D, nullptr, D, 1, (r / 16) * 64, (r % 16) * 64, WSP(bf16_t, WS_WOUT) + (size_t)l * D * D, D); return; }
    it -= 2 * CI_WOUT;
    if (it < CI_W13) { cvt_item(c, INP(19), INP(20), DFF, 2, (it / 112) * 64, (it % 112) * 64, WSP(bf16_t, WS_W13), D); return; }
    it -= CI_W13;
    cvt_item(c, INP(21), nullptr, D, 1, (it / 16) * 64, (it % 16) * 64, WSP(bf16_t, WS_W2), DFF);
}
constexpr int CI_MOE = 8 * (CI_W13 + CI_W2);
__device__ __forceinline__ void cvt_moe_item(const Ctx& c, int it) {
    const int e = it / (CI_W13 + CI_W2); int r = it % (CI_W13 + CI_W2);
    if (r < CI_W13) { cvt_item(c, INP(24) + (size_t)e * D * DFF, INP(25) + (size_t)e * D * DFF, DFF, 2, (r / 112) * 64, (r % 112) * 64, WSP(bf16_t, WS_MOEW13) + (size_t)e * 7168 * D, D); return; }
    r -= CI_W13;
    cvt_item(c, INP(26) + (size_t)e * DFF * D, nullptr, D, 1, (r / 16) * 64, (r % 16) * 64, WSP(bf16_t, WS_MOEW2) + (size_t)e * D * DFF, DFF);
}

__device__ __forceinline__ void phase_prologue(const Ctx& c) {
    {
        float* sv = (float*)c.lds;
        float* red = sv + 3 * 1024;
        for (int i = c.tid; i < 3 * 1024; i += 512) { const int s = i >> 10, k = i & 1023; const float x = s < 2 ? INP(1)[s * D + k] : INP(3)[k]; sv[i] = siluf_(x); }
        __syncthreads();
        for (int it = c.bid; it < 2 * 96; it += c.G) {
            const int l = it / 96, n0 = (it % 96) * 64, col = c.tid & 63, kg = c.tid >> 6;
            const float* w = INP(4) + (size_t)l * D * 6144 + n0 + col;
            float a0 = 0.f, a1 = 0.f, a2 = 0.f;
#pragma unroll 8
            for (int k = kg; k < D; k += 8) { const float wv = w[(size_t)k * 6144]; a0 += sv[k] * wv; a1 += sv[1024 + k] * wv; a2 += sv[2048 + k] * wv; }
            red[(kg * 3 + 0) * 64 + col] = a0; red[(kg * 3 + 1) * 64 + col] = a1; red[(kg * 3 + 2) * 64 + col] = a2;
            __syncthreads();
            if (c.tid < 192) { const int s = c.tid >> 6; float a = INP(5)[l * 6144 + n0 + col];
#pragma unroll
                for (int q = 0; q < 8; ++q) a += red[(q * 3 + s) * 64 + col];
                WSP(float, WS_MOD)[(l * 3 + s) * 6144 + n0 + col] = a; }
            __syncthreads();
        }
    }
    {
        const int gt = c.bid * 512 + c.tid, GT = c.G * 512;
        for (int i = gt; i < 2 * 16 * 1024; i += GT) { const int l = i >> 14, j = (i >> 10) & 15, k = i & 1023; WSP(float, WS_WG)[i] = INP(8)[(size_t)l * D * DPROJ + (size_t)k * DPROJ + 2304 + j]; }
        for (int i = gt; i < 8 * 1024; i += GT) { const int e = i >> 10, k = i & 1023; WSP(float, WS_WR)[i] = INP(22)[k * 8 + e]; }
        for (int i = gt; i < 128 * 16; i += GT) { const int pos = i >> 4, f = i & 15; const float inv = powf(10000.f, -(float)f / 16.f); const float ang = (float)pos * inv;
            WSP(float, WS_ROPE)[i] = cosf(ang); WSP(float, WS_ROPE)[2048 + i] = sinf(ang); }
        for (int i = gt; i < NSLOTS; i += GT) WSP(int, WS_SLOTTOK)[i] = 0;
    }
    __syncthreads();
    for (int it = c.bid; it < CI_DENSE; it += c.G) cvt_dense_item(c, it);
}

__device__ __forceinline__ void phase_norm(const Ctx& c, int l, int which) {
    const int nrows = (l == 1 && which == 2) ? NLAT : MTOK;
    const int NG = which == 1 ? 16 : (l == 1 ? 8 : 0);
    float* wl = (float*)c.lds;
    unsigned* hist = (unsigned*)(c.lds + 65536);
    if (NG) { const float* src = which == 1 ? WSP(float, WS_WG) + l * 16 * 1024 : WSP(float, WS_WR);
        for (int i = c.tid; i < NG * 1024; i += 512) wl[i] = src[i]; }
    if (c.tid < 8) hist[c.tid] = 0u;
    __syncthreads();
    const float* ng = INP(which == 1 ? 6 : 7) + l * D;
    const float* mod = WSP(float, WS_MOD) + (size_t)l * 3 * 6144;
    const bool from_input = (l == 0 && which == 1);
    bf16_t* H = WSP(bf16_t, WS_H);
    for (int row = c.bid * 8 + c.wave; row < nrows; row += c.G * 8) {
        const int s = row < SEQ ? 0 : (row < NLAT ? 1 : 2);
        const float* xr = row < NLAT ? (from_input ? INP(0) : c.p->out) + (size_t)row * D : (from_input ? INP(2) : WSP(float, WS_XC)) + (size_t)(row - NLAT) * D;
        f32x4 v[4]; float ss = 0.f;
#pragma unroll
        for (int j = 0; j < 4; ++j) { v[j] = *(const f32x4*)(xr + 4 * c.lane + 256 * j); ss += (v[j].x * v[j].x + v[j].y * v[j].y) + (v[j].z * v[j].z + v[j].w * v[j].w); }
        const float r = rsqrtf(wave_sum(ss) * (1.f / D) + EPS);
        const float* sh = mod + s * 6144 + (which == 1 ? 0 : 3072); const float* sc = sh + 1024;
#pragma unroll
        for (int j = 0; j < 4; ++j) { const int col = 4 * c.lane + 256 * j;
            const f32x4 g = *(const f32x4*)(ng + col), a = *(const f32x4*)(sc + col), b = *(const f32x4*)(sh + col);
            v[j] = (v[j] * r) * g * (a + 1.f) + b;
            u32x2 w; w.x = pk2(v[j].x, v[j].y); w.y = pk2(v[j].z, v[j].w);
            *(u32x2*)(H + (size_t)row * D + col) = w; }
        if (NG) {
            float mine = 0.f;
#pragma unroll 2
            for (int q = 0; q < NG; ++q) { float a = 0.f;
#pragma unroll
                for (int j = 0; j < 4; ++j) { const f32x4 w = *(const f32x4*)(wl + q * 1024 + 4 * c.lane + 256 * j); a += (v[j].x * w.x + v[j].y * w.y) + (v[j].z * w.z + v[j].w * w.w); }
                a = wave_sum(a); if (c.lane == q) mine = a; }
            if (NG == 16) { if (c.lane < 16) WSP(float, WS_GATES)[(size_t)row * 16 + c.lane] = mine; }
            else {
            float lg[8];
#pragma unroll
            for (int q = 0; q < 8; ++q) lg[q] = __shfl(mine, q) + INP(23)[q];
            int e0 = 0; float m0 = lg[0];
#pragma unroll
            for (int q = 1; q < 8; ++q) if (lg[q] > m0) { m0 = lg[q]; e0 = q; }
            int e1 = -1; float m1 = -3.0e38f;
#pragma unroll
            for (int q = 0; q < 8; ++q) if (q != e0 && lg[q] > m1) { m1 = lg[q]; e1 = q; }
            const float g0 = 1.f / (1.f + expf(m1 - m0)), g1 = 1.f - g0;
            if (c.lane == 0) { WSP(int, WS_TOKE)[row * 2] = e0; WSP(int, WS_TOKE)[row * 2 + 1] = e1; WSP(float, WS_TOKG)[row * 2] = g0; WSP(float, WS_TOKG)[row * 2 + 1] = g1;
                atomicAdd(&hist[e0], 1u); atomicAdd(&hist[e1], 1u); }
            }
        }
    }
    __syncthreads();
    if (NG == 8 && c.tid < 8) atomicAdd(WSP(unsigned, WS_CTL) + CW_CNT + c.tid, hist[c.tid]);
    __syncthreads();
}
__device__ __forceinline__ float gdn_gates(const Ctx& c, int l, int h, int dir, int base, int tau, float& beta) {
    const int tok = dir ? 63 - tau : tau;
    const float* gr = WSP(float, WS_GATES) + (size_t)(base + tok) * 16;
    const float a = gr[dir * 4 + h], bb = gr[8 + dir * 4 + h];
    const float la = -expf(INP(13)[l * 8 + dir * 4 + h]) * softplusf_(a + INP(14)[l * 8 + dir * 4 + h]);
    beta = 1.f / (1.f + expf(-bb));
    float g = la;
#pragma unroll
    for (int o = 1; o < 64; o <<= 1) { const float t = __shfl_up(g, o); if (tau >= o) g += t; }
    return g;
}

__device__ __forceinline__ void m1_gdn_item(const Ctx& c, int l, int b, int h, int cid) {
    unsigned char* L0 = c.lds;
    float* raw = (float*)L0;
    float* Lm = (float*)L0;
    bf16_t* WT = (bf16_t*)(L0 + 32768);
    float* cw = (float*)(L0 + 53248);
    float* gl = (float*)(L0 + 57344);
    bf16_t* Kf = (bf16_t*)(L0 + 58368);
    bf16_t* Vf = Kf + 64 * LDP; bf16_t* Kr = Vf + 64 * LDP; bf16_t* Vr = Kr + 64 * LDP;
    bf16_t* KdT = (bf16_t*)(L0 + 95232);
    bf16_t* U0T = (bf16_t*)(L0 + 113664);
    const int base = chunk_row(b, cid), t0 = cid < 128 ? cid * 64 : (cid - 128) * 64, slen = cid < 128 ? SEQ : CTXL;
    const bf16_t* P = WSP(bf16_t, WS_P);
    for (int idx = c.tid; idx < 68 * 24; idx += 512) {
        const int rr = idx / 24, ch = idx % 24, part = ch >> 3, c8 = ch & 7, tt = t0 + rr - 2;
        float f[8];
        if (tt >= 0 && tt < slen) { const u32x4 v = *(const u32x4*)(P + (size_t)(base + rr - 2) * NP + C_GQ + part * 256 + h * 64 + c8 * 8); unpack8(v, f); }
        else {
#pragma unroll
            for (int e = 0; e < 8; ++e) f[e] = 0.f; }
#pragma unroll
        for (int e = 0; e < 8; ++e) raw[rr * 193 + part * 64 + c8 * 8 + e] = f[e];
    }
    for (int i = c.tid; i < 5 * 192; i += 512) { const int k = i / 192, j = i % 192, part = j >> 6, d = j & 63; cw[i] = INP(12)[(size_t)l * 5 * 768 + k * 768 + part * 256 + h * 64 + d]; }
    __syncthreads();
    {
        const int t = c.tid >> 3, sub = c.tid & 7;
        float y[3][8];
#pragma unroll
        for (int part = 0; part < 3; ++part)
#pragma unroll
            for (int e = 0; e < 8; ++e) { const int j = part * 64 + sub * 8 + e; float a = 0.f;
#pragma unroll
                for (int k = 0; k < 5; ++k) a += cw[k * 192 + j] * raw[(t + k) * 193 + j];
                y[part][e] = siluf_(a); }
#pragma unroll
        for (int part = 0; part < 2; ++part) { float ss = 0.f;
#pragma unroll
            for (int e = 0; e < 8; ++e) ss += y[part][e] * y[part][e];
            ss += __shfl_xor(ss, 1); ss += __shfl_xor(ss, 2); ss += __shfl_xor(ss, 4);
            const float r = rsqrtf(ss + EPS);
#pragma unroll
            for (int e = 0; e < 8; ++e) y[part][e] *= r; }
        if (cid < 128) {
            const float* ct = WSP(float, WS_ROPE); const float* st = ct + 2048;
#pragma unroll
            for (int part = 0; part < 2; ++part)
#pragma unroll
                for (int e = 0; e < 8; ++e) {
                    const float other = __shfl_xor(y[part][e], 4);
                    const int i = (sub & 3) * 8 + e;
                    const int pos = i < 16 ? cid : t, f = i & 15;
                    const float cs = ct[pos * 16 + f], sn = st[pos * 16 + f];
                    y[part][e] = sub < 4 ? y[part][e] * cs - other * sn : other * sn + y[part][e] * cs;
                }
        }
#pragma unroll
        for (int e = 0; e < 8; ++e) y[0][e] *= 0.125f;
        const u32x4 qv = pack8(y[0]), kv = pack8(y[1]), vv = pack8(y[2]);
        bf16_t* gq = WSP(bf16_t, WS_GQKV) + (size_t)(base + t) * 256 + h * 64 + sub * 8;
        *(u32x4*)gq = qv; *(u32x4*)(gq + (size_t)MTOK * 256) = kv; *(u32x4*)(gq + (size_t)2 * MTOK * 256) = vv;
        *(u32x4*)(Kf + t * LDP + sub * 8) = kv; *(u32x4*)(Vf + t * LDP + sub * 8) = vv;
        *(u32x4*)(Kr + (63 - t) * LDP + sub * 8) = kv; *(u32x4*)(Vr + (63 - t) * LDP + sub * 8) = vv;
    }
    if (c.wave < 2) { float beta; const float g = gdn_gates(c, l, h, c.wave, base, c.lane, beta); gl[c.wave * 64 + c.lane] = g; gl[128 + c.wave * 64 + c.lane] = beta; }
    __syncthreads();
    const int dir = c.wave >> 2, w4 = c.wave & 3;
    const bf16_t* Kp = dir ? Kr : Kf; const bf16_t* Vp = dir ? Vr : Vf;
    const float* gd = gl + dir * 64; const float* bd = gl + 128 + dir * 64;
    const int r16 = c.lane & 15, g4 = c.lane >> 4;
    {
        const int tt = w4;
        for (int st = 0; st <= tt; ++st) {
            const f32x4 a = mm16(Kp + tt * 16 * LDP, LDP, Kp + st * 16 * LDP, LDP, (f32x4){0.f, 0.f, 0.f, 0.f}, c.lane);
            const int s = 16 * st + r16;
#pragma unroll
            for (int e = 0; e < 4; ++e) { const int t = 16 * tt + 4 * g4 + e; Lm[dir * 4096 + t * 64 + s] = s < t ? bd[t] * a[e] * __expf(gd[t] - gd[s]) : 0.f; }
        }
    }
    __syncthreads();
    if (c.wave < 4) {
        const int sdir = c.wave >> 1, part = c.wave & 1, col = c.lane;
        const bf16_t* Sp = sdir ? (part ? Vr : Kr) : (part ? Vf : Kf);
        const float* sg = gl + sdir * 64; const float* sb = gl + 128 + sdir * 64; const float* Ls = Lm + sdir * 4096;
        float X[64];
#pragma unroll
        for (int t = 0; t < 64; ++t) { const float x = bf2f(Sp[t * LDP + col]); X[t] = part ? sb[t] * x : sb[t] * __expf(sg[t]) * x; }
#pragma unroll
        for (int t = 1; t < 64; ++t) { float a = X[t];
#pragma unroll
            for (int s4 = 0; s4 < (t + 3) / 4; ++s4) { const f32x4 lv = *(const f32x4*)(Ls + t * 64 + 4 * s4);
                a -= lv[0] * X[4 * s4]; a -= lv[1] * X[4 * s4 + 1]; a -= lv[2] * X[4 * s4 + 2]; a -= lv[3] * X[4 * s4 + 3]; }
            asm volatile("" : "+v"(a) :: "memory");
            X[t] = a; }
        const size_t idx = (size_t)(((b * 4 + h) * 2 + sdir) * NCH + cid);
        bf16_t* gdst = WSP(bf16_t, part ? WS_GU : WS_GW) + idx * 4096 + col;
        bf16_t* ldst = (part ? U0T : WT) + sdir * 64 * LDP + col * LDP;
#pragma unroll
        for (int t = 0; t < 64; t += 2) { const unsigned w = pk2(X[t], X[t + 1]); gdst[t * 64] = (bf16_t)(w & 0xffffu); gdst[(t + 1) * 64] = (bf16_t)(w >> 16); *(unsigned*)(ldst + t) = w; }
    } else {
        const int t2 = c.tid - 256;
        for (int i = t2; i < 8192; i += 256) { const int dd = i >> 12, d = (i >> 6) & 63, tau = i & 63;
            const bf16_t* Kq = dd ? Kr : Kf; const float* gq = gl + dd * 64;
            KdT[dd * 64 * LDP + d * LDP + tau] = (bf16_t)f2bf(bf2f(Kq[tau * LDP + d]) * __expf(gq[63] - gq[tau])); }
    }
    __syncthreads();
    {
        const size_t idx = (size_t)(((b * 4 + h) * 2 + dir) * NCH + cid);
        const int dt = w4; const float ge = __expf(gd[63]);
        bf16_t* Ag = WSP(bf16_t, WS_GA) + idx * 4096; float* Bg = WSP(float, WS_GB) + idx * 4096;
        const int d = 16 * dt + r16;
#pragma unroll
        for (int ct = 0; ct < 4; ++ct) {
            const f32x4 a = mm16(WT + dir * 64 * LDP + ct * 16 * LDP, LDP, KdT + dir * 64 * LDP + dt * 16 * LDP, LDP, (f32x4){0.f, 0.f, 0.f, 0.f}, c.lane);
            const int d1 = 16 * ct + 4 * g4; float o[4];
#pragma unroll
            for (int e = 0; e < 4; ++e) o[e] = ((d1 + e == d) ? ge : 0.f) - a[e];
            u32x2 w; w.x = pk2(o[0], o[1]); w.y = pk2(o[2], o[3]); *(u32x2*)(Ag + d * 64 + d1) = w;
        }
#pragma unroll
        for (int vt = 0; vt < 4; ++vt) {
            const f32x4 a = mm16(KdT + dir * 64 * LDP + dt * 16 * LDP, LDP, U0T + dir * 64 * LDP + vt * 16 * LDP, LDP, (f32x4){0.f, 0.f, 0.f, 0.f}, c.lane);
            *(f32x4*)(Bg + (16 * vt + r16) * 64 + 16 * dt + 4 * g4) = a;
        }
    }
    __syncthreads();
}

__device__ __forceinline__ void hgrn_fk(float z, float lb, float& logf, float& k) {
    logf = logsigmoidf_(z) + log1pf(lb * expf(-z));
    k = (1.f - lb) / (1.f + expf(z));
}
__device__ __forceinline__ float hgrn_lb(const Ctx& c, int l, int dir, int ch) {
    if (l == 0) return 0.f;
    const float r0 = INP(10)[dir * 2 * 256 + ch], r1 = INP(10)[dir * 2 * 256 + 256 + ch];
    return 1.f / (1.f + expf(r0 - r1));
}
__device__ __forceinline__ void m1_hgrn_item(const Ctx& c, int l, int b, int h, int cid) {
    float* LF = (float*)c.lds;
    float* KV = LF + 2 * 64 * 65;
    bf16_t* VT = (bf16_t*)(KV + 2 * 64 * 65);
    bf16_t* KtT = VT + 64 * LDP;
    const int base = chunk_row(b, cid);
    const bf16_t* P = WSP(bf16_t, WS_P);
    const int t = c.tid >> 3, sub = c.tid & 7;
    {
        const bf16_t* pr = P + (size_t)(base + t) * NP + h * 64 + sub * 8;
        float zf[8], zb[8], vv[8];
        unpack8(*(const u32x4*)(pr + C_HFF), zf); unpack8(*(const u32x4*)(pr + C_HFB), zb); unpack8(*(const u32x4*)(pr + C_HI), vv);
#pragma unroll
        for (int e = 0; e < 8; ++e) { const int d = sub * 8 + e; float lf, k;
            hgrn_fk(zf[e], hgrn_lb(c, l, 0, h * 64 + d), lf, k); LF[t * 65 + d] = lf; KV[t * 65 + d] = k;
            hgrn_fk(zb[e], hgrn_lb(c, l, 1, h * 64 + d), lf, k); LF[4160 + t * 65 + d] = lf; KV[4160 + t * 65 + d] = k;
            VT[d * LDP + t] = (bf16_t)f2bf(vv[e]); }
    }
    __syncthreads();
    if (c.tid < 128) { const int dir = c.tid >> 6, d = c.tid & 63; float* col = LF + dir * 4160 + d; float a = 0.f;
        if (dir == 0) { for (int i = 0; i < 64; ++i) { a += col[i * 65]; col[i * 65] = a; } }
        else { for (int i = 63; i >= 0; --i) { a += col[i * 65]; col[i * 65] = a; } }
        const size_t idx = (size_t)(((b * 4 + h) * 2 + dir) * NCH + cid);
        WSP(float, WS_HA)[idx * 64 + d] = expf(a); }
    __syncthreads();
#pragma unroll
    for (int dir = 0; dir < 2; ++dir)
#pragma unroll
        for (int e = 0; e < 8; ++e) { const int d = sub * 8 + e; const float be = LF[dir * 4160 + (dir ? 0 : 63) * 65 + d];
            KtT[dir * 64 * LDP + d * LDP + t] = (bf16_t)f2bf(KV[dir * 4160 + t * 65 + d] * __expf(be - LF[dir * 4160 + t * 65 + d])); }
    __syncthreads();
    {
        const int dir = c.wave >> 2, dt = c.wave & 3, r16 = c.lane & 15, g4 = c.lane >> 4;
        const size_t idx = (size_t)(((b * 4 + h) * 2 + dir) * NCH + cid);
        float* Bg = WSP(float, WS_HB) + idx * 4096;
#pragma unroll
        for (int vt = 0; vt < 4; ++vt) {
            const f32x4 a = mm16(KtT + dir * 64 * LDP + dt * 16 * LDP, LDP, VT + vt * 16 * LDP, LDP, (f32x4){0.f, 0.f, 0.f, 0.f}, c.lane);
            *(f32x4*)(Bg + (16 * vt + r16) * 64 + 16 * dt + 4 * g4) = a;
        }
    }
    __syncthreads();
}

__device__ __forceinline__ void m1_na_item(const Ctx& c, int l, int b, int cid, int h) {
    bf16_t* VTt = (bf16_t*)c.lds;
    const int base = chunk_row(b, cid), t = c.tid >> 3, sub = c.tid & 7;
    bf16_t* pr = WSP(bf16_t, WS_P) + (size_t)(base + t) * NP + h * 64 + sub * 8;
#pragma unroll
    for (int part = 0; part < 2; ++part) {
        float f[8]; unpack8(*(const u32x4*)(pr + (part ? C_NK : C_NQ)), f);
        float ss = 0.f;
#pragma unroll
        for (int e = 0; e < 8; ++e) ss += f[e] * f[e];
        ss += __shfl_xor(ss, 1); ss += __shfl_xor(ss, 2); ss += __shfl_xor(ss, 4);
        const float r = rsqrtf(ss * (1.f / 64.f) + EPS) * (part ? 1.f : 0.125f);
        const float* gw = INP(part ? 17 : 16) + l * 64 + sub * 8;
#pragma unroll
        for (int e = 0; e < 8; ++e) f[e] = f[e] * r * gw[e];
        *(u32x4*)(pr + (part ? C_NK : C_NQ)) = pack8(f);
    }
    {
        const u32x4 v = *(const u32x4*)(pr + C_NV);
#pragma unroll
        for (int i = 0; i < 4; ++i) { VTt[(sub * 8 + 2 * i) * LDP + t] = (bf16_t)(v[i] & 0xffffu); VTt[(sub * 8 + 2 * i + 1) * LDP + t] = (bf16_t)(v[i] >> 16); }
    }
    __syncthreads();
    {
        const int d = c.tid >> 3, s8 = c.tid & 7;
        const int tok = cid < 128 ? cid * 64 : SEQ + (cid - 128) * 64;
        *(u32x4*)(WSP(bf16_t, WS_VT) + ((size_t)(b * 8 + h) * 64 + d) * VT_LD + tok + s8 * 8) = *(const u32x4*)(VTt + d * LDP + s8 * 8);
    }
    __syncthreads();
}

constexpr int M1_GDN = NB * 4 * NCH, M1_HGRN = NB * 4 * NCH, M1_NA = NB * NCH * 8;
__device__ __forceinline__ void phase_m1(const Ctx& c, int l) {
    for (int it = c.bid; it < M1_GDN + M1_HGRN + M1_NA; it += c.G) {
#ifndef M1_SKIP_GDN
        if (it < M1_GDN) { const int b = it / (4 * NCH), h = (it / NCH) % 4, cid = it % NCH; m1_gdn_item(c, l, b, h, cid); } else
#endif
#ifndef M1_SKIP_HGRN
        if (it < M1_GDN + M1_HGRN) { const int j = it - M1_GDN; const int b = j / (4 * NCH), h = (j / NCH) % 4, cid = j % NCH; m1_hgrn_item(c, l, b, h, cid); } else
#endif
        { const int j = it - M1_GDN - M1_HGRN; const int b = j / (NCH * 8), cid = (j / 8) % NCH, h = j % 8; m1_na_item(c, l, b, cid, h); }
    }
}
__device__ __forceinline__ void m2_gdn_chain(const Ctx& c, int chain) {
    bf16_t* STl = (bf16_t*)c.lds;
    const int dir = chain & 1, vt = c.wave >> 1, dt0 = 2 * (c.wave & 1), r16 = c.lane & 15, g4 = c.lane >> 4;
    const bf16_t* Ag = WSP(bf16_t, WS_GA) + (size_t)chain * NCH * 4096;
    const float* Bg = WSP(float, WS_GB) + (size_t)chain * NCH * 4096;
    bf16_t* Sg = WSP(bf16_t, WS_GS) + (size_t)chain * NCH * 4096;
    f32x4 S[2]; S[0] = (f32x4){0.f, 0.f, 0.f, 0.f}; S[1] = S[0];
    bf16x8 af[3][2][2]; f32x4 bf[3][2];
#define G2_LOAD(set, step) do { const int cid_ = seq_cid(dir, (step)); \
        _Pragma("unroll") for (int q_ = 0; q_ < 2; ++q_) { \
            _Pragma("unroll") for (int kk_ = 0; kk_ < 2; ++kk_) af[set][q_][kk_] = *(const bf16x8*)(Ag + (size_t)cid_ * 4096 + (16 * (dt0 + q_) + r16) * 64 + kk_ * 32 + g4 * 8); \
            bf[set][q_] = *(const f32x4*)(Bg + (size_t)cid_ * 4096 + (16 * vt + r16) * 64 + 16 * (dt0 + q_) + 4 * g4); } } while (0)
#define G2_STEP(set, step) do { const int cid_ = seq_cid(dir, (step)); bf16_t* sb_ = STl + ((step) & 1) * 64 * LDP; \
        _Pragma("unroll") for (int q_ = 0; q_ < 2; ++q_) { u32x2 w_; w_.x = pk2(S[q_][0], S[q_][1]); w_.y = pk2(S[q_][2], S[q_][3]); \
            *(u32x2*)(sb_ + (16 * vt + r16) * LDP + 16 * (dt0 + q_) + 4 * g4) = w_; \
            *(u32x2*)(Sg + (size_t)cid_ * 4096 + (16 * vt + r16) * 64 + 16 * (dt0 + q_) + 4 * g4) = w_; } \
        if ((step) + 2 < NCH) G2_LOAD(((set) + 2) % 3, (step) + 2); \
        __syncthreads(); \
        const bf16x8 s0_ = *(const bf16x8*)(sb_ + (16 * vt + r16) * LDP + g4 * 8), s1_ = *(const bf16x8*)(sb_ + (16 * vt + r16) * LDP + 32 + g4 * 8); \
        _Pragma("unroll") for (int q_ = 0; q_ < 2; ++q_) { f32x4 a_ = bf[set][q_]; \
            a_ = __builtin_amdgcn_mfma_f32_16x16x32_bf16(af[set][q_][0], s0_, a_, 0, 0, 0); a_ = __builtin_amdgcn_mfma_f32_16x16x32_bf16(af[set][q_][1], s1_, a_, 0, 0, 0); S[q_] = a_; } } while (0)
    G2_LOAD(0, 0); G2_LOAD(1, 1);
    for (int step = 0; step < NCH; step += 3) { G2_STEP(0, step); G2_STEP(1, step + 1); G2_STEP(2, step + 2); }
#undef G2_LOAD
#undef G2_STEP
    __syncthreads();
}
__device__ __forceinline__ void m2_hgrn_scan(const Ctx& c, int blk) {
    const int gt = blk * 512 + c.tid, chain = gt >> 12, e = gt & 4095, d = e & 63, dir = chain & 1;
    float* Bg = WSP(float, WS_HB) + (size_t)chain * NCH * 4096 + e;
    const float* Ag = WSP(float, WS_HA) + (size_t)chain * NCH * 64 + d;
    float S = 0.f;
    for (int s0 = 0; s0 < NCH; s0 += 4) {
        float bv[4], av[4];
#pragma unroll
        for (int j = 0; j < 4; ++j) { const int cid = seq_cid(dir, s0 + j); bv[j] = Bg[(size_t)cid * 4096]; av[j] = Ag[cid * 64]; }
#pragma unroll
        for (int j = 0; j < 4; ++j) { const int cid = seq_cid(dir, s0 + j); Bg[(size_t)cid * 4096] = S; S = av[j] * S + bv[j]; }
    }
}

template <bool LOCAL>
__device__ __forceinline__ void na_wave_item(const Ctx& c, const float* rpb, int b, int h, int r, int m) {
    const int lane = c.lane, q16 = lane & 15, g4 = lane >> 4;
    const bf16_t* P = WSP(bf16_t, WS_P);
    const bf16_t* VT = WSP(bf16_t, WS_VT) + (size_t)(b * 8 + h) * 64 * VT_LD;
    const int qrow = LOCAL ? b * SEQ + r * 64 + 16 * m + q16 : NLAT + b * CTXL + 16 * m + q16;
    bf16x8 qf[2];
#pragma unroll
    for (int kk = 0; kk < 2; ++kk) qf[kk] = *(const bf16x8*)(P + (size_t)qrow * NP + C_NQ + h * 64 + kk * 32 + g4 * 8);
    constexpr int NSP = LOCAL ? 16 : 8;
    float sc[NSP][8];
    const int r0 = LOCAL ? min(max(r - 4, 0), 120) : 0;
    const int cs = m == 0 ? 0 : (m == 1 ? 8 : (m == 2 ? 24 : 32));
    const int jq = 16 * m + q16, c0 = min(max(jq - 8, 0), 48);
    const int kperm = 8 * (q16 >> 2) + (q16 & 3);
#pragma unroll
    for (int sp = 0; sp < NSP; ++sp) {
        if ((sp & 3) == 0) asm volatile("" ::: "memory");
        const bool loc = LOCAL && sp < 8;
        const int tok0 = loc ? (r0 + sp) * 64 + cs : SEQ + 32 * (LOCAL ? sp - 8 : sp);
#pragma unroll
        for (int tile = 0; tile < 2; ++tile) {
            const int kt = tok0 + kperm + 4 * tile;
            const int krow = kt < SEQ ? b * SEQ + kt : NLAT + b * CTXL + (kt - SEQ);
            f32x4 a = (f32x4){0.f, 0.f, 0.f, 0.f};
#pragma unroll
            for (int kk = 0; kk < 2; ++kk) { const bf16x8 kf = *(const bf16x8*)(P + (size_t)krow * NP + C_NK + h * 64 + kk * 32 + g4 * 8); a = __builtin_amdgcn_mfma_f32_16x16x32_bf16(kf, qf[kk], a, 0, 0, 0); }
#pragma unroll
            for (int e = 0; e < 4; ++e) {
                float v = a[e];
                if (loc) { const int kc = cs + 8 * g4 + 4 * tile + e, kr = r0 + sp;
                    const bool ok = kc >= c0 && kc < c0 + 16;
                    const int bi = (kr - r + 7) * 31 + min(max(kc - jq + 15, 0), 30);
                    v = ok ? v + rpb[h * 465 + bi] : -1.0e30f; }
                sc[sp][4 * tile + e] = v; }
        }
    }
    float mx = -1.0e30f;
#pragma unroll
    for (int sp = 0; sp < NSP; ++sp)
#pragma unroll
        for (int e = 0; e < 8; ++e) mx = fmaxf(mx, sc[sp][e]);
    mx = fmaxf(mx, __shfl_xor(mx, 16)); mx = fmaxf(mx, __shfl_xor(mx, 32));
    float sum = 0.f;
#pragma unroll
    for (int sp = 0; sp < NSP; ++sp)
#pragma unroll
        for (int e = 0; e < 8; ++e) { const float p = __expf(sc[sp][e] - mx); sc[sp][e] = p; sum += p; }
    sum += __shfl_xor(sum, 16); sum += __shfl_xor(sum, 32);
    f32x4 o[4];
#pragma unroll
    for (int dt = 0; dt < 4; ++dt) o[dt] = (f32x4){0.f, 0.f, 0.f, 0.f};
#pragma unroll
    for (int sp = 0; sp < NSP; ++sp) {
        if ((sp & 3) == 0) asm volatile("" ::: "memory");
        const bool loc = LOCAL && sp < 8;
        const int tok0 = loc ? (r0 + sp) * 64 + cs : SEQ + 32 * (LOCAL ? sp - 8 : sp);
        const u32x4 pw = pack8(sc[sp]); const bf16x8 pf = __builtin_bit_cast(bf16x8, pw);
#pragma unroll
        for (int dt = 0; dt < 4; ++dt) { const bf16x8 vf = *(const bf16x8*)(VT + (size_t)(16 * dt + q16) * VT_LD + tok0 + 8 * g4); o[dt] = __builtin_amdgcn_mfma_f32_16x16x32_bf16(vf, pf, o[dt], 0, 0, 0); }
    }
    const float inv = 1.f / sum;
    bf16_t* yr = WSP(bf16_t, WS_H) + (size_t)qrow * D + 512 + h * 64 + 4 * g4;
#pragma unroll
    for (int dt = 0; dt < 4; ++dt) { u32x2 w; w.x = pk2(o[dt][0] * inv, o[dt][1] * inv); w.y = pk2(o[dt][2] * inv, o[dt][3] * inv); *(u32x2*)(yr + 16 * dt) = w; }
}

__device__ __forceinline__ void phase_m2(const Ctx& c, int l) {
    if (c.bid < 16) m2_gdn_chain(c, c.bid);
    else if (c.bid < 144) m2_hgrn_scan(c, c.bid - 16);
    __syncthreads();
    float* rpb = (float*)c.lds;
    int* qslot = (int*)(c.lds + 16384);
    for (int i = c.tid; i < 8 * 465; i += 512) rpb[i] = INP(18)[(size_t)l * 8 * 465 + i];
    __syncthreads();
    const int n_lat = NB * 8 * 128 * 4 / 8, n_ctx = (l == 0) ? NB * 8 * 16 / 8 : 0;
    for (;;) {
        if (c.tid == 0) *qslot = (int)atomicAdd(WSP(unsigned, WS_CTL) + CW_NAQ + l, 1u);
        __syncthreads();
        const int qi = *qslot;
        __syncthreads();
        if (qi >= n_lat + n_ctx) break;
        if (qi < n_lat) { const int wi = qi * 8 + c.wave; const int m = wi & 3, r = (wi >> 2) & 127, h = (wi >> 9) & 7, b = wi >> 12; na_wave_item<true>(c, rpb, b, h, r, m); }
        else { const int wi = (qi - n_lat) * 8 + c.wave; const int m = wi & 15, h = (wi >> 4) & 7, b = wi >> 7; na_wave_item<false>(c, rpb, b, h, 0, m); }
    }
}
__device__ __forceinline__ void gated_norm_store(const Ctx& c, const float* OUT, const float* gw, int base, int gate_col, int ycol) {
    const int t = c.tid >> 3, sub = c.tid & 7;
    float o[8], gt[8]; float ss = 0.f;
#pragma unroll
    for (int e = 0; e < 8; ++e) { o[e] = OUT[t * 65 + sub * 8 + e]; ss += o[e] * o[e]; }
    ss += __shfl_xor(ss, 1); ss += __shfl_xor(ss, 2); ss += __shfl_xor(ss, 4);
    const float r = rsqrtf(ss * (1.f / 64.f) + EPS);
    unpack8(*(const u32x4*)(WSP(bf16_t, WS_P) + (size_t)(base + t) * NP + gate_col + sub * 8), gt);
#pragma unroll
    for (int e = 0; e < 8; ++e) o[e] = o[e] * r * gw[sub * 8 + e] * siluf_(gt[e]);
    *(u32x4*)(WSP(bf16_t, WS_H) + (size_t)(base + t) * D + ycol + sub * 8) = pack8(o);
}

__device__ __forceinline__ void m3_gdn_item(const Ctx& c, int l, int b, int h, int cid) {
    unsigned char* L0 = c.lds;
    bf16_t* Qf = (bf16_t*)L0; bf16_t* Kf = Qf + 64 * LDP; bf16_t* Qr = Kf + 64 * LDP; bf16_t* Kr = Qr + 64 * LDP;
    bf16_t* Wl = Kr + 64 * LDP;
    bf16_t* Ul = Wl + 2 * 64 * LDP;
    bf16_t* Sl = Ul + 2 * 64 * LDP;
    bf16_t* uT = Sl + 2 * 64 * LDP;
    bf16_t* QKm = uT + 2 * 64 * LDP;
    float* gl = (float*)(QKm + 2 * 64 * LDP);
    float* OUT = (float*)Wl;
    const int base = chunk_row(b, cid);
    {
        const int t = c.tid >> 3, sub = c.tid & 7;
        const bf16_t* gq = WSP(bf16_t, WS_GQKV) + (size_t)(base + t) * 256 + h * 64 + sub * 8;
        const u32x4 qv = *(const u32x4*)gq, kv = *(const u32x4*)(gq + (size_t)MTOK * 256);
        *(u32x4*)(Qf + t * LDP + sub * 8) = qv; *(u32x4*)(Kf + t * LDP + sub * 8) = kv;
        *(u32x4*)(Qr + (63 - t) * LDP + sub * 8) = qv; *(u32x4*)(Kr + (63 - t) * LDP + sub * 8) = kv;
#pragma unroll
        for (int dir = 0; dir < 2; ++dir) { const size_t idx = (size_t)(((b * 4 + h) * 2 + dir) * NCH + cid);
            *(u32x4*)(Wl + dir * 64 * LDP + t * LDP + sub * 8) = *(const u32x4*)(WSP(bf16_t, WS_GW) + idx * 4096 + t * 64 + sub * 8);
            *(u32x4*)(Ul + dir * 64 * LDP + t * LDP + sub * 8) = *(const u32x4*)(WSP(bf16_t, WS_GU) + idx * 4096 + t * 64 + sub * 8);
            *(u32x4*)(Sl + dir * 64 * LDP + t * LDP + sub * 8) = *(const u32x4*)(WSP(bf16_t, WS_GS) + idx * 4096 + t * 64 + sub * 8); }
        if (c.wave < 2) { float beta; const float g = gdn_gates(c, l, h, c.wave, base, c.lane, beta); gl[c.wave * 64 + c.lane] = g; }
    }
    __syncthreads();
    const int dir = c.wave >> 2, tt = c.wave & 3, r16 = c.lane & 15, g4 = c.lane >> 4;
    bf16_t* Qp = dir ? Qr : Qf; const bf16_t* Kp = dir ? Kr : Kf; const float* gd = gl + dir * 64;
    {
#pragma unroll
        for (int vt = 0; vt < 4; ++vt) {
            const f32x4 a = mm16(Wl + dir * 64 * LDP + tt * 16 * LDP, LDP, Sl + dir * 64 * LDP + vt * 16 * LDP, LDP, (f32x4){0.f, 0.f, 0.f, 0.f}, c.lane);
            float u[4];
#pragma unroll
            for (int e = 0; e < 4; ++e) u[e] = bf2f(Ul[dir * 64 * LDP + (16 * tt + 4 * g4 + e) * LDP + 16 * vt + r16]) - a[e];
            u32x2 w; w.x = pk2(u[0], u[1]); w.y = pk2(u[2], u[3]);
            *(u32x2*)(uT + dir * 64 * LDP + (16 * vt + r16) * LDP + 16 * tt + 4 * g4) = w;
        }
#pragma unroll
        for (int st = 0; st < 4; ++st) {
            f32x4 a = (f32x4){0.f, 0.f, 0.f, 0.f};
            if (st <= tt) a = mm16(Qp + tt * 16 * LDP, LDP, Kp + st * 16 * LDP, LDP, a, c.lane);
            const int s = 16 * st + r16;
#pragma unroll
            for (int e = 0; e < 4; ++e) { const int t = 16 * tt + 4 * g4 + e; const float v = (s <= t) ? a[e] * __expf(gd[t] - gd[s]) : 0.f; QKm[dir * 64 * LDP + t * LDP + s] = (bf16_t)f2bf(v); }
        }
    }
    __syncthreads();
    {
        const int t = c.tid >> 3, sub = c.tid & 7;
#pragma unroll
        for (int dd = 0; dd < 2; ++dd) { bf16_t* q = (dd ? Qr : Qf) + t * LDP + sub * 8; float f[8]; unpack8(*(const u32x4*)q, f); const float s = __expf(gl[dd * 64 + t]);
#pragma unroll
            for (int e = 0; e < 8; ++e) f[e] *= s;
            *(u32x4*)q = pack8(f); }
    }
    __syncthreads();
    f32x4 o[4];
#pragma unroll
    for (int vt = 0; vt < 4; ++vt) {
        f32x4 a = mm16(Qp + tt * 16 * LDP, LDP, Sl + dir * 64 * LDP + vt * 16 * LDP, LDP, (f32x4){0.f, 0.f, 0.f, 0.f}, c.lane);
        o[vt] = mm16(QKm + dir * 64 * LDP + tt * 16 * LDP, LDP, uT + dir * 64 * LDP + vt * 16 * LDP, LDP, a, c.lane);
    }
    __syncthreads();
    if (dir == 0) {
#pragma unroll
        for (int vt = 0; vt < 4; ++vt)
#pragma unroll
            for (int e = 0; e < 4; ++e) OUT[(16 * tt + 4 * g4 + e) * 65 + 16 * vt + r16] = o[vt][e];
    }
    __syncthreads();
    if (dir == 1) {
#pragma unroll
        for (int vt = 0; vt < 4; ++vt)
#pragma unroll
            for (int e = 0; e < 4; ++e) OUT[(63 - (16 * tt + 4 * g4 + e)) * 65 + 16 * vt + r16] += o[vt][e];
    }
    __syncthreads();
    gated_norm_store(c, OUT, INP(15) + l * 64, base, C_GG + h * 64, 256 + h * 64);
    __syncthreads();
}

__device__ __forceinline__ void m3_hgrn_item(const Ctx& c, int l, int b, int h, int cid) {
    unsigned char* L0 = c.lds;
    float* LF = (float*)L0;
    float* OUT = LF + 64 * 65;
    bf16_t* VT = (bf16_t*)(OUT + 64 * 65);
    bf16_t* Sl = VT + 64 * LDP;
    bf16_t* Qd = Sl + 64 * LDP; bf16_t* Kd = Qd + 64 * LDP; bf16_t* Ko = Kd + 64 * LDP; bf16_t* Qg = Ko + 64 * LDP;
    bf16_t* Qo = Qg + 64 * LDP;
    bf16_t* Am = Qo + 3 * 64 * LDP;
    const int base = chunk_row(b, cid);
    const bf16_t* P = WSP(bf16_t, WS_P);
    const int t = c.tid >> 3, sub = c.tid & 7, r16 = c.lane & 15, g4 = c.lane >> 4;
    for (int dir = 0; dir < 2; ++dir) {
        const int tok = dir ? 63 - t : t;
        float q[8], kk[8];
        {
            const bf16_t* pr = P + (size_t)(base + tok) * NP + h * 64 + sub * 8;
            float z[8], vv[8];
            unpack8(*(const u32x4*)(pr + (dir ? C_HFB : C_HFF)), z); unpack8(*(const u32x4*)(pr + C_HQ), q); unpack8(*(const u32x4*)(pr + C_HI), vv);
#pragma unroll
            for (int e = 0; e < 8; ++e) { const int d = sub * 8 + e; float lf; hgrn_fk(z[e], hgrn_lb(c, l, dir, h * 64 + d), lf, kk[e]); LF[t * 65 + d] = lf; VT[d * LDP + t] = (bf16_t)f2bf(vv[e]); }
            const size_t idx = (size_t)(((b * 4 + h) * 2 + dir) * NCH + cid);
            const float* sg = WSP(float, WS_HB) + idx * 4096 + t * 64 + sub * 8;
            float sf[8]; *(f32x4*)sf = *(const f32x4*)sg; *(f32x4*)(sf + 4) = *(const f32x4*)(sg + 4);
            *(u32x4*)(Sl + t * LDP + sub * 8) = pack8(sf);
            *(u32x4*)(Am + t * LDP + sub * 8) = (u32x4){0u, 0u, 0u, 0u};
        }
        __syncthreads();
        if (c.tid < 64) { float* col = LF + c.tid; float a = 0.f; for (int i = 0; i < 64; ++i) { a += col[i * 65]; col[i * 65] = a; } }
        __syncthreads();
        {
            const int i = t >> 4;
            float fd[8], fkd[8], fko[8], fg[8], fo[3][8];
#pragma unroll
            for (int e = 0; e < 8; ++e) { const int d = sub * 8 + e; const float bt = LF[t * 65 + d];
                const float refd = i > 0 ? LF[(16 * i - 1) * 65 + d] : 0.f;
                fd[e] = q[e] * __expf(bt - refd); fkd[e] = kk[e] * __expf(refd - bt);
                fko[e] = kk[e] * __expf(LF[(16 * i + 15) * 65 + d] - bt);
                fg[e] = q[e] * __expf(bt);
#pragma unroll
                for (int j = 0; j < 3; ++j) fo[j][e] = i > j ? q[e] * __expf(bt - LF[(16 * j + 15) * 65 + d]) : 0.f; }
            *(u32x4*)(Qd + t * LDP + sub * 8) = pack8(fd); *(u32x4*)(Kd + t * LDP + sub * 8) = pack8(fkd); *(u32x4*)(Ko + t * LDP + sub * 8) = pack8(fko); *(u32x4*)(Qg + t * LDP + sub * 8) = pack8(fg);
#pragma unroll
            for (int j = 0; j < 3; ++j) *(u32x4*)(Qo + j * 64 * LDP + t * LDP + sub * 8) = pack8(fo[j]);
        }
        __syncthreads();
        for (int ti = c.wave; ti < 10; ti += 8) {
            const int i = ti < 1 ? 0 : (ti < 3 ? 1 : (ti < 6 ? 2 : 3)), j = ti - (i * (i + 1)) / 2;
            f32x4 a;
            if (i == j) a = mm16(Qd + i * 16 * LDP, LDP, Kd + j * 16 * LDP, LDP, (f32x4){0.f, 0.f, 0.f, 0.f}, c.lane);
            else a = mm16(Qo + j * 64 * LDP + i * 16 * LDP, LDP, Ko + j * 16 * LDP, LDP, (f32x4){0.f, 0.f, 0.f, 0.f}, c.lane);
#pragma unroll
            for (int e = 0; e < 4; ++e) { const int tl = 4 * g4 + e; const float v = (i != j || r16 <= tl) ? a[e] : 0.f; Am[(16 * i + tl) * LDP + 16 * j + r16] = (bf16_t)f2bf(v); }
        }
        __syncthreads();
        {
            const int tt = c.wave >> 1;
#pragma unroll
            for (int q2 = 0; q2 < 2; ++q2) { const int vt = 2 * (c.wave & 1) + q2;
                f32x4 a = mm16(Am + tt * 16 * LDP, LDP, VT + vt * 16 * LDP, LDP, (f32x4){0.f, 0.f, 0.f, 0.f}, c.lane);
                a = mm16(Qg + tt * 16 * LDP, LDP, Sl + vt * 16 * LDP, LDP, a, c.lane);
#pragma unroll
                for (int e = 0; e < 4; ++e) { const int tau = 16 * tt + 4 * g4 + e; float* op = OUT + (dir ? 63 - tau : tau) * 65 + 16 * vt + r16; if (dir) *op += a[e]; else *op = a[e]; }
            }
        }
        __syncthreads();
    }
    gated_norm_store(c, OUT, INP(11) + l * 64, base, C_HG + h * 64, h * 64);
    __syncthreads();
}

__device__ __forceinline__ void phase_m3(const Ctx& c, int l) {
    const int ncid = l == 0 ? NCH : 128;
    const int n1 = NB * 4 * ncid;
    for (int it = c.bid; it < 2 * n1; it += c.G) {
        const int j = it % n1; const int b = j / (4 * ncid), h = (j / ncid) % 4, cid = j % ncid;
        if (it < n1) m3_gdn_item(c, l, b, h, cid); else m3_hgrn_item(c, l, b, h, cid);
    }
}
__device__ __forceinline__ void phase_moe_assign(const Ctx& c) {
    int* sh = (int*)c.lds;
    if (c.tid == 0) { int acc = 0; for (int e = 0; e < NEXP; ++e) { const int cnt = (int)WSP(unsigned, WS_CTL)[CW_CNT + e]; sh[e] = acc; acc += (cnt + 255) / 256 * 256; sh[8 + e] = acc; } }
    __syncthreads();
    if (c.bid == 0 && c.tid <= NSLOT_TILES) {
        if (c.tid == NSLOT_TILES) WSP(int, WS_TILEE)[NSLOT_TILES] = sh[15] / 256;
        else { int e = 0; while (e < NEXP - 1 && sh[8 + e] <= c.tid * 256) ++e; WSP(int, WS_TILEE)[c.tid] = e; }
    }
    if (c.wave == 0) {
        for (int ch = c.bid; ch < NLAT / 64; ch += c.G) {
            const int tok = ch * 64 + c.lane;
#pragma unroll
            for (int k = 0; k < 2; ++k) {
                const int e = WSP(int, WS_TOKE)[tok * 2 + k]; int slot = 0;
                for (int ee = 0; ee < NEXP; ++ee) {
                    const unsigned long long mask = __ballot(e == ee);
                    if (mask) { unsigned bs = 0; if (c.lane == 0) bs = atomicAdd(WSP(unsigned, WS_CTL) + CW_CUR + ee, (unsigned)__popcll(mask)); bs = __shfl(bs, 0);
                        if (e == ee) slot = sh[ee] + (int)bs + __popcll(mask & ((1ull << c.lane) - 1ull)); }
                }
                WSP(int, WS_TOKS)[tok * 2 + k] = slot; WSP(int, WS_SLOTTOK)[slot] = tok;
            }
        }
    }
    __syncthreads();
}
__device__ __forceinline__ void phase_moe_combine(const Ctx& c) {
    const float* mod = WSP(float, WS_MOD) + (size_t)1 * 3 * 6144 + 5120;
    const bf16_t* YP = WSP(bf16_t, WS_YP);
    for (int row = c.bid * 8 + c.wave; row < NLAT; row += c.G * 8) {
        const int s = row < SEQ ? 0 : 1;
        const int sa = WSP(int, WS_TOKS)[row * 2], sb = WSP(int, WS_TOKS)[row * 2 + 1];
        const float ga = WSP(float, WS_TOKG)[row * 2], gb = WSP(float, WS_TOKG)[row * 2 + 1];
        float* xr = c.p->out + (size_t)row * D;
#pragma unroll
        for (int j = 0; j < 2; ++j) { const int col = 8 * c.lane + 512 * j;
            float ya[8], yb[8]; unpack8(*(const u32x4*)(YP + (size_t)sa * D + col), ya); unpack8(*(const u32x4*)(YP + (size_t)sb * D + col), yb);
            f32x4 x0 = *(const f32x4*)(xr + col), x1 = *(const f32x4*)(xr + col + 4);
            const f32x4 g0 = *(const f32x4*)(mod + s * 6144 + col), g1 = *(const f32x4*)(mod + s * 6144 + col + 4);
#pragma unroll
            for (int e = 0; e < 4; ++e) { x0[e] += g0[e] * (ga * ya[e] + gb * yb[e]); x1[e] += g1[e] * (ga * ya[4 + e] + gb * yb[4 + e]); }
            *(f32x4*)(xr + col) = x0; *(f32x4*)(xr + col + 4) = x1; }
    }
}

__device__ __forceinline__ void phase_inproj(const Ctx& c, int l) {
    pg8::Gemm g{WSP(bf16_t, WS_H), WSP(bf16_t, WS_WIN) + (size_t)l * NP * D, D, MTOK / 256, NP / 256, nullptr, 0, nullptr, 0, 0};
    pg8::EpiBf16 E{WSP(bf16_t, WS_P), NP, 0};
    pg8::gemm_phase(( LAS unsigned char*)c.lds, g, E);
}
__device__ __forceinline__ void phase_outproj(const Ctx& c, int l) {
    pg8::Gemm g{WSP(bf16_t, WS_H), WSP(bf16_t, WS_WOUT) + (size_t)l * D * D, D, (l == 0 ? MTOK : NLAT) / 256, D / 256, nullptr, 0, nullptr, 0, 0};
    pg8::EpiResid E{l == 0 ? INP(0) : c.p->out, l == 0 ? INP(2) : WSP(float, WS_XC), c.p->out, WSP(float, WS_XC), WSP(float, WS_MOD) + (size_t)l * 3 * 6144 + 2048};
    pg8::gemm_phase((LAS unsigned char*)c.lds, g, E);
}
__device__ __forceinline__ void phase_ffn1(const Ctx& c) {
    pg8::Gemm g{WSP(bf16_t, WS_H), WSP(bf16_t, WS_W13), D, MTOK / 256, 7168 / 256, nullptr, 0, nullptr, 0, 0};
    pg8::EpiSwiGLU E{WSP(bf16_t, WS_P), DFF};
    pg8::gemm_phase((LAS unsigned char*)c.lds, g, E);
}
__device__ __forceinline__ void phase_ffn2(const Ctx& c) {
    pg8::Gemm g{WSP(bf16_t, WS_P), WSP(bf16_t, WS_W2), DFF, MTOK / 256, D / 256, nullptr, 0, nullptr, 0, 0};
    pg8::EpiResid E{c.p->out, WSP(float, WS_XC), c.p->out, WSP(float, WS_XC), WSP(float, WS_MOD) + 5120};
    pg8::gemm_phase((LAS unsigned char*)c.lds, g, E);
}
__device__ __forceinline__ void moe_half(const Ctx& c, int half, int& t0, int& nt) {
    const int ntiles = WSP(int, WS_TILEE)[NSLOT_TILES];
    t0 = half * HALF_TILES; const int t1 = half ? ntiles : (ntiles < HALF_TILES ? ntiles : HALF_TILES);
    nt = t1 > t0 ? t1 - t0 : 0;
}
__device__ __forceinline__ void phase_moe1(const Ctx& c, int half) {
    int t0, nt; moe_half(c, half, t0, nt);
    pg8::Gemm g{WSP(bf16_t, WS_H), WSP(bf16_t, WS_MOEW13), D, nt, 7168 / 256, WSP(int, WS_SLOTTOK), 0, WSP(int, WS_TILEE), t0, (size_t)7168 * D};
    pg8::EpiSwiGLU E{WSP(bf16_t, WS_P), DFF};
    pg8::gemm_phase((LAS unsigned char*)c.lds, g, E);
}
__device__ __forceinline__ void phase_moe2(const Ctx& c, int half) {
    int t0, nt; moe_half(c, half, t0, nt);
    pg8::Gemm g{WSP(bf16_t, WS_P), WSP(bf16_t, WS_MOEW2), DFF, nt, D / 256, nullptr, 0, WSP(int, WS_TILEE), t0, (size_t)D * DFF};
    pg8::EpiBf16 E{WSP(bf16_t, WS_YP), D, t0 * 256};
    pg8::gemm_phase((LAS unsigned char*)c.lds, g, E);
}

constexpr int N_PHASES = 23;
__device__ __forceinline__ void run_phase(const Ctx& c, int ph) {
    switch (ph) {
        case 0: phase_prologue(c); break;
        case 1: phase_norm(c, 0, 1); break;
        case 2: phase_inproj(c, 0); break;
        case 3: phase_m1(c, 0); break;
        case 4: phase_m2(c, 0); break;
        case 5: phase_m3(c, 0); break;
        case 6: phase_outproj(c, 0); break;
        case 7: phase_norm(c, 0, 2); break;
        case 8: phase_ffn1(c); break;
        case 9: phase_ffn2(c); break;
        case 10: phase_norm(c, 1, 1); break;
        case 11: phase_inproj(c, 1); break;
        case 12: phase_m1(c, 1); break;
        case 13: phase_m2(c, 1); break;
        case 14: phase_m3(c, 1); break;
        case 15: phase_outproj(c, 1); break;
        case 16: phase_norm(c, 1, 2); for (int it = c.bid; it < CI_MOE; it += c.G) cvt_moe_item(c, it); break;
        case 17: phase_moe_assign(c); break;
        case 18: phase_moe1(c, 0); break;
        case 19: phase_moe2(c, 0); break;
        case 20: phase_moe1(c, 1); break;
        case 21: phase_moe2(c, 1); break;
        case 22: phase_moe_combine(c); break;
        default: break;
    }
}

#ifndef MK_MEGA
#define MK_MEGA 0
#endif
__global__ void __launch_bounds__(512, 2) fwd_kernel(Params p) {
    extern __shared__ __attribute__((aligned(16))) unsigned char lds[];
    Ctx c; c.p = &p; c.lds = lds; c.ws = p.ws; c.tid = threadIdx.x; c.lane = c.tid & 63; c.wave = __builtin_amdgcn_readfirstlane(c.tid >> 6); c.bid = blockIdx.x; c.G = gridDim.x;
#if MK_MEGA
    cg::grid_group grid = cg::this_grid();
#endif
#if MK_MEGA
#define PH(k) if (p.ph_lo <= (k) && (k) < p.ph_hi) { run_phase(c, (k)); if ((k) + 1 < p.ph_hi) grid.sync(); }
#else
#define PH(k) if (p.ph_lo <= (k) && (k) < p.ph_hi) { run_phase(c, (k)); }
#endif
#ifdef ONLY_PHASE
    PH(ONLY_PHASE)
#else
    PH(0) PH(1) PH(2) PH(3) PH(4) PH(5) PH(6) PH(7) PH(8) PH(9) PH(10) PH(11) PH(12) PH(13) PH(14) PH(15) PH(16) PH(17) PH(18) PH(19) PH(20) PH(21) PH(22)
#endif
#undef PH
}

extern "C" void kernel_launch(void* const* d_in, const int* in_sizes, int n_in, void* d_out, int out_size, void* d_ws, size_t ws_size, hipStream_t stream) {
    static int grid = 0;
    if (grid == 0) {
        if (n_in != 27 || out_size != NLAT * D || ws_size < WS_END) { fprintf(stderr, "kernel_launch: unexpected sizes (n_in %d, out %d, ws %zu, need %zu)\n", n_in, out_size, ws_size, (size_t)WS_END); grid = -1; return; }
        int dev = 0, cus = 0, per_cu = 0;
        hipGetDevice(&dev); hipDeviceGetAttribute(&cus, hipDeviceAttributeMultiprocessorCount, dev);
        hipFuncSetAttribute((const void*)fwd_kernel, hipFuncAttributeMaxDynamicSharedMemorySize, LDS_BYTES);
        hipOccupancyMaxActiveBlocksPerMultiprocessor(&per_cu, (const void*)fwd_kernel, 512, LDS_BYTES);
        if (per_cu < 1) { fprintf(stderr, "kernel_launch: occupancy query says %d blocks/CU\n", per_cu); per_cu = 1; }
        grid = cus;
        (void)hipGetLastError();
    }
    if (grid < 0) return;
    hipMemsetAsync((char*)d_ws + WS_CTL, 0, CTL_BYTES, stream);
    Params p{};
    for (int i = 0; i < 27; ++i) p.in[i] = (const float*)d_in[i];
    p.out = (float*)d_out; p.ws = (unsigned char*)d_ws;
#if MK_MEGA
    p.ph_lo = 0; p.ph_hi = N_PHASES;
    void* args[] = {&p};
    hipError_t e = hipLaunchCooperativeKernel((const void*)fwd_kernel, dim3(grid), dim3(512), args, LDS_BYTES, stream);
    if (e != hipSuccess) fprintf(stderr, "cooperative launch failed: %s (grid %d)\n", hipGetErrorString(e), grid);
#else
    for (int ph = 0; ph < N_PHASES; ++ph) { p.ph_lo = ph; p.ph_hi = ph + 1; hipLaunchKernelGGL(fwd_kernel, dim3(grid), dim3(512), LDS_BYTES, stream, p); }
#endif
}
```

```cpp
#include <hip/hip_runtime.h>
#include <hip/hip_cooperative_groups.h>
#include <cstdio>
#include <cstdint>
namespace cg = cooperative_groups;

#define LAS __attribute__((address_space(3)))
typedef unsigned short bf16_t;
typedef short bf16x8 __attribute__((ext_vector_type(8)));
typedef float f32x4 __attribute__((ext_vector_type(4)));
typedef float f32x2 __attribute__((ext_vector_type(2)));
typedef unsigned u32x4 __attribute__((ext_vector_type(4)));
typedef unsigned u32x2 __attribute__((ext_vector_type(2)));

constexpr int D = 1024, NB = 2, SEQ = 8192, CTXL = 256, NLAT = NB * SEQ, NCTX = NB * CTXL, MTOK = NLAT + NCTX;
constexpr int NP = 3840;
constexpr int C_HQ = 0, C_HFF = 256, C_HFB = 512, C_HI = 768, C_HG = 1024, C_GQ = 1280, C_GK = 1536, C_GV = 1792, C_GG = 2048, C_NQ = 2304, C_NK = 2816, C_NV = 3328;
constexpr int DPROJ = 3856, DFF = 3584, NEXP = 8;
constexpr int NCH = 132;
constexpr int NSLOT_TILES = 136, NSLOTS = NSLOT_TILES * 256, HALF_TILES = 68;
constexpr int VT_LD = 8448;
constexpr float EPS = 1e-6f;

constexpr size_t KiB = 1024, MiB = 1024 * 1024;
constexpr size_t WS_CTL = 0, CTL_BYTES = 64 * KiB;
constexpr size_t WS_MOD = 64 * KiB;
constexpr size_t WS_ROPE = 256 * KiB;
constexpr size_t WS_WG = 320 * KiB;
constexpr size_t WS_WR = 448 * KiB;
constexpr size_t WS_TOKE = 512 * KiB, WS_TOKG = 640 * KiB, WS_TOKS = 768 * KiB, WS_SLOTTOK = 896 * KiB;
constexpr size_t WS_TILEE = 1040 * KiB;
constexpr size_t WS_GATES = 2 * MiB;
constexpr size_t WS_XC = 4 * MiB;
constexpr size_t WS_WIN = 6 * MiB;
constexpr size_t WS_WOUT = 21 * MiB;
constexpr size_t WS_W13 = 25 * MiB;
constexpr size_t WS_W2 = 39 * MiB;
constexpr size_t WS_H = 46 * MiB;
constexpr size_t WS_P = 80 * MiB;
constexpr size_t WS_SCR = 204 * MiB;
constexpr size_t NITEM = 16 * NCH;
constexpr size_t WS_GA = WS_SCR;
constexpr size_t WS_GB = WS_GA + NITEM * 8192;
constexpr size_t WS_GW = WS_GB + NITEM * 16384;
constexpr size_t WS_GU = WS_GW + NITEM * 8192;
constexpr size_t WS_GS = WS_GU + NITEM * 8192;
constexpr size_t WS_GQKV = WS_GS + NITEM * 8192;
constexpr size_t WS_HB = WS_GQKV + (size_t)3 * MTOK * 256 * 2;
constexpr size_t WS_HA = WS_HB + NITEM * 16384;
constexpr size_t WS_VT = WS_HA + NITEM * 256;
constexpr size_t WS_SCR_END = WS_VT + (size_t)NB * 8 * 64 * VT_LD * 2;
constexpr size_t WS_MOEW13 = WS_SCR;
constexpr size_t WS_MOEW2 = WS_MOEW13 + (size_t)8 * 7168 * 1024 * 2;
constexpr size_t WS_YP = 396 * MiB;
constexpr size_t WS_END = WS_YP + (size_t)NSLOTS * 1024 * 2;
static_assert(WS_SCR_END <= WS_YP && WS_MOEW2 + (size_t)8 * 1024 * 3584 * 2 <= WS_YP, "ws map");
static_assert(WS_P + (size_t)MTOK * NP * 2 <= WS_SCR && WS_H + (size_t)MTOK * D * 2 <= WS_P, "ws map");
constexpr int CW_CNT = 64, CW_CUR = 128, CW_NAQ = 192;

constexpr int LDS_BYTES = 147456;
constexpr int LDS_CTLOFF = 135168;

__device__ __forceinline__ float bf2f(unsigned short b) { return __uint_as_float((unsigned)b << 16); }
__device__ __forceinline__ unsigned f2bf(float f) { unsigned u = __float_as_uint(f); return (u + 0x7fffu + ((u >> 16) & 1u)) >> 16; }
__device__ __forceinline__ unsigned pk2(float lo, float hi) { return f2bf(lo) | (f2bf(hi) << 16); }
__device__ __forceinline__ void unpack8(const u32x4 v, float (&f)[8]) {
#pragma unroll
    for (int i = 0; i < 4; ++i) { f[2 * i] = __uint_as_float(v[i] << 16); f[2 * i + 1] = __uint_as_float(v[i] & 0xffff0000u); }
}
__device__ __forceinline__ u32x4 pack8(const float (&f)[8]) { u32x4 v; v.x = pk2(f[0], f[1]); v.y = pk2(f[2], f[3]); v.z = pk2(f[4], f[5]); v.w = pk2(f[6], f[7]); return v; }
__device__ __forceinline__ float wave_sum(float v) {
#pragma unroll
    for (int o = 1; o < 64; o <<= 1) v += __shfl_xor(v, o);
    return v;
}
__device__ __forceinline__ float sigmoidf_(float x) { return 1.f / (1.f + __expf(-x)); }
__device__ __forceinline__ float siluf_(float x) { return x / (1.f + __expf(-x)); }
__device__ __forceinline__ float softplusf_(float x) { return x > 20.f ? x : log1pf(expf(x)); }
__device__ __forceinline__ float logsigmoidf_(float z) { return fminf(z, 0.f) - log1pf(expf(-fabsf(z))); }
__device__ __forceinline__ int chunk_row(int b, int cid) { return cid < 128 ? b * SEQ + cid * 64 : NLAT + b * CTXL + (cid - 128) * 64; }
__device__ __forceinline__ int seq_cid(int dir, int step) { return dir == 0 ? (step < 4 ? 128 + step : step - 4) : (step < 4 ? 131 - step : 131 - step); }

__device__ __forceinline__ f32x4 mm16(const bf16_t* As, int lda, const bf16_t* Bs, int ldb, f32x4 acc, int lane) {
    const int r = lane & 15, g = lane >> 4;
#pragma unroll
    for (int kk = 0; kk < 2; ++kk) {
        const bf16x8 a = *(const bf16x8*)(As + r * lda + kk * 32 + g * 8);
        const bf16x8 b = *(const bf16x8*)(Bs + r * ldb + kk * 32 + g * 8);
        acc = __builtin_amdgcn_mfma_f32_16x16x32_bf16(a, b, acc, 0, 0, 0);
    }
    return acc;
}
constexpr int LDP = 72;

struct Params {
    const float* in[27];
    float* out;
    unsigned char* ws;
    int ph_lo, ph_hi;
};
namespace pg8 {
constexpr int BM = 256, BK = 64, HALF = 128, HTB = HALF * BK * 2, STAGE_BYTES = 8 * HTB, NXCD = 8, WGM = 8;
__host__ __device__ __forceinline__ int lds_byte(int r, int c) { const int st = (r >> 4) * 2 + (c >> 5), rr = r & 15, cc = c & 31, ob = rr * 64 + cc * 2; return st * 1024 + (ob ^ (((ob >> 9) & 1) << 5)); }
__host__ __device__ __forceinline__ void stage_rc(int b, int& R, int& C) { const int st = b / 1024, sb = b % 1024, swz = sb ^ (((sb >> 9) & 1) << 5); R = (st >> 1) * 16 + swz / 64; C = (st & 1) * 32 + (swz % 64) / 2; }
__host__ __device__ __forceinline__ int perm32(int rho) { const int n = rho >> 4, i = rho & 15; return 8 * (i >> 2) + 4 * n + (i & 3); }

struct Unit { int pm, pn; };
struct Gemm { const bf16_t* A; const bf16_t* Bt; int K, nM, nN; const int* rowmap; int arow0; const int* tile_e; int tile0; size_t estride; };

__device__ __forceinline__ bool next_unit(int nM, int nN, int G, int c, int i, Unit& u) {
    const int nwg = nM * nN; const long L = (long)i * G + c; if (L >= nwg) return false;
    int wgid = (int)L; { const int q = nwg / NXCD, r = nwg % NXCD, xcd = wgid % NXCD, off = wgid / NXCD; wgid = (xcd < r ? xcd * (q + 1) : r * (q + 1) + (xcd - r) * q) + off; }
    const int nig = WGM * nN, gid = wgid / nig, fm = gid * WGM, gsz = (nM - fm) < WGM ? (nM - fm) : WGM;
    u.pm = fm + ((wgid % nig) % gsz); u.pn = (wgid % nig) / gsz; return true;
}
__device__ __forceinline__ unsigned cvt_pk_bf16(float lo, float hi) { unsigned r; asm volatile("v_cvt_pk_bf16_f32 %0, %1, %2" : "=v"(r) : "v"(lo), "v"(hi)); return r; }

struct EpiBf16 {
    static constexpr bool PERM = true;
    bf16_t* O; int ldc; int row0;
    __device__ __forceinline__ void operator()(const f32x4 (&acc)[2][2][4][2], const Unit& u, int wr, int wc, int fr, int fq) const {
        const int rowb = row0 + u.pm * BM + wr * 64 + fr; const int col0 = u.pn * BM + wc * 32 + 8 * fq;
#pragma unroll
        for (int ai = 0; ai < 2; ++ai)
#pragma unroll
            for (int m = 0; m < 4; ++m) { bf16_t* rowp = O + (size_t)(rowb + ai * HALF + m * 16) * ldc + col0;
#pragma unroll
                for (int bj = 0; bj < 2; ++bj) { const f32x4 v0 = acc[ai][bj][m][0], v1 = acc[ai][bj][m][1];
                    u32x4 w; w.x = cvt_pk_bf16(v0[0], v0[1]); w.y = cvt_pk_bf16(v0[2], v0[3]); w.z = cvt_pk_bf16(v1[0], v1[1]); w.w = cvt_pk_bf16(v1[2], v1[3]);
                    *(u32x4*)(rowp + bj * HALF) = w; } }
    }
};
struct EpiSwiGLU {
    static constexpr bool PERM = true;
    bf16_t* O; int ldc;
    __device__ __forceinline__ void operator()(const f32x4 (&acc)[2][2][4][2], const Unit& u, int wr, int wc, int fr, int fq) const {
        const int rowb = u.pm * BM + wr * 64 + fr; const int col0 = (u.pn * BM + wc * 32 + 8 * fq) >> 1;
#pragma unroll
        for (int ai = 0; ai < 2; ++ai)
#pragma unroll
            for (int m = 0; m < 4; ++m) { bf16_t* rowp = O + (size_t)(rowb + ai * HALF + m * 16) * ldc + col0;
#pragma unroll
                for (int bj = 0; bj < 2; ++bj) { const f32x4 g = acc[ai][bj][m][0], v = acc[ai][bj][m][1];
                    float a[4];
#pragma unroll
                    for (int e = 0; e < 4; ++e) a[e] = g[e] / (1.f + __expf(-g[e])) * v[e];
                    u32x2 w; w.x = cvt_pk_bf16(a[0], a[1]); w.y = cvt_pk_bf16(a[2], a[3]);
                    *(u32x2*)(rowp + bj * (HALF / 2)) = w; } }
    }
};
struct EpiResid {
    static constexpr bool PERM = false;
    const float* base_lat; const float* base_ctx; float* out_lat; float* out_ctx; const float* gate;
    __device__ __forceinline__ void operator()(const f32x4 (&acc)[2][2][4][2], const Unit& u, int wr, int wc, int fr, int fq) const {
        const bool isctx = u.pm >= 64; const int s = isctx ? 2 : (u.pm >> 5);
        const float* bp = isctx ? base_ctx : base_lat; float* op = isctx ? out_ctx : out_lat;
        const int rowb = (isctx ? (u.pm - 64) : u.pm) * BM + wr * 64 + fr; const int col0 = u.pn * BM + wc * 32 + 4 * fq;
        f32x4 gv[2][2];
#pragma unroll
        for (int bj = 0; bj < 2; ++bj)
#pragma unroll
            for (int n = 0; n < 2; ++n) gv[bj][n] = *(const f32x4*)(gate + s * 6144 + col0 + bj * HALF + n * 16);
#pragma unroll
        for (int ai = 0; ai < 2; ++ai)
#pragma unroll
            for (int m = 0; m < 4; ++m) { const size_t off = (size_t)(rowb + ai * HALF + m * 16) * D + col0;
#pragma unroll
                for (int bj = 0; bj < 2; ++bj)
#pragma unroll
                    for (int n = 0; n < 2; ++n) { const f32x4 b = *(const f32x4*)(bp + off + bj * HALF + n * 16); *(f32x4*)(op + off + bj * HALF + n * 16) = b + gv[bj][n] * acc[ai][bj][m][n]; } }
    }
};

__device__ __forceinline__ void a_offsets(const Gemm& g, const Unit& u, int tid, unsigned (&o)[2][2]) {
#pragma unroll
    for (int h = 0; h < 2; ++h)
#pragma unroll
        for (int i = 0; i < 2; ++i) {
            int R, C; stage_rc(tid * 16 + i * 8192, R, C);
            const int lr = u.pm * BM + h * HALF + R;
            const int row = g.rowmap ? g.rowmap[g.tile0 * BM + lr] : g.arow0 + lr;
            o[h][i] = ((unsigned)row * (unsigned)g.K + (unsigned)C) * 2u;
        }
}
__device__ __forceinline__ const char* b_base(const Gemm& g, const Unit& u) {
    const size_t e = g.tile_e ? (size_t)g.tile_e[g.tile0 + u.pm] * g.estride : 0;
    return (const char*)(g.Bt + e + (size_t)u.pn * BM * g.K);
}

template <class Epi>
__device__ __forceinline__ void gemm_phase(LAS unsigned char* lds, const Gemm g, const Epi& E) {
    const int tid = threadIdx.x, wid = __builtin_amdgcn_readfirstlane(tid >> 6), lane = tid & 63, wr = wid >> 2, wc = wid & 3, fr = lane & 15, fq = lane >> 4;
    const int K = g.K, nt = K / BK, G = gridDim.x, cidx = blockIdx.x;
    unsigned voffB[2];
#pragma unroll
    for (int i = 0; i < 2; ++i) { int R, C; stage_rc(tid * 16 + i * 8192, R, C); const int Rb = Epi::PERM ? ((R & ~31) + perm32(R & 31)) : R; voffB[i] = (unsigned)(Rb * K + C) * 2u; }
    const size_t kstep = (size_t)(BK * 2);
    const size_t hstep = (size_t)HALF * K * 2;
    const unsigned ldsw = (unsigned)wid * 1024u;
    const int aoff = lds_byte(wr * 64 + fr, fq * 8), boff = lds_byte(wc * 32 + fr, fq * 8);
#define PG8_SA(b, h) (((b) * 2 + (h)) * HTB)
#define PG8_SB(b, h) ((4 + (b) * 2 + (h)) * HTB)
#define PG8_STAGE(bufoff, gbase, voff) do { _Pragma("unroll") for (int _i = 0; _i < 2; ++_i) \
        __builtin_amdgcn_global_load_lds((const unsigned*)((const char*)(gbase) + (voff)[_i]), (LAS unsigned*)(lds + (bufoff) + ldsw + _i * 8192), 16, 0, 0); } while (0)
#define PG8_LDA(dst, b, h) do { _Pragma("unroll") for (int m = 0; m < 4; ++m) _Pragma("unroll") for (int k = 0; k < 2; ++k) dst[m][k] = *(const LAS bf16x8*)(lds + PG8_SA(b, h) + aoff + m * 2048 + k * 1024); } while (0)
#define PG8_LDB(dst, b, h) do { _Pragma("unroll") for (int n = 0; n < 2; ++n) _Pragma("unroll") for (int k = 0; k < 2; ++k) dst[n][k] = *(const LAS bf16x8*)(lds + PG8_SB(b, h) + boff + n * 2048 + k * 1024); } while (0)
#define PG8_MMA(ai, bj, At, Bt) do { __builtin_amdgcn_s_setprio(1); _Pragma("unroll") for (int m = 0; m < 4; ++m) _Pragma("unroll") for (int n = 0; n < 2; ++n) _Pragma("unroll") for (int k = 0; k < 2; ++k) \
        acc[ai][bj][m][n] = __builtin_amdgcn_mfma_f32_16x16x32_bf16(Bt[n][k], At[m][k], acc[ai][bj][m][n], 0, 0, 0); __builtin_amdgcn_s_setprio(0); } while (0)
#define PG8_WAIT_V(n) asm volatile("s_waitcnt vmcnt(" #n ")" ::: "memory")
#define PG8_WAIT_L(n) asm volatile("s_waitcnt lgkmcnt(" #n ")" ::: "memory")
#define PG8_BAR __builtin_amdgcn_s_barrier()
#define PG8_SCHED __builtin_amdgcn_sched_barrier(0)
    Unit cur, nxt; int ui = 0;
    if (!next_unit(g.nM, g.nN, G, cidx, 0, cur)) return;
    f32x4 acc[2][2][4][2];
#pragma unroll
    for (int a = 0; a < 2; ++a)
#pragma unroll
        for (int b = 0; b < 2; ++b)
#pragma unroll
            for (int m = 0; m < 4; ++m)
#pragma unroll
                for (int n = 0; n < 2; ++n) acc[a][b][m][n] = (f32x4){0.f, 0.f, 0.f, 0.f};
    bf16x8 At[4][2], B0[2][2], B1[2][2];
    const char* const Ab = (const char*)g.A;
    unsigned oc[2][2];
    a_offsets(g, cur, tid, oc);
    const char* cB = b_base(g, cur);
    PG8_STAGE(PG8_SB(0, 0), cB, voffB); PG8_STAGE(PG8_SB(0, 1), cB + hstep, voffB); PG8_STAGE(PG8_SA(0, 0), Ab, oc[0]); PG8_STAGE(PG8_SA(0, 1), Ab, oc[1]);
    if (wr == 1) PG8_BAR;
    PG8_WAIT_V(2); PG8_BAR;
    PG8_STAGE(PG8_SB(1, 0), cB + kstep, voffB); PG8_STAGE(PG8_SA(1, 0), Ab + kstep, oc[0]); PG8_STAGE(PG8_SB(1, 1), cB + hstep + kstep, voffB);
    PG8_WAIT_V(6); PG8_BAR;
    for (;;) {
        bool has_next = false; const char* nB = cB;
        for (int t = 0; t < nt; t += 2) {
            const bool last = (t == nt - 2);
            const char* a1 = Ab + (size_t)(t + 1) * kstep;
            PG8_LDB(B0, 0, 0); PG8_LDB(B1, 0, 1); PG8_SCHED; PG8_LDA(At, 0, 0); PG8_STAGE(PG8_SA(1, 1), a1, oc[1]);
            PG8_WAIT_V(8); PG8_WAIT_L(0); PG8_BAR; PG8_MMA(0, 0, At, B0); PG8_MMA(0, 1, At, B1); PG8_BAR; PG8_SCHED;
            if (last) { has_next = next_unit(g.nM, g.nN, G, cidx, ui + 1, nxt); if (has_next) { a_offsets(g, nxt, tid, oc); nB = b_base(g, nxt); } }
            const char* a2 = last ? Ab : Ab + (size_t)(t + 2) * kstep; const char* b2 = last ? nB : cB + (size_t)(t + 2) * kstep;
            const char* a3 = a2 + kstep; const char* b3 = b2 + kstep;
            PG8_LDA(At, 0, 1); PG8_STAGE(PG8_SB(0, 0), b2, voffB); PG8_STAGE(PG8_SB(0, 1), b2 + hstep, voffB); PG8_STAGE(PG8_SA(0, 0), a2, oc[0]);
            PG8_WAIT_V(8); PG8_WAIT_L(0); PG8_BAR; PG8_MMA(1, 0, At, B0); PG8_MMA(1, 1, At, B1); PG8_BAR; PG8_SCHED;
            PG8_LDB(B0, 1, 0); PG8_LDB(B1, 1, 1); PG8_SCHED; PG8_LDA(At, 1, 0); PG8_STAGE(PG8_SA(0, 1), a2, oc[1]);
            PG8_WAIT_V(8); PG8_WAIT_L(0); PG8_BAR; PG8_MMA(0, 0, At, B0); PG8_MMA(0, 1, At, B1); PG8_BAR; PG8_SCHED;
            PG8_LDA(At, 1, 1); PG8_STAGE(PG8_SB(1, 0), b3, voffB); PG8_STAGE(PG8_SB(1, 1), b3 + hstep, voffB); PG8_STAGE(PG8_SA(1, 0), a3, oc[0]);
            PG8_WAIT_V(8); PG8_WAIT_L(0); PG8_BAR; PG8_MMA(1, 0, At, B0); PG8_MMA(1, 1, At, B1); PG8_BAR; PG8_SCHED;
        }
        if (wr == 0) PG8_BAR;
        E(acc, cur, wr, wc, fr, fq);
        if (!has_next) break;
#pragma unroll
        for (int a = 0; a < 2; ++a)
#pragma unroll
            for (int b = 0; b < 2; ++b)
#pragma unroll
                for (int m = 0; m < 4; ++m)
#pragma unroll
                    for (int n = 0; n < 2; ++n) acc[a][b][m][n] = (f32x4){0.f, 0.f, 0.f, 0.f};
        cur = nxt; cB = nB; ++ui;
        if (wr == 1) PG8_BAR;
    }
    PG8_WAIT_V(0);
    PG8_BAR;
#undef PG8_SA
#undef PG8_SB
#undef PG8_STAGE
#undef PG8_LDA
#undef PG8_LDB
#undef PG8_MMA
#undef PG8_WAIT_V
#undef PG8_WAIT_L
#undef PG8_BAR
#undef PG8_SCHED
}
}
struct Ctx {
    const Params* p;
    unsigned char* lds;
    unsigned char* ws;
    int tid, lane, wave, bid, G;
};
#define INP(i) (c.p->in[i])
#define WSP(T, off) ((T*)(c.ws + (off)))

__device__ __forceinline__ void cvt_item(const Ctx& c, const float* s0, const float* s1, int ldsrc, int mode, int k0, int n0, bf16_t* dst, int Kdst) {
    float* tile = (float*)c.lds;
#pragma unroll
    for (int i = 0; i < 8; ++i) {
        const int idx = c.tid + 512 * i, kk = idx >> 6, nn = idx & 63, n = n0 + nn;
        const float* sp = s0; int col = n; float sc = 1.f;
        if (mode == 0) { col = n + (n >= 2304 ? 16 : 0); sc = n < 256 ? 0.125f : 1.f; }
        else if (mode == 2) { const int q = n >> 3, e = n & 7; sp = e < 4 ? s0 : s1; col = 4 * q + (e & 3); }
        tile[kk * 65 + nn] = sp[(size_t)(k0 + kk) * ldsrc + col] * sc;
    }
    __syncthreads();
    {
        const int r = c.tid >> 3, ch = c.tid & 7; float f[8];
#pragma unroll
        for (int e = 0; e < 8; ++e) f[e] = tile[(8 * ch + e) * 65 + r];
        *(u32x4*)(dst + (size_t)(n0 + r) * Kdst + k0 + 8 * ch) = pack8(f);
    }
    __syncthreads();
}
constexpr int CI_WIN = 16 * 60, CI_WOUT = 16 * 16, CI_W13 = 16 * 112, CI_W2 = 56 * 16;
constexpr int CI_DENSE = 2 * CI_WIN + 2 * CI_WOUT + CI_W13 + CI_W2;
__device__ __forceinline__ void cvt_dense_item(const Ctx& c, int it) {
    if (it < 2 * CI_WIN) { const int l = it / CI_WIN, r = it % CI_WIN; cvt_item(c, INP(8) + (size_t)l * D * DPROJ, nullptr, DPROJ, 0, (r / 60) * 64, (r % 60) * 64, WSP(bf16_t, WS_WIN) + (size_t)l * NP * D, D); return; }
    it -= 2 * CI_WIN;
    if (it < 2 * CI_WOUT) { const int l = it / CI_WOUT, r = it % CI_WOUT; cvt_item(c, INP(9) + (size_t)l * D * D, nullptr, D, 1, (r / 16) * 64, (r % 16) * 64, WSP(bf16_t, WS_WOUT) + (size_t)l * D * D, D); return; }
    it -= 2 * CI_WOUT;
    if (it < CI_W13) { cvt_item(c, INP(19), INP(20), DFF, 2, (it / 112) * 64, (it % 112) * 64, WSP(bf16_t, WS_W13), D); return; }
    it -= CI_W13;
    cvt_item(c, INP(21), nullptr, D, 1, (it / 16) * 64, (it % 16) * 64, WSP(bf16_t, WS_W2), DFF);
}
constexpr int CI_MOE = 8 * (CI_W13 + CI_W2);
__device__ __forceinline__ void cvt_moe_item(const Ctx& c, int it) {
    const int e = it / (CI_W13 + CI_W2); int r = it % (CI_W13 + CI_W2);
    if (r < CI_W13) { cvt_item(c, INP(24) + (size_t)e * D * DFF, INP(25) + (size_t)e * D * DFF, DFF, 2, (r / 112) * 64, (r % 112) * 64, WSP(bf16_t, WS_MOEW13) + (size_t)e * 7168 * D, D); return; }
    r -= CI_W13;
    cvt_item(c, INP(26) + (size_t)e * DFF * D, nullptr, D, 1, (r / 16) * 64, (r % 16) * 64, WSP(bf16_t, WS_MOEW2) + (size_t)e * D * DFF, DFF);
}

__device__ __forceinline__ void phase_prologue(const Ctx& c) {
    {
        float* sv = (float*)c.lds;
        float* red = sv + 3 * 1024;
        for (int i = c.tid; i < 3 * 1024; i += 512) { const int s = i >> 10, k = i & 1023; const float x = s < 2 ? INP(1)[s * D + k] : INP(3)[k]; sv[i] = siluf_(x); }
        __syncthreads();
        for (int it = c.bid; it < 2 * 96; it += c.G) {
            const int l = it / 96, n0 = (it % 96) * 64, col = c.tid & 63, kg = c.tid >> 6;
            const float* w = INP(4) + (size_t)l * D * 6144 + n0 + col;
            float a0 = 0.f, a1 = 0.f, a2 = 0.f;
#pragma unroll 8
            for (int k = kg; k < D; k += 8) { const float wv = w[(size_t)k * 6144]; a0 += sv[k] * wv; a1 += sv[1024 + k] * wv; a2 += sv[2048 + k] * wv; }
            red[(kg * 3 + 0) * 64 + col] = a0; red[(kg * 3 + 1) * 64 + col] = a1; red[(kg * 3 + 2) * 64 + col] = a2;
            __syncthreads();
            if (c.tid < 192) { const int s = c.tid >> 6; float a = INP(5)[l * 6144 + n0 + col];
#pragma unroll
                for (int q = 0; q < 8; ++q) a += red[(q * 3 + s) * 64 + col];
                WSP(float, WS_MOD)[(l * 3 + s) * 6144 + n0 + col] = a; }
            __syncthreads();
        }
    }
    {
        const int gt = c.bid * 512 + c.tid, GT = c.G * 512;
        for (int i = gt; i < 2 * 16 * 1024; i += GT) { const int l = i >> 14, j = (i >> 10) & 15, k = i & 1023; WSP(float, WS_WG)[i] = INP(8)[(size_t)l * D * DPROJ + (size_t)k * DPROJ + 2304 + j]; }
        for (int i = gt; i < 8 * 1024; i += GT) { const int e = i >> 10, k = i & 1023; WSP(float, WS_WR)[i] = INP(22)[k * 8 + e]; }
        for (int i = gt; i < 128 * 16; i += GT) { const int pos = i >> 4, f = i & 15; const float inv = powf(10000.f, -(float)f / 16.f); const float ang = (float)pos * inv;
            WSP(float, WS_ROPE)[i] = cosf(ang); WSP(float, WS_ROPE)[2048 + i] = sinf(ang); }
        for (int i = gt; i < NSLOTS; i += GT) WSP(int, WS_SLOTTOK)[i] = 0;
    }
    __syncthreads();
    for (int it = c.bid; it < CI_DENSE; it += c.G) cvt_dense_item(c, it);
}

__device__ __forceinline__ void phase_norm(const Ctx& c, int l, int which) {
    const int nrows = (l == 1 && which == 2) ? NLAT : MTOK;
    const int NG = which == 1 ? 16 : (l == 1 ? 8 : 0);
    float* wl = (float*)c.lds;
    unsigned* hist = (unsigned*)(c.lds + 65536);
    if (NG) { const float* src = which == 1 ? WSP(float, WS_WG) + l * 16 * 1024 : WSP(float, WS_WR);
        for (int i = c.tid; i < NG * 1024; i += 512) wl[i] = src[i]; }
    if (c.tid < 8) hist[c.tid] = 0u;
    __syncthreads();
    const float* ng = INP(which == 1 ? 6 : 7) + l * D;
    const float* mod = WSP(float, WS_MOD) + (size_t)l * 3 * 6144;
    const bool from_input = (l == 0 && which == 1);
    bf16_t* H = WSP(bf16_t, WS_H);
    for (int row = c.bid * 8 + c.wave; row < nrows; row += c.G * 8) {
        const int s = row < SEQ ? 0 : (row < NLAT ? 1 : 2);
        const float* xr = row < NLAT ? (from_input ? INP(0) : c.p->out) + (size_t)row * D : (from_input ? INP(2) : WSP(float, WS_XC)) + (size_t)(row - NLAT) * D;
        f32x4 v[4]; float ss = 0.f;
#pragma unroll
        for (int j = 0; j < 4; ++j) { v[j] = *(const f32x4*)(xr + 4 * c.lane + 256 * j); ss += (v[j].x * v[j].x + v[j].y * v[j].y) + (v[j].z * v[j].z + v[j].w * v[j].w); }
        const float r = rsqrtf(wave_sum(ss) * (1.f / D) + EPS);
        const float* sh = mod + s * 6144 + (which == 1 ? 0 : 3072); const float* sc = sh + 1024;
#pragma unroll
        for (int j = 0; j < 4; ++j) { const int col = 4 * c.lane + 256 * j;
            const f32x4 g = *(const f32x4*)(ng + col), a = *(const f32x4*)(sc + col), b = *(const f32x4*)(sh + col);
            v[j] = (v[j] * r) * g * (a + 1.f) + b;
            u32x2 w; w.x = pk2(v[j].x, v[j].y); w.y = pk2(v[j].z, v[j].w);
            *(u32x2*)(H + (size_t)row * D + col) = w; }
        if (NG) {
            float mine = 0.f;
#pragma unroll 2
            for (int q = 0; q < NG; ++q) { float a = 0.f;
#pragma unroll
                for (int j = 0; j < 4; ++j) { const f32x4 w = *(const f32x4*)(wl + q * 1024 + 4 * c.lane + 256 * j); a += (v[j].x * w.x + v[j].y * w.y) + (v[j].z * w.z + v[j].w * w.w); }
                a = wave_sum(a); if (c.lane == q) mine = a; }
            if (NG == 16) { if (c.lane < 16) WSP(float, WS_GATES)[(size_t)row * 16 + c.lane] = mine; }
            else {
            float lg[8];
#pragma unroll
            for (int q = 0; q < 8; ++q) lg[q] = __shfl(mine, q) + INP(23)[q];
            int e0 = 0; float m0 = lg[0];
#pragma unroll
            for (int q = 1; q < 8; ++q) if (lg[q] > m0) { m0 = lg[q]; e0 = q; }
            int e1 = -1; float m1 = -3.0e38f;
#pragma unroll
            for (int q = 0; q < 8; ++q) if (q != e0 && lg[q] > m1) { m1 = lg[q]; e1 = q; }
            const float g0 = 1.f / (1.f + expf(m1 - m0)), g1 = 1.f - g0;
            if (c.lane == 0) { WSP(int, WS_TOKE)[row * 2] = e0; WSP(int, WS_TOKE)[row * 2 + 1] = e1; WSP(float, WS_TOKG)[row * 2] = g0; WSP(float, WS_TOKG)[row * 2 + 1] = g1;
                atomicAdd(&hist[e0], 1u); atomicAdd(&hist[e1], 1u); }
            }
        }
    }
    __syncthreads();
    if (NG == 8 && c.tid < 8) atomicAdd(WSP(unsigned, WS_CTL) + CW_CNT + c.tid, hist[c.tid]);
    __syncthreads();
}
__device__ __forceinline__ float gdn_gates(const Ctx& c, int l, int h, int dir, int base, int tau, float& beta) {
    const int tok = dir ? 63 - tau : tau;
    const float* gr = WSP(float, WS_GATES) + (size_t)(base + tok) * 16;
    const float a = gr[dir * 4 + h], bb = gr[8 + dir * 4 + h];
    const float la = -expf(INP(13)[l * 8 + dir * 4 + h]) * softplusf_(a + INP(14)[l * 8 + dir * 4 + h]);
    beta = 1.f / (1.f + expf(-bb));
    float g = la;
#pragma unroll
    for (int o = 1; o < 64; o <<= 1) { const float t = __shfl_up(g, o); if (tau >= o) g += t; }
    return g;
}

__device__ __forceinline__ void m1_gdn_item(const Ctx& c, int l, int b, int h, int cid) {
    unsigned char* L0 = c.lds;
    float* raw = (float*)L0;
    float* Lm = (float*)L0;
    bf16_t* WT = (bf16_t*)(L0 + 32768);
    float* cw = (float*)(L0 + 53248);
    float* gl = (float*)(L0 + 57344);
    bf16_t* Kf = (bf16_t*)(L0 + 58368);
    bf16_t* Vf = Kf + 64 * LDP; bf16_t* Kr = Vf + 64 * LDP; bf16_t* Vr = Kr + 64 * LDP;
    bf16_t* KdT = (bf16_t*)(L0 + 95232);
    bf16_t* U0T = (bf16_t*)(L0 + 113664);
    const int base = chunk_row(b, cid), t0 = cid < 128 ? cid * 64 : (cid - 128) * 64, slen = cid < 128 ? SEQ : CTXL;
    const bf16_t* P = WSP(bf16_t, WS_P);
    for (int idx = c.tid; idx < 68 * 24; idx += 512) {
        const int rr = idx / 24, ch = idx % 24, part = ch >> 3, c8 = ch & 7, tt = t0 + rr - 2;
        float f[8];
        if (tt >= 0 && tt < slen) { const u32x4 v = *(const u32x4*)(P + (size_t)(base + rr - 2) * NP + C_GQ + part * 256 + h * 64 + c8 * 8); unpack8(v, f); }
        else {
#pragma unroll
            for (int e = 0; e < 8; ++e) f[e] = 0.f; }
#pragma unroll
        for (int e = 0; e < 8; ++e) raw[rr * 193 + part * 64 + c8 * 8 + e] = f[e];
    }
    for (int i = c.tid; i < 5 * 192; i += 512) { const int k = i / 192, j = i % 192, part = j >> 6, d = j & 63; cw[i] = INP(12)[(size_t)l * 5 * 768 + k * 768 + part * 256 + h * 64 + d]; }
    __syncthreads();
    {
        const int t = c.tid >> 3, sub = c.tid & 7;
        float y[3][8];
#pragma unroll
        for (int part = 0; part < 3; ++part)
#pragma unroll
            for (int e = 0; e < 8; ++e) { const int j = part * 64 + sub * 8 + e; float a = 0.f;
#pragma unroll
                for (int k = 0; k < 5; ++k) a += cw[k * 192 + j] * raw[(t + k) * 193 + j];
                y[part][e] = siluf_(a); }
#pragma unroll
        for (int part = 0; part < 2; ++part) { float ss = 0.f;
#pragma unroll
            for (int e = 0; e < 8; ++e) ss += y[part][e] * y[part][e];
            ss += __shfl_xor(ss, 1); ss += __shfl_xor(ss, 2); ss += __shfl_xor(ss, 4);
            const float r = rsqrtf(ss + EPS);
#pragma unroll
            for (int e = 0; e < 8; ++e) y[part][e] *= r; }
        if (cid < 128) {
            const float* ct = WSP(float, WS_ROPE); const float* st = ct + 2048;
#pragma unroll
            for (int part = 0; part < 2; ++part)
#pragma unroll
                for (int e = 0; e < 8; ++e) {
                    const float other = __shfl_xor(y[part][e], 4);
                    const int i = (sub & 3) * 8 + e;
                    const int pos = i < 16 ? cid : t, f = i & 15;
                    const float cs = ct[pos * 16 + f], sn = st[pos * 16 + f];
                    y[part][e] = sub < 4 ? y[part][e] * cs - other * sn : other * sn + y[part][e] * cs;
                }
        }
#pragma unroll
        for (int e = 0; e < 8; ++e) y[0][e] *= 0.125f;
        const u32x4 qv = pack8(y[0]), kv = pack8(y[1]), vv = pack8(y[2]);
        bf16_t* gq = WSP(bf16_t, WS_GQKV) + (size_t)(base + t) * 256 + h * 64 + sub * 8;
        *(u32x4*)gq = qv; *(u32x4*)(gq + (size_t)MTOK * 256) = kv; *(u32x4*)(gq + (size_t)2 * MTOK * 256) = vv;
        *(u32x4*)(Kf + t * LDP + sub * 8) = kv; *(u32x4*)(Vf + t * LDP + sub * 8) = vv;
        *(u32x4*)(Kr + (63 - t) * LDP + sub * 8) = kv; *(u32x4*)(Vr + (63 - t) * LDP + sub * 8) = vv;
    }
    if (c.wave < 2) { float beta; const float g = gdn_gates(c, l, h, c.wave, base, c.lane, beta); gl[c.wave * 64 + c.lane] = g; gl[128 + c.wave * 64 + c.lane] = beta; }
    __syncthreads();
    const int dir = c.wave >> 2, w4 = c.wave & 3;
    const bf16_t* Kp = dir ? Kr : Kf; const bf16_t* Vp = dir ? Vr : Vf;
    const float* gd = gl + dir * 64; const float* bd = gl + 128 + dir * 64;
    const int r16 = c.lane & 15, g4 = c.lane >> 4;
    {
        const int tt = w4;
        for (int st = 0; st <= tt; ++st) {
            const f32x4 a = mm16(Kp + tt * 16 * LDP, LDP, Kp + st * 16 * LDP, LDP, (f32x4){0.f, 0.f, 0.f, 0.f}, c.lane);
            const int s = 16 * st + r16;
#pragma unroll
            for (int e = 0; e < 4; ++e) { const int t = 16 * tt + 4 * g4 + e; Lm[dir * 4096 + t * 64 + s] = s < t ? bd[t] * a[e] * __expf(gd[t] - gd[s]) : 0.f; }
        }
    }
    __syncthreads();
    if (c.wave < 4) {
        const int sdir = c.wave >> 1, part = c.wave & 1, col = c.lane;
        const bf16_t* Sp = sdir ? (part ? Vr : Kr) : (part ? Vf : Kf);
        const float* sg = gl + sdir * 64; const float* sb = gl + 128 + sdir * 64; const float* Ls = Lm + sdir * 4096;
        float X[64];
#pragma unroll
        for (int t = 0; t < 64; ++t) { const float x = bf2f(Sp[t * LDP + col]); X[t] = part ? sb[t] * x : sb[t] * __expf(sg[t]) * x; }
#pragma unroll
        for (int t = 1; t < 64; ++t) { float a = X[t];
#pragma unroll
            for (int s4 = 0; s4 < (t + 3) / 4; ++s4) { const f32x4 lv = *(const f32x4*)(Ls + t * 64 + 4 * s4);
                a -= lv[0] * X[4 * s4]; a -= lv[1] * X[4 * s4 + 1]; a -= lv[2] * X[4 * s4 + 2]; a -= lv[3] * X[4 * s4 + 3]; }
            asm volatile("" : "+v"(a) :: "memory");
            X[t] = a; }
        const size_t idx = (size_t)(((b * 4 + h) * 2 + sdir) * NCH + cid);
        bf16_t* gdst = WSP(bf16_t, part ? WS_GU : WS_GW) + idx * 4096 + col;
        bf16_t* ldst = (part ? U0T : WT) + sdir * 64 * LDP + col * LDP;
#pragma unroll
        for (int t = 0; t < 64; t += 2) { const unsigned w = pk2(X[t], X[t + 1]); gdst[t * 64] = (bf16_t)(w & 0xffffu); gdst[(t + 1) * 64] = (bf16_t)(w >> 16); *(unsigned*)(ldst + t) = w; }
    } else {
        const int t2 = c.tid - 256;
        for (int i = t2; i < 8192; i += 256) { const int dd = i >> 12, d = (i >> 6) & 63, tau = i & 63;
            const bf16_t* Kq = dd ? Kr : Kf; const float* gq = gl + dd * 64;
            KdT[dd * 64 * LDP + d * LDP + tau] = (bf16_t)f2bf(bf2f(Kq[tau * LDP + d]) * __expf(gq[63] - gq[tau])); }
    }
    __syncthreads();
    {
        const size_t idx = (size_t)(((b * 4 + h) * 2 + dir) * NCH + cid);
        const int dt = w4; const float ge = __expf(gd[63]);
        bf16_t* Ag = WSP(bf16_t, WS_GA) + idx * 4096; float* Bg = WSP(float, WS_GB) + idx * 4096;
        const int d = 16 * dt + r16;
#pragma unroll
        for (int ct = 0; ct < 4; ++ct) {
            const f32x4 a = mm16(WT + dir * 64 * LDP + ct * 16 * LDP, LDP, KdT + dir * 64 * LDP + dt * 16 * LDP, LDP, (f32x4){0.f, 0.f, 0.f, 0.f}, c.lane);
            const int d1 = 16 * ct + 4 * g4; float o[4];
#pragma unroll
            for (int e = 0; e < 4; ++e) o[e] = ((d1 + e == d) ? ge : 0.f) - a[e];
            u32x2 w; w.x = pk2(o[0], o[1]); w.y = pk2(o[2], o[3]); *(u32x2*)(Ag + d * 64 + d1) = w;
        }
#pragma unroll
        for (int vt = 0; vt < 4; ++vt) {
            const f32x4 a = mm16(KdT + dir * 64 * LDP + dt * 16 * LDP, LDP, U0T + dir * 64 * LDP + vt * 16 * LDP, LDP, (f32x4){0.f, 0.f, 0.f, 0.f}, c.lane);
            *(f32x4*)(Bg + (16 * vt + r16) * 64 + 16 * dt + 4 * g4) = a;
        }
    }
    __syncthreads();
}

__device__ __forceinline__ void hgrn_fk(float z, float lb, float& logf, float& k) {
    logf = logsigmoidf_(z) + log1pf(lb * expf(-z));
    k = (1.f - lb) / (1.f + expf(z));
}
__device__ __forceinline__ float hgrn_lb(const Ctx& c, int l, int dir, int ch) {
    if (l == 0) return 0.f;
    const float r0 = INP(10)[dir * 2 * 256 + ch], r1 = INP(10)[dir * 2 * 256 + 256 + ch];
    return 1.f / (1.f + expf(r0 - r1));
}
__device__ __forceinline__ void m1_hgrn_item(const Ctx& c, int l, int b, int h, int cid) {
    float* LF = (float*)c.lds;
    float* KV = LF + 2 * 64 * 65;
    bf16_t* VT = (bf16_t*)(KV + 2 * 64 * 65);
    bf16_t* KtT = VT + 64 * LDP;
    const int base = chunk_row(b, cid);
    const bf16_t* P = WSP(bf16_t, WS_P);
    const int t = c.tid >> 3, sub = c.tid & 7;
    {
        const bf16_t* pr = P + (size_t)(base + t) * NP + h * 64 + sub * 8;
        float zf[8], zb[8], vv[8];
        unpack8(*(const u32x4*)(pr + C_HFF), zf); unpack8(*(const u32x4*)(pr + C_HFB), zb); unpack8(*(const u32x4*)(pr + C_HI), vv);
#pragma unroll
        for (int e = 0; e < 8; ++e) { const int d = sub * 8 + e; float lf, k;
            hgrn_fk(zf[e], hgrn_lb(c, l, 0, h * 64 + d), lf, k); LF[t * 65 + d] = lf; KV[t * 65 + d] = k;
            hgrn_fk(zb[e], hgrn_lb(c, l, 1, h * 64 + d), lf, k); LF[4160 + t * 65 + d] = lf; KV[4160 + t * 65 + d] = k;
            VT[d * LDP + t] = (bf16_t)f2bf(vv[e]); }
    }
    __syncthreads();
    if (c.tid < 128) { const int dir = c.tid >> 6, d = c.tid & 63; float* col = LF + dir * 4160 + d; float a = 0.f;
        if (dir == 0) { for (int i = 0; i < 64; ++i) { a += col[i * 65]; col[i * 65] = a; } }
        else { for (int i = 63; i >= 0; --i) { a += col[i * 65]; col[i * 65] = a; } }
        const size_t idx = (size_t)(((b * 4 + h) * 2 + dir) * NCH + cid);
        WSP(float, WS_HA)[idx * 64 + d] = expf(a); }
    __syncthreads();
#pragma unroll
    for (int dir = 0; dir < 2; ++dir)
#pragma unroll
        for (int e = 0; e < 8; ++e) { const int d = sub * 8 + e; const float be = LF[dir * 4160 + (dir ? 0 : 63) * 65 + d];
            KtT[dir * 64 * LDP + d * LDP + t] = (bf16_t)f2bf(KV[dir * 4160 + t * 65 + d] * __expf(be - LF[dir * 4160 + t * 65 + d])); }
    __syncthreads();
    {
        const int dir = c.wave >> 2, dt = c.wave & 3, r16 = c.lane & 15, g4 = c.lane >> 4;
        const size_t idx = (size_t)(((b * 4 + h) * 2 + dir) * NCH + cid);
        float* Bg = WSP(float, WS_HB) + idx * 4096;
#pragma unroll
        for (int vt = 0; vt < 4; ++vt) {
            const f32x4 a = mm16(KtT + dir * 64 * LDP + dt * 16 * LDP, LDP, VT + vt * 16 * LDP, LDP, (f32x4){0.f, 0.f, 0.f, 0.f}, c.lane);
            *(f32x4*)(Bg + (16 * vt + r16) * 64 + 16 * dt + 4 * g4) = a;
        }
    }
    __syncthreads();
}

__device__ __forceinline__ void m1_na_item(const Ctx& c, int l, int b, int cid, int h) {
    bf16_t* VTt = (bf16_t*)c.lds;
    const int base = chunk_row(b, cid), t = c.tid >> 3, sub = c.tid & 7;
    bf16_t* pr = WSP(bf16_t, WS_P) + (size_t)(base + t) * NP + h * 64 + sub * 8;
#pragma unroll
    for (int part = 0; part < 2; ++part) {
        float f[8]; unpack8(*(const u32x4*)(pr + (part ? C_NK : C_NQ)), f);
        float ss = 0.f;
#pragma unroll
        for (int e = 0; e < 8; ++e) ss += f[e] * f[e];
        ss += __shfl_xor(ss, 1); ss += __shfl_xor(ss, 2); ss += __shfl_xor(ss, 4);
        const float r = rsqrtf(ss * (1.f / 64.f) + EPS) * (part ? 1.f : 0.125f);
        const float* gw = INP(part ? 17 : 16) + l * 64 + sub * 8;
#pragma unroll
        for (int e = 0; e < 8; ++e) f[e] = f[e] * r * gw[e];
        *(u32x4*)(pr + (part ? C_NK : C_NQ)) = pack8(f);
    }
    {
        const u32x4 v = *(const u32x4*)(pr + C_NV);
#pragma unroll
        for (int i = 0; i < 4; ++i) { VTt[(sub * 8 + 2 * i) * LDP + t] = (bf16_t)(v[i] & 0xffffu); VTt[(sub * 8 + 2 * i + 1) * LDP + t] = (bf16_t)(v[i] >> 16); }
    }
    __syncthreads();
    {
        const int d = c.tid >> 3, s8 = c.tid & 7;
        const int tok = cid < 128 ? cid * 64 : SEQ + (cid - 128) * 64;
        *(u32x4*)(WSP(bf16_t, WS_VT) + ((size_t)(b * 8 + h) * 64 + d) * VT_LD + tok + s8 * 8) = *(const u32x4*)(VTt + d * LDP + s8 * 8);
    }
    __syncthreads();
}

constexpr int M1_GDN = NB * 4 * NCH, M1_HGRN = NB * 4 * NCH, M1_NA = NB * NCH * 8;
__device__ __forceinline__ void phase_m1(const Ctx& c, int l) {
    for (int it = c.bid; it < M1_GDN + M1_HGRN + M1_NA; it += c.G) {
#ifndef M1_SKIP_GDN
        if (it < M1_GDN) { const int b = it / (4 * NCH), h = (it / NCH) % 4, cid = it % NCH; m1_gdn_item(c, l, b, h, cid); } else
#endif
#ifndef M1_SKIP_HGRN
        if (it < M1_GDN + M1_HGRN) { const int j = it - M1_GDN; const int b = j / (4 * NCH), h = (j / NCH) % 4, cid = j % NCH; m1_hgrn_item(c, l, b, h, cid); } else
#endif
        { const int j = it - M1_GDN - M1_HGRN; const int b = j / (NCH * 8), cid = (j / 8) % NCH, h = j % 8; m1_na_item(c, l, b, cid, h); }
    }
}
__device__ __forceinline__ void m2_gdn_chain(const Ctx& c, int chain) {
    bf16_t* STl = (bf16_t*)c.lds;
    const int dir = chain & 1, vt = c.wave >> 1, dt0 = 2 * (c.wave & 1), r16 = c.lane & 15, g4 = c.lane >> 4;
    const bf16_t* Ag = WSP(bf16_t, WS_GA) + (size_t)chain * NCH * 4096;
    const float* Bg = WSP(float, WS_GB) + (size_t)chain * NCH * 4096;
    bf16_t* Sg = WSP(bf16_t, WS_GS) + (size_t)chain * NCH * 4096;
    f32x4 S[2]; S[0] = (f32x4){0.f, 0.f, 0.f, 0.f}; S[1] = S[0];
    bf16x8 af[3][2][2]; f32x4 bf[3][2];
#define G2_LOAD(set, step) do { const int cid_ = seq_cid(dir, (step)); \
        _Pragma("unroll") for (int q_ = 0; q_ < 2; ++q_) { \
            _Pragma("unroll") for (int kk_ = 0; kk_ < 2; ++kk_) af[set][q_][kk_] = *(const bf16x8*)(Ag + (size_t)cid_ * 4096 + (16 * (dt0 + q_) + r16) * 64 + kk_ * 32 + g4 * 8); \
            bf[set][q_] = *(const f32x4*)(Bg + (size_t)cid_ * 4096 + (16 * vt + r16) * 64 + 16 * (dt0 + q_) + 4 * g4); } } while (0)
#define G2_STEP(set, step) do { const int cid_ = seq_cid(dir, (step)); bf16_t* sb_ = STl + ((step) & 1) * 64 * LDP; \
        _Pragma("unroll") for (int q_ = 0; q_ < 2; ++q_) { u32x2 w_; w_.x = pk2(S[q_][0], S[q_][1]); w_.y = pk2(S[q_][2], S[q_][3]); \
            *(u32x2*)(sb_ + (16 * vt + r16) * LDP + 16 * (dt0 + q_) + 4 * g4) = w_; \
            *(u32x2*)(Sg + (size_t)cid_ * 4096 + (16 * vt + r16) * 64 + 16 * (dt0 + q_) + 4 * g4) = w_; } \
        if ((step) + 2 < NCH) G2_LOAD(((set) + 2) % 3, (step) + 2); \
        __syncthreads(); \
        const bf16x8 s0_ = *(const bf16x8*)(sb_ + (16 * vt + r16) * LDP + g4 * 8), s1_ = *(const bf16x8*)(sb_ + (16 * vt + r16) * LDP + 32 + g4 * 8); \
        _Pragma("unroll") for (int q_ = 0; q_ < 2; ++q_) { f32x4 a_ = bf[set][q_]; \
            a_ = __builtin_amdgcn_mfma_f32_16x16x32_bf16(af[set][q_][0], s0_, a_, 0, 0, 0); a_ = __builtin_amdgcn_mfma_f32_16x16x32_bf16(af[set][q_][1], s1_, a_, 0, 0, 0); S[q_] = a_; } } while (0)
    G2_LOAD(0, 0); G2_LOAD(1, 1);
    for (int step = 0; step < NCH; step += 3) { G2_STEP(0, step); G2_STEP(1, step + 1); G2_STEP(2, step + 2); }
#undef G2_LOAD
#undef G2_STEP
    __syncthreads();
}
__device__ __forceinline__ void m2_hgrn_scan(const Ctx& c, int blk) {
    const int gt = blk * 512 + c.tid, chain = gt >> 12, e = gt & 4095, d = e & 63, dir = chain & 1;
    float* Bg = WSP(float, WS_HB) + (size_t)chain * NCH * 4096 + e;
    const float* Ag = WSP(float, WS_HA) + (size_t)chain * NCH * 64 + d;
    float S = 0.f;
    for (int s0 = 0; s0 < NCH; s0 += 4) {
        float bv[4], av[4];
#pragma unroll
        for (int j = 0; j < 4; ++j) { const int cid = seq_cid(dir, s0 + j); bv[j] = Bg[(size_t)cid * 4096]; av[j] = Ag[cid * 64]; }
#pragma unroll
        for (int j = 0; j < 4; ++j) { const int cid = seq_cid(dir, s0 + j); Bg[(size_t)cid * 4096] = S; S = av[j] * S + bv[j]; }
    }
}

template <bool LOCAL>
__device__ __forceinline__ void na_wave_item(const Ctx& c, const float* rpb, int b, int h, int r, int m) {
    const int lane = c.lane, q16 = lane & 15, g4 = lane >> 4;
    const bf16_t* P = WSP(bf16_t, WS_P);
    const bf16_t* VT = WSP(bf16_t, WS_VT) + (size_t)(b * 8 + h) * 64 * VT_LD;
    const int qrow = LOCAL ? b * SEQ + r * 64 + 16 * m + q16 : NLAT + b * CTXL + 16 * m + q16;
    bf16x8 qf[2];
#pragma unroll
    for (int kk = 0; kk < 2; ++kk) qf[kk] = *(const bf16x8*)(P + (size_t)qrow * NP + C_NQ + h * 64 + kk * 32 + g4 * 8);
    constexpr int NSP = LOCAL ? 16 : 8;
    float sc[NSP][8];
    const int r0 = LOCAL ? min(max(r - 4, 0), 120) : 0;
    const int cs = m == 0 ? 0 : (m == 1 ? 8 : (m == 2 ? 24 : 32));
    const int jq = 16 * m + q16, c0 = min(max(jq - 8, 0), 48);
    const int kperm = 8 * (q16 >> 2) + (q16 & 3);
#pragma unroll
    for (int sp = 0; sp < NSP; ++sp) {
        if ((sp & 3) == 0) asm volatile("" ::: "memory");
        const bool loc = LOCAL && sp < 8;
        const int tok0 = loc ? (r0 + sp) * 64 + cs : SEQ + 32 * (LOCAL ? sp - 8 : sp);
#pragma unroll
        for (int tile = 0; tile < 2; ++tile) {
            const int kt = tok0 + kperm + 4 * tile;
            const int krow = kt < SEQ ? b * SEQ + kt : NLAT + b * CTXL + (kt - SEQ);
            f32x4 a = (f32x4){0.f, 0.f, 0.f, 0.f};
#pragma unroll
            for (int kk = 0; kk < 2; ++kk) { const bf16x8 kf = *(const bf16x8*)(P + (size_t)krow * NP + C_NK + h * 64 + kk * 32 + g4 * 8); a = __builtin_amdgcn_mfma_f32_16x16x32_bf16(kf, qf[kk], a, 0, 0, 0); }
#pragma unroll
            for (int e = 0; e < 4; ++e) {
                float v = a[e];
                if (loc) { const int kc = cs + 8 * g4 + 4 * tile + e, kr = r0 + sp;
                    const bool ok = kc >= c0 && kc < c0 + 16;
                    const int bi = (kr - r + 7) * 31 + min(max(kc - jq + 15, 0), 30);
                    v = ok ? v + rpb[h * 465 + bi] : -1.0e30f; }
                sc[sp][4 * tile + e] = v; }
        }
    }
    float mx = -1.0e30f;
#pragma unroll
    for (int sp = 0; sp < NSP; ++sp)
#pragma unroll
        for (int e = 0; e < 8; ++e) mx = fmaxf(mx, sc[sp][e]);
    mx = fmaxf(mx, __shfl_xor(mx, 16)); mx = fmaxf(mx, __shfl_xor(mx, 32));
    float sum = 0.f;
#pragma unroll
    for (int sp = 0; sp < NSP; ++sp)
#pragma unroll
        for (int e = 0; e < 8; ++e) { const float p = __expf(sc[sp][e] - mx); sc[sp][e] = p; sum += p; }
    sum += __shfl_xor(sum, 16); sum += __shfl_xor(sum, 32);
    f32x4 o[4];
#pragma unroll
    for (int dt = 0; dt < 4; ++dt) o[dt] = (f32x4){0.f, 0.f, 0.f, 0.f};
#pragma unroll
    for (int sp = 0; sp < NSP; ++sp) {
        if ((sp & 3) == 0) asm volatile("" ::: "memory");
        const bool loc = LOCAL && sp < 8;
        const int tok0 = loc ? (r0 + sp) * 64 + cs : SEQ + 32 * (LOCAL ? sp - 8 : sp);
        const u32x4 pw = pack8(sc[sp]); const bf16x8 pf = __builtin_bit_cast(bf16x8, pw);
#pragma unroll
        for (int dt = 0; dt < 4; ++dt) { const bf16x8 vf = *(const bf16x8*)(VT + (size_t)(16 * dt + q16) * VT_LD + tok0 + 8 * g4); o[dt] = __builtin_amdgcn_mfma_f32_16x16x32_bf16(vf, pf, o[dt], 0, 0, 0); }
    }
    const float inv = 1.f / sum;
    bf16_t* yr = WSP(bf16_t, WS_H) + (size_t)qrow * D + 512 + h * 64 + 4 * g4;
#pragma unroll
    for (int dt = 0; dt < 4; ++dt) { u32x2 w; w.x = pk2(o[dt][0] * inv, o[dt][1] * inv); w.y = pk2(o[dt][2] * inv, o[dt][3] * inv); *(u32x2*)(yr + 16 * dt) = w; }
}

__device__ __forceinline__ void phase_m2(const Ctx& c, int l) {
    if (c.bid < 16) m2_gdn_chain(c, c.bid);
    else if (c.bid < 144) m2_hgrn_scan(c, c.bid - 16);
    __syncthreads();
    float* rpb = (float*)c.lds;
    int* qslot = (int*)(c.lds + 16384);
    for (int i = c.tid; i < 8 * 465; i += 512) rpb[i] = INP(18)[(size_t)l * 8 * 465 + i];
    __syncthreads();
    const int n_lat = NB * 8 * 128 * 4 / 8, n_ctx = (l == 0) ? NB * 8 * 16 / 8 : 0;
    for (;;) {
        if (c.tid == 0) *qslot = (int)atomicAdd(WSP(unsigned, WS_CTL) + CW_NAQ + l, 1u);
        __syncthreads();
        const int qi = *qslot;
        __syncthreads();
        if (qi >= n_lat + n_ctx) break;
        if (qi < n_lat) { const int wi = qi * 8 + c.wave; const int m = wi & 3, r = (wi >> 2) & 127, h = (wi >> 9) & 7, b = wi >> 12; na_wave_item<true>(c, rpb, b, h, r, m); }
        else { const int wi = (qi - n_lat) * 8 + c.wave; const int m = wi & 15, h = (wi >> 4) & 7, b = wi >> 7; na_wave_item<false>(c, rpb, b, h, 0, m); }
    }
}
__device__ __forceinline__ void gated_norm_store(const Ctx& c, const float* OUT, const float* gw, int base, int gate_col, int ycol) {
    const int t = c.tid >> 3, sub = c.tid & 7;
    float o[8], gt[8]; float ss = 0.f;
#pragma unroll
    for (int e = 0; e < 8; ++e) { o[e] = OUT[t * 65 + sub * 8 + e]; ss += o[e] * o[e]; }
    ss += __shfl_xor(ss, 1); ss += __shfl_xor(ss, 2); ss += __shfl_xor(ss, 4);
    const float r = rsqrtf(ss * (1.f / 64.f) + EPS);
    unpack8(*(const u32x4*)(WSP(bf16_t, WS_P) + (size_t)(base + t) * NP + gate_col + sub * 8), gt);
#pragma unroll
    for (int e = 0; e < 8; ++e) o[e] = o[e] * r * gw[sub * 8 + e] * siluf_(gt[e]);
    *(u32x4*)(WSP(bf16_t, WS_H) + (size_t)(base + t) * D + ycol + sub * 8) = pack8(o);
}

__device__ __forceinline__ void m3_gdn_item(const Ctx& c, int l, int b, int h, int cid) {
    unsigned char* L0 = c.lds;
    bf16_t* Qf = (bf16_t*)L0; bf16_t* Kf = Qf + 64 * LDP; bf16_t* Qr = Kf + 64 * LDP; bf16_t* Kr = Qr + 64 * LDP;
    bf16_t* Wl = Kr + 64 * LDP;
    bf16_t* Ul = Wl + 2 * 64 * LDP;
    bf16_t* Sl = Ul + 2 * 64 * LDP;
    bf16_t* uT = Sl + 2 * 64 * LDP;
    bf16_t* QKm = uT + 2 * 64 * LDP;
    float* gl = (float*)(QKm + 2 * 64 * LDP);
    float* OUT = (float*)Wl;
    const int base = chunk_row(b, cid);
    {
        const int t = c.tid >> 3, sub = c.tid & 7;
        const bf16_t* gq = WSP(bf16_t, WS_GQKV) + (size_t)(base + t) * 256 + h * 64 + sub * 8;
        const u32x4 qv = *(const u32x4*)gq, kv = *(const u32x4*)(gq + (size_t)MTOK * 256);
        *(u32x4*)(Qf + t * LDP + sub * 8) = qv; *(u32x4*)(Kf + t * LDP + sub * 8) = kv;
        *(u32x4*)(Qr + (63 - t) * LDP + sub * 8) = qv; *(u32x4*)(Kr + (63 - t) * LDP + sub * 8) = kv;
#pragma unroll
        for (int dir = 0; dir < 2; ++dir) { const size_t idx = (size_t)(((b * 4 + h) * 2 + dir) * NCH + cid);
            *(u32x4*)(Wl + dir * 64 * LDP + t * LDP + sub * 8) = *(const u32x4*)(WSP(bf16_t, WS_GW) + idx * 4096 + t * 64 + sub * 8);
            *(u32x4*)(Ul + dir * 64 * LDP + t * LDP + sub * 8) = *(const u32x4*)(WSP(bf16_t, WS_GU) + idx * 4096 + t * 64 + sub * 8);
            *(u32x4*)(Sl + dir * 64 * LDP + t * LDP + sub * 8) = *(const u32x4*)(WSP(bf16_t, WS_GS) + idx * 4096 + t * 64 + sub * 8); }
        if (c.wave < 2) { float beta; const float g = gdn_gates(c, l, h, c.wave, base, c.lane, beta); gl[c.wave * 64 + c.lane] = g; }
    }
    __syncthreads();
    const int dir = c.wave >> 2, tt = c.wave & 3, r16 = c.lane & 15, g4 = c.lane >> 4;
    bf16_t* Qp = dir ? Qr : Qf; const bf16_t* Kp = dir ? Kr : Kf; const float* gd = gl + dir * 64;
    {
#pragma unroll
        for (int vt = 0; vt < 4; ++vt) {
            const f32x4 a = mm16(Wl + dir * 64 * LDP + tt * 16 * LDP, LDP, Sl + dir * 64 * LDP + vt * 16 * LDP, LDP, (f32x4){0.f, 0.f, 0.f, 0.f}, c.lane);
            float u[4];
#pragma unroll
            for (int e = 0; e < 4; ++e) u[e] = bf2f(Ul[dir * 64 * LDP + (16 * tt + 4 * g4 + e) * LDP + 16 * vt + r16]) - a[e];
            u32x2 w; w.x = pk2(u[0], u[1]); w.y = pk2(u[2], u[3]);
            *(u32x2*)(uT + dir * 64 * LDP + (16 * vt + r16) * LDP + 16 * tt + 4 * g4) = w;
        }
#pragma unroll
        for (int st = 0; st < 4; ++st) {
            f32x4 a = (f32x4){0.f, 0.f, 0.f, 0.f};
            if (st <= tt) a = mm16(Qp + tt * 16 * LDP, LDP, Kp + st * 16 * LDP, LDP, a, c.lane);
            const int s = 16 * st + r16;
#pragma unroll
            for (int e = 0; e < 4; ++e) { const int t = 16 * tt + 4 * g4 + e; const float v = (s <= t) ? a[e] * __expf(gd[t] - gd[s]) : 0.f; QKm[dir * 64 * LDP + t * LDP + s] = (bf16_t)f2bf(v); }
        }
    }
    __syncthreads();
    {
        const int t = c.tid >> 3, sub = c.tid & 7;
#pragma unroll
        for (int dd = 0; dd < 2; ++dd) { bf16_t* q = (dd ? Qr : Qf) + t * LDP + sub * 8; float f[8]; unpack8(*(const u32x4*)q, f); const float s = __expf(gl[dd * 64 + t]);
#pragma unroll
            for (int e = 0; e < 8; ++e) f[e] *= s;
            *(u32x4*)q = pack8(f); }
    }
    __syncthreads();
    f32x4 o[4];
#pragma unroll
    for (int vt = 0; vt < 4; ++vt) {
        f32x4 a = mm16(Qp + tt * 16 * LDP, LDP, Sl + dir * 64 * LDP + vt * 16 * LDP, LDP, (f32x4){0.f, 0.f, 0.f, 0.f}, c.lane);
        o[vt] = mm16(QKm + dir * 64 * LDP + tt * 16 * LDP, LDP, uT + dir * 64 * LDP + vt * 16 * LDP, LDP, a, c.lane);
    }
    __syncthreads();
    if (dir == 0) {
#pragma unroll
        for (int vt = 0; vt < 4; ++vt)
#pragma unroll
            for (int e = 0; e < 4; ++e) OUT[(16 * tt + 4 * g4 + e) * 65 + 16 * vt + r16] = o[vt][e];
    }
    __syncthreads();
    if (dir == 1) {
#pragma unroll
        for (int vt = 0; vt < 4; ++vt)
#pragma unroll
            for (int e = 0; e < 4; ++e) OUT[(63 - (16 * tt + 4 * g4 + e)) * 65 + 16 * vt + r16] += o[vt][e];
    }
    __syncthreads();
    gated_norm_store(c, OUT, INP(15) + l * 64, base, C_GG + h * 64, 256 + h * 64);
    __syncthreads();
}

__device__ __forceinline__ void m3_hgrn_item(const Ctx& c, int l, int b, int h, int cid) {
    unsigned char* L0 = c.lds;
    float* LF = (float*)L0;
    float* OUT = LF + 64 * 65;
    bf16_t* VT = (bf16_t*)(OUT + 64 * 65);
    bf16_t* Sl = VT + 64 * LDP;
    bf16_t* Qd = Sl + 64 * LDP; bf16_t* Kd = Qd + 64 * LDP; bf16_t* Ko = Kd + 64 * LDP; bf16_t* Qg = Ko + 64 * LDP;
    bf16_t* Qo = Qg + 64 * LDP;
    bf16_t* Am = Qo + 3 * 64 * LDP;
    const int base = chunk_row(b, cid);
    const bf16_t* P = WSP(bf16_t, WS_P);
    const int t = c.tid >> 3, sub = c.tid & 7, r16 = c.lane & 15, g4 = c.lane >> 4;
    for (int dir = 0; dir < 2; ++dir) {
        const int tok = dir ? 63 - t : t;
        float q[8], kk[8];
        {
            const bf16_t* pr = P + (size_t)(base + tok) * NP + h * 64 + sub * 8;
            float z[8], vv[8];
            unpack8(*(const u32x4*)(pr + (dir ? C_HFB : C_HFF)), z); unpack8(*(const u32x4*)(pr + C_HQ), q); unpack8(*(const u32x4*)(pr + C_HI), vv);
#pragma unroll
            for (int e = 0; e < 8; ++e) { const int d = sub * 8 + e; float lf; hgrn_fk(z[e], hgrn_lb(c, l, dir, h * 64 + d), lf, kk[e]); LF[t * 65 + d] = lf; VT[d * LDP + t] = (bf16_t)f2bf(vv[e]); }
            const size_t idx = (size_t)(((b * 4 + h) * 2 + dir) * NCH + cid);
            const float* sg = WSP(float, WS_HB) + idx * 4096 + t * 64 + sub * 8;
            float sf[8]; *(f32x4*)sf = *(const f32x4*)sg; *(f32x4*)(sf + 4) = *(const f32x4*)(sg + 4);
            *(u32x4*)(Sl + t * LDP + sub * 8) = pack8(sf);
            *(u32x4*)(Am + t * LDP + sub * 8) = (u32x4){0u, 0u, 0u, 0u};
        }
        __syncthreads();
        if (c.tid < 64) { float* col = LF + c.tid; float a = 0.f; for (int i = 0; i < 64; ++i) { a += col[i * 65]; col[i * 65] = a; } }
        __syncthreads();
        {
            const int i = t >> 4;
            float fd[8], fkd[8], fko[8], fg[8], fo[3][8];
#pragma unroll
            for (int e = 0; e < 8; ++e) { const int d = sub * 8 + e; const float bt = LF[t * 65 + d];
                const float refd = i > 0 ? LF[(16 * i - 1) * 65 + d] : 0.f;
                fd[e] = q[e] * __expf(bt - refd); fkd[e] = kk[e] * __expf(refd - bt);
                fko[e] = kk[e] * __expf(LF[(16 * i + 15) * 65 + d] - bt);
                fg[e] = q[e] * __expf(bt);
#pragma unroll
                for (int j = 0; j < 3; ++j) fo[j][e] = i > j ? q[e] * __expf(bt - LF[(16 * j + 15) * 65 + d]) : 0.f; }
            *(u32x4*)(Qd + t * LDP + sub * 8) = pack8(fd); *(u32x4*)(Kd + t * LDP + sub * 8) = pack8(fkd); *(u32x4*)(Ko + t * LDP + sub * 8) = pack8(fko); *(u32x4*)(Qg + t * LDP + sub * 8) = pack8(fg);
#pragma unroll
            for (int j = 0; j < 3; ++j) *(u32x4*)(Qo + j * 64 * LDP + t * LDP + sub * 8) = pack8(fo[j]);
        }
        __syncthreads();
        for (int ti = c.wave; ti < 10; ti += 8) {
            const int i = ti < 1 ? 0 : (ti < 3 ? 1 : (ti < 6 ? 2 : 3)), j = ti - (i * (i + 1)) / 2;
            f32x4 a;
            if (i == j) a = mm16(Qd + i * 16 * LDP, LDP, Kd + j * 16 * LDP, LDP, (f32x4){0.f, 0.f, 0.f, 0.f}, c.lane);
            else a = mm16(Qo + j * 64 * LDP + i * 16 * LDP, LDP, Ko + j * 16 * LDP, LDP, (f32x4){0.f, 0.f, 0.f, 0.f}, c.lane);
#pragma unroll
            for (int e = 0; e < 4; ++e) { const int tl = 4 * g4 + e; const float v = (i != j || r16 <= tl) ? a[e] : 0.f; Am[(16 * i + tl) * LDP + 16 * j + r16] = (bf16_t)f2bf(v); }
        }
        __syncthreads();
        {
            const int tt = c.wave >> 1;
#pragma unroll
            for (int q2 = 0; q2 < 2; ++q2) { const int vt = 2 * (c.wave & 1) + q2;
                f32x4 a = mm16(Am + tt * 16 * LDP, LDP, VT + vt * 16 * LDP, LDP, (f32x4){0.f, 0.f, 0.f, 0.f}, c.lane);
                a = mm16(Qg + tt * 16 * LDP, LDP, Sl + vt * 16 * LDP, LDP, a, c.lane);
#pragma unroll
                for (int e = 0; e < 4; ++e) { const int tau = 16 * tt + 4 * g4 + e; float* op = OUT + (dir ? 63 - tau : tau) * 65 + 16 * vt + r16; if (dir) *op += a[e]; else *op = a[e]; }
            }
        }
        __syncthreads();
    }
    gated_norm_store(c, OUT, INP(11) + l * 64, base, C_HG + h * 64, h * 64);
    __syncthreads();
}

__device__ __forceinline__ void phase_m3(const Ctx& c, int l) {
    const int ncid = l == 0 ? NCH : 128;
    const int n1 = NB * 4 * ncid;
    for (int it = c.bid; it < 2 * n1; it += c.G) {
        const int j = it % n1; const int b = j / (4 * ncid), h = (j / ncid) % 4, cid = j % ncid;
        if (it < n1) m3_gdn_item(c, l, b, h, cid); else m3_hgrn_item(c, l, b, h, cid);
    }
}
__device__ __forceinline__ void phase_moe_assign(const Ctx& c) {
    int* sh = (int*)c.lds;
    if (c.tid == 0) { int acc = 0; for (int e = 0; e < NEXP; ++e) { const int cnt = (int)WSP(unsigned, WS_CTL)[CW_CNT + e]; sh[e] = acc; acc += (cnt + 255) / 256 * 256; sh[8 + e] = acc; } }
    __syncthreads();
    if (c.bid == 0 && c.tid <= NSLOT_TILES) {
        if (c.tid == NSLOT_TILES) WSP(int, WS_TILEE)[NSLOT_TILES] = sh[15] / 256;
        else { int e = 0; while (e < NEXP - 1 && sh[8 + e] <= c.tid * 256) ++e; WSP(int, WS_TILEE)[c.tid] = e; }
    }
    if (c.wave == 0) {
        for (int ch = c.bid; ch < NLAT / 64; ch += c.G) {
            const int tok = ch * 64 + c.lane;
#pragma unroll
            for (int k = 0; k < 2; ++k) {
                const int e = WSP(int, WS_TOKE)[tok * 2 + k]; int slot = 0;
                for (int ee = 0; ee < NEXP; ++ee) {
                    const unsigned long long mask = __ballot(e == ee);
                    if (mask) { unsigned bs = 0; if (c.lane == 0) bs = atomicAdd(WSP(unsigned, WS_CTL) + CW_CUR + ee, (unsigned)__popcll(mask)); bs = __shfl(bs, 0);
                        if (e == ee) slot = sh[ee] + (int)bs + __popcll(mask & ((1ull << c.lane) - 1ull)); }
                }
                WSP(int, WS_TOKS)[tok * 2 + k] = slot; WSP(int, WS_SLOTTOK)[slot] = tok;
            }
        }
    }
    __syncthreads();
}
__device__ __forceinline__ void phase_moe_combine(const Ctx& c) {
    const float* mod = WSP(float, WS_MOD) + (size_t)1 * 3 * 6144 + 5120;
    const bf16_t* YP = WSP(bf16_t, WS_YP);
    for (int row = c.bid * 8 + c.wave; row < NLAT; row += c.G * 8) {
        const int s = row < SEQ ? 0 : 1;
        const int sa = WSP(int, WS_TOKS)[row * 2], sb = WSP(int, WS_TOKS)[row * 2 + 1];
        const float ga = WSP(float, WS_TOKG)[row * 2], gb = WSP(float, WS_TOKG)[row * 2 + 1];
        float* xr = c.p->out + (size_t)row * D;
#pragma unroll
        for (int j = 0; j < 2; ++j) { const int col = 8 * c.lane + 512 * j;
            float ya[8], yb[8]; unpack8(*(const u32x4*)(YP + (size_t)sa * D + col), ya); unpack8(*(const u32x4*)(YP + (size_t)sb * D + col), yb);
            f32x4 x0 = *(const f32x4*)(xr + col), x1 = *(const f32x4*)(xr + col + 4);
            const f32x4 g0 = *(const f32x4*)(mod + s * 6144 + col), g1 = *(const f32x4*)(mod + s * 6144 + col + 4);
#pragma unroll
            for (int e = 0; e < 4; ++e) { x0[e] += g0[e] * (ga * ya[e] + gb * yb[e]); x1[e] += g1[e] * (ga * ya[4 + e] + gb * yb[4 + e]); }
            *(f32x4*)(xr + col) = x0; *(f32x4*)(xr + col + 4) = x1; }
    }
}

__device__ __forceinline__ void phase_inproj(const Ctx& c, int l) {
    pg8::Gemm g{WSP(bf16_t, WS_H), WSP(bf16_t, WS_WIN) + (size_t)l * NP * D, D, MTOK / 256, NP / 256, nullptr, 0, nullptr, 0, 0};
    pg8::EpiBf16 E{WSP(bf16_t, WS_P), NP, 0};
    pg8::gemm_phase(( LAS unsigned char*)c.lds, g, E);
}
__device__ __forceinline__ void phase_outproj(const Ctx& c, int l) {
    pg8::Gemm g{WSP(bf16_t, WS_H), WSP(bf16_t, WS_WOUT) + (size_t)l * D * D, D, (l == 0 ? MTOK : NLAT) / 256, D / 256, nullptr, 0, nullptr, 0, 0};
    pg8::EpiResid E{l == 0 ? INP(0) : c.p->out, l == 0 ? INP(2) : WSP(float, WS_XC), c.p->out, WSP(float, WS_XC), WSP(float, WS_MOD) + (size_t)l * 3 * 6144 + 2048};
    pg8::gemm_phase((LAS unsigned char*)c.lds, g, E);
}
__device__ __forceinline__ void phase_ffn1(const Ctx& c) {
    pg8::Gemm g{WSP(bf16_t, WS_H), WSP(bf16_t, WS_W13), D, MTOK / 256, 7168 / 256, nullptr, 0, nullptr, 0, 0};
    pg8::EpiSwiGLU E{WSP(bf16_t, WS_P), DFF};
    pg8::gemm_phase((LAS unsigned char*)c.lds, g, E);
}
__device__ __forceinline__ void phase_ffn2(const Ctx& c) {
    pg8::Gemm g{WSP(bf16_t, WS_P), WSP(bf16_t, WS_W2), DFF, MTOK / 256, D / 256, nullptr, 0, nullptr, 0, 0};
    pg8::EpiResid E{c.p->out, WSP(float, WS_XC), c.p->out, WSP(float, WS_XC), WSP(float, WS_MOD) + 5120};
    pg8::gemm_phase((LAS unsigned char*)c.lds, g, E);
}
__device__ __forceinline__ void moe_half(const Ctx& c, int half, int& t0, int& nt) {
    const int ntiles = WSP(int, WS_TILEE)[NSLOT_TILES];
    t0 = half * HALF_TILES; const int t1 = half ? ntiles : (ntiles < HALF_TILES ? ntiles : HALF_TILES);
    nt = t1 > t0 ? t1 - t0 : 0;
}
__device__ __forceinline__ void phase_moe1(const Ctx& c, int half) {
    int t0, nt; moe_half(c, half, t0, nt);
    pg8::Gemm g{WSP(bf16_t, WS_H), WSP(bf16_t, WS_MOEW13), D, nt, 7168 / 256, WSP(int, WS_SLOTTOK), 0, WSP(int, WS_TILEE), t0, (size_t)7168 * D};
    pg8::EpiSwiGLU E{WSP(bf16_t, WS_P), DFF};
    pg8::gemm_phase((LAS unsigned char*)c.lds, g, E);
}
__device__ __forceinline__ void phase_moe2(const Ctx& c, int half) {
    int t0, nt; moe_half(c, half, t0, nt);
    pg8::Gemm g{WSP(bf16_t, WS_P), WSP(bf16_t, WS_MOEW2), DFF, nt, D / 256, nullptr, 0, WSP(int, WS_TILEE), t0, (size_t)D * DFF};
    pg8::EpiBf16 E{WSP(bf16_t, WS_YP), D, t0 * 256};
    pg8::gemm_phase((LAS unsigned char*)c.lds, g, E);
}

constexpr int N_PHASES = 23;
__device__ __forceinline__ void run_phase(const Ctx& c, int ph) {
    switch (ph) {
        case 0: phase_prologue(c); break;
        case 1: phase_norm(c, 0, 1); break;
        case 2: phase_inproj(c, 0); break;
        case 3: phase_m1(c, 0); break;
        case 4: phase_m2(c, 0); break;
        case 5: phase_m3(c, 0); break;
        case 6: phase_outproj(c, 0); break;
        case 7: phase_norm(c, 0, 2); break;
        case 8: phase_ffn1(c); break;
        case 9: phase_ffn2(c); break;
        case 10: phase_norm(c, 1, 1); break;
        case 11: phase_inproj(c, 1); break;
        case 12: phase_m1(c, 1); break;
        case 13: phase_m2(c, 1); break;
        case 14: phase_m3(c, 1); break;
        case 15: phase_outproj(c, 1); break;
        case 16: phase_norm(c, 1, 2); for (int it = c.bid; it < CI_MOE; it += c.G) cvt_moe_item(c, it); break;
        case 17: phase_moe_assign(c); break;
        case 18: phase_moe1(c, 0); break;
        case 19: phase_moe2(c, 0); break;
        case 20: phase_moe1(c, 1); break;
        case 21: phase_moe2(c, 1); break;
        case 22: phase_moe_combine(c); break;
        default: break;
    }
}

#ifndef MK_MEGA
#define MK_MEGA 1
#endif
__global__ void __launch_bounds__(512, 2) fwd_kernel(Params p) {
    extern __shared__ __attribute__((aligned(16))) unsigned char lds[];
    Ctx c; c.p = &p; c.lds = lds; c.ws = p.ws; c.tid = threadIdx.x; c.lane = c.tid & 63; c.wave = __builtin_amdgcn_readfirstlane(c.tid >> 6); c.bid = blockIdx.x; c.G = gridDim.x;
#if MK_MEGA
    cg::grid_group grid = cg::this_grid();
#endif
#if MK_MEGA
#define PH(k) if (p.ph_lo <= (k) && (k) < p.ph_hi) { run_phase(c, (k)); if ((k) + 1 < p.ph_hi) grid.sync(); }
#else
#define PH(k) if (p.ph_lo <= (k) && (k) < p.ph_hi) { run_phase(c, (k)); }
#endif
#ifdef ONLY_PHASE
    PH(ONLY_PHASE)
#else
    PH(0) PH(1) PH(2) PH(3) PH(4) PH(5) PH(6) PH(7) PH(8) PH(9) PH(10) PH(11) PH(12) PH(13) PH(14) PH(15) PH(16) PH(17) PH(18) PH(19) PH(20) PH(21) PH(22)
#endif
#undef PH
}

extern "C" void kernel_launch(void* const* d_in, const int* in_sizes, int n_in, void* d_out, int out_size, void* d_ws, size_t ws_size, hipStream_t stream) {
    static int grid = 0;
    if (grid == 0) {
        if (n_in != 27 || out_size != NLAT * D || ws_size < WS_END) { fprintf(stderr, "kernel_launch: unexpected sizes (n_in %d, out %d, ws %zu, need %zu)\n", n_in, out_size, ws_size, (size_t)WS_END); grid = -1; return; }
        int dev = 0, cus = 0, per_cu = 0;
        hipGetDevice(&dev); hipDeviceGetAttribute(&cus, hipDeviceAttributeMultiprocessorCount, dev);
        hipFuncSetAttribute((const void*)fwd_kernel, hipFuncAttributeMaxDynamicSharedMemorySize, LDS_BYTES);
        hipOccupancyMaxActiveBlocksPerMultiprocessor(&per_cu, (const void*)fwd_kernel, 512, LDS_BYTES);
        if (per_cu < 1) { fprintf(stderr, "kernel_launch: occupancy query says %d blocks/CU\n", per_cu); per_cu = 1; }
        grid = cus;
        (void)hipGetLastError();
    }
    if (grid < 0) return;
    hipMemsetAsync((char*)d_ws + WS_CTL, 0, CTL_BYTES, stream);
    Params p{};
    for (int i = 0; i < 27; ++i) p.in[i] = (const float*)d_in[i];
    p.out = (float*)d_out; p.ws = (unsigned char*)d_ws;
#if MK_MEGA
    p.ph_lo = 0; p.ph_hi = N_PHASES;
    void* args[] = {&p};
    hipError_t e = hipLaunchCooperativeKernel((const void*)fwd_kernel, dim3(grid), dim3(512), args, LDS_BYTES, stream);
    if (e != hipSuccess) fprintf(stderr, "cooperative launch failed: %s (grid %d)\n", hipGetErrorString(e), grid);
#else
    for (int ph = 0; ph < N_PHASES; ++ph) { p.ph_lo = ph; p.ph_hi = ph + 1; hipLaunchKernelGGL(fwd_kernel, dim3(grid), dim3(512), LDS_BYTES, stream, p); }
#endif
}
```

```cpp
#include <hip/hip_runtime.h>
#include <hip/hip_cooperative_groups.h>
#include <cstdio>
#include <cstdint>
namespace cg = cooperative_groups;

#define LAS __attribute__((address_space(3)))
typedef unsigned short bf16_t;
typedef short bf16x8 __attribute__((ext_vector_type(8)));
typedef float f32x4 __attribute__((ext_vector_type(4)));
typedef float f32x2 __attribute__((ext_vector_type(2)));
typedef unsigned u32x4 __attribute__((ext_vector_type(4)));
typedef unsigned u32x2 __attribute__((ext_vector_type(2)));

constexpr int D = 1024, NB = 2, SEQ = 8192, CTXL = 256, NLAT = NB * SEQ, NCTX = NB * CTXL, MTOK = NLAT + NCTX;
constexpr int NP = 3840;
constexpr int C_HQ = 0, C_HFF = 256, C_HFB = 512, C_HI = 768, C_HG = 1024, C_GQ = 1280, C_GK = 1536, C_GV = 1792, C_GG = 2048, C_NQ = 2304, C_NK = 2816, C_NV = 3328;
constexpr int DPROJ = 3856, DFF = 3584, NEXP = 8;
constexpr int NCH = 132;
constexpr int NSLOT_TILES = 136, NSLOTS = NSLOT_TILES * 256;
constexpr int VT_LD = 8448;
constexpr float EPS = 1e-6f;

constexpr size_t KiB = 1024, MiB = 1024 * 1024;
constexpr size_t WS_CTL = 0, CTL_BYTES = 64 * KiB;
constexpr size_t WS_MOD = 64 * KiB;
constexpr size_t WS_ROPE = 256 * KiB;
constexpr size_t WS_WG = 320 * KiB;
constexpr size_t WS_WR = 448 * KiB;
constexpr size_t WS_TOKE = 512 * KiB, WS_TOKG = 640 * KiB, WS_TOKS = 768 * KiB, WS_SLOTTOK = 896 * KiB;
constexpr size_t WS_TILEE = 1040 * KiB;
constexpr size_t WS_TILEP = 1044 * KiB;
constexpr size_t WS_GATES = 2 * MiB;
constexpr size_t WS_XC = 4 * MiB;
constexpr size_t WS_H = 6 * MiB;
constexpr size_t WS_WIN = 40 * MiB;
constexpr size_t WS_WOUT = 55 * MiB;
constexpr size_t WS_W13 = 59 * MiB;
constexpr size_t WS_W2 = 73 * MiB;
constexpr size_t WS_P = 80 * MiB;
constexpr size_t WS_SCR = 204 * MiB;
constexpr size_t NITEM = 16 * NCH;
constexpr size_t WS_GA = WS_SCR;
constexpr size_t WS_GB = WS_GA + NITEM * 8192;
constexpr size_t WS_GW = WS_GB + NITEM * 16384;
constexpr size_t WS_GU = WS_GW + NITEM * 8192;
constexpr size_t WS_GS = WS_GU + NITEM * 8192;
constexpr size_t WS_GQKV = WS_GS + NITEM * 8192;
constexpr size_t WS_HB = WS_GQKV + (size_t)3 * MTOK * 256 * 2;
constexpr size_t WS_HA = WS_HB + NITEM * 16384;
constexpr size_t WS_VT = WS_HA + NITEM * 256;
constexpr int NSEG = 11, SEGL = 12;
constexpr size_t WS_SA = WS_VT + (size_t)NB * 8 * 64 * VT_LD * 2;
constexpr size_t WS_SB = WS_SA + (size_t)16 * NSEG * 8192;
constexpr size_t WS_SS = WS_SB + (size_t)16 * NSEG * 16384;
constexpr size_t WS_HQ = WS_SS + (size_t)16 * NSEG * 16384;
constexpr size_t WS_HO = WS_GQKV;
constexpr size_t WS_SCR_END = WS_HQ + NITEM * 8192;
constexpr int CTX_SPLIT_O = 8, CTX_SPLIT_F = 28;
constexpr size_t WS_PARTO = WS_SCR;
constexpr size_t WS_PARTF = WS_SCR + 16 * MiB;
constexpr size_t WS_MOEW13 = 40 * MiB;
constexpr int NE13 = 3;
constexpr int MOE2_MAIN = 512, MOE2_SPLIT = 7;
constexpr size_t WS_PART2 = 80 * MiB;
constexpr size_t WS_ACTP = 208 * MiB;
constexpr size_t WS_YP = 6 * MiB;
constexpr size_t WS_XB = 446 * MiB;
constexpr size_t WS_MOEW13E = WS_XB + (size_t)NLAT * 1024 * 2;
constexpr size_t WS_END = WS_MOEW13E + (size_t)NE13 * 7168 * 1024 * 2;
static_assert(WS_SCR_END <= 446 * MiB && WS_MOEW13 + (size_t)8 * 7168 * 1024 * 2 <= WS_ACTP && WS_ACTP + (size_t)NSLOTS * DFF * 2 <= WS_XB && WS_YP + (size_t)NSLOTS * 1024 * 2 <= WS_PART2 && WS_PART2 + (size_t)32 * 7 * 65536 * 4 <= WS_ACTP, "ws map");
static_assert(WS_P + (size_t)MTOK * NP * 2 <= WS_SCR && WS_H + (size_t)MTOK * D * 2 <= WS_WIN && WS_W2 + (size_t)D * DFF * 2 <= WS_P, "ws map");
constexpr int CW_CNT = 64, CW_CUR = 128, CW_NAQ = 192  , CW_TQ = 320  , CW_BQ = 512  , CW_CV = 576  , CW_RT = 704  , CW_BAR = 4096;

constexpr int LDS_BYTES = 147456;
constexpr int LDS_CTLOFF = 135168;

__device__ __forceinline__ float bf2f(unsigned short b) { return __uint_as_float((unsigned)b << 16); }
__device__ __forceinline__ unsigned f2bf(float f) { unsigned u = __float_as_uint(f); return (u + 0x7fffu + ((u >> 16) & 1u)) >> 16; }
typedef __bf16 bf16x2_t __attribute__((ext_vector_type(2)));
__device__ __forceinline__ unsigned pk2(float lo, float hi) { const f32x2 v = {lo, hi}; const bf16x2_t b = __builtin_convertvector(v, bf16x2_t); return __builtin_bit_cast(unsigned, b); }
__device__ __forceinline__ void unpack8(const u32x4 v, float (&f)[8]) {
#pragma unroll
    for (int i = 0; i < 4; ++i) { f[2 * i] = __uint_as_float(v[i] << 16); f[2 * i + 1] = __uint_as_float(v[i] & 0xffff0000u); }
}
__device__ __forceinline__ u32x4 pack8(const float (&f)[8]) { u32x4 v; v.x = pk2(f[0], f[1]); v.y = pk2(f[2], f[3]); v.z = pk2(f[4], f[5]); v.w = pk2(f[6], f[7]); return v; }
__device__ __forceinline__ float wave_sum(float v) {
#define DPP_ADD(ctrl, rmask, bmask) v += __builtin_bit_cast(float, __builtin_amdgcn_update_dpp(0, __builtin_bit_cast(int, v), (ctrl), (rmask), (bmask), true))
    DPP_ADD(0x111, 0xf, 0xf);
    DPP_ADD(0x112, 0xf, 0xf);
    DPP_ADD(0x114, 0xf, 0xf);
    DPP_ADD(0x118, 0xf, 0xf);
    DPP_ADD(0x142, 0xa, 0xf);
    DPP_ADD(0x143, 0xc, 0xf);
#undef DPP_ADD
    return __builtin_bit_cast(float, __builtin_amdgcn_readlane(__builtin_bit_cast(int, v), 63));
}
__device__ __forceinline__ float wave_scan(float v) {
#define DPP_ADD(ctrl, rmask, bmask) v += __builtin_bit_cast(float, __builtin_amdgcn_update_dpp(0, __builtin_bit_cast(int, v), (ctrl), (rmask), (bmask), true))
    DPP_ADD(0x111, 0xf, 0xf); DPP_ADD(0x112, 0xf, 0xf); DPP_ADD(0x114, 0xf, 0xf); DPP_ADD(0x118, 0xf, 0xf); DPP_ADD(0x142, 0xa, 0xf); DPP_ADD(0x143, 0xc, 0xf);
#undef DPP_ADD
    return v;
}
__device__ __forceinline__ float sum8(float v) {
    v += __builtin_bit_cast(float, __builtin_amdgcn_update_dpp(0, __builtin_bit_cast(int, v), 0xB1, 0xf, 0xf, true));
    v += __builtin_bit_cast(float, __builtin_amdgcn_update_dpp(0, __builtin_bit_cast(int, v), 0x4E, 0xf, 0xf, true));
    v += __builtin_bit_cast(float, __builtin_amdgcn_update_dpp(0, __builtin_bit_cast(int, v), 0x141, 0xf, 0xf, true));
    return v;
}
__device__ __forceinline__ float xmax16(float v) { const auto r = __builtin_amdgcn_permlane16_swap(__float_as_uint(v), __float_as_uint(v), false, false); return fmaxf(__uint_as_float(r[0]), __uint_as_float(r[1])); }
__device__ __forceinline__ float xmax32(float v) { const auto r = __builtin_amdgcn_permlane32_swap(__float_as_uint(v), __float_as_uint(v), false, false); return fmaxf(__uint_as_float(r[0]), __uint_as_float(r[1])); }
__device__ __forceinline__ float xadd16(float v) { const auto r = __builtin_amdgcn_permlane16_swap(__float_as_uint(v), __float_as_uint(v), false, false); return __uint_as_float(r[0]) + __uint_as_float(r[1]); }
__device__ __forceinline__ float xadd32(float v) { const auto r = __builtin_amdgcn_permlane32_swap(__float_as_uint(v), __float_as_uint(v), false, false); return __uint_as_float(r[0]) + __uint_as_float(r[1]); }
__device__ __forceinline__ float sigmoidf_(float x) { return __builtin_amdgcn_rcpf(1.f + __expf(-x)); }
__device__ __forceinline__ float siluf_(float x) { return x * __builtin_amdgcn_rcpf(1.f + __expf(-x)); }
__device__ __forceinline__ float softplusf_(float x) { return x > 20.f ? x : log1pf(expf(x)); }
__device__ __forceinline__ float logsigmoidf_(float z) { return fminf(z, 0.f) - log1pf(expf(-fabsf(z))); }
__device__ __forceinline__ int chunk_row(int b, int cid) { return cid < 128 ? b * SEQ + cid * 64 : NLAT + b * CTXL + (cid - 128) * 64; }
__device__ __forceinline__ int seq_cid(int dir, int step) { return dir == 0 ? (step < 4 ? 128 + step : step - 4) : (step < 4 ? 131 - step : 131 - step); }

__device__ __forceinline__ f32x4 mm16(const bf16_t* As, int lda, const bf16_t* Bs, int ldb, f32x4 acc, int lane) {
    const int r = lane & 15, g = lane >> 4;
#pragma unroll
    for (int kk = 0; kk < 2; ++kk) {
        const bf16x8 a = *(const bf16x8*)(As + r * lda + kk * 32 + g * 8);
        const bf16x8 b = *(const bf16x8*)(Bs + r * ldb + kk * 32 + g * 8);
        acc = __builtin_amdgcn_mfma_f32_16x16x32_bf16(a, b, acc, 0, 0, 0);
    }
    return acc;
}
constexpr int LDP = 72;

struct Params {
    const float* in[27];
    float* out;
    unsigned char* ws;
    int ph_lo, ph_hi;
    int cg_seams, pad;
};
namespace pg8 {
constexpr int BM = 256, BK = 64, HALF = 128, HTB = HALF * BK * 2, STAGE_BYTES = 8 * HTB, NXCD = 8, WGM = 8;
__host__ __device__ __forceinline__ int lds_byte(int r, int c) { const int st = (r >> 4) * 2 + (c >> 5), rr = r & 15, cc = c & 31, ob = rr * 64 + cc * 2; return st * 1024 + (ob ^ (((ob >> 9) & 1) << 5)); }
__host__ __device__ __forceinline__ void stage_rc(int b, int& R, int& C) { const int st = b / 1024, sb = b % 1024, swz = sb ^ (((sb >> 9) & 1) << 5); R = (st >> 1) * 16 + swz / 64; C = (st & 1) * 32 + (swz % 64) / 2; }
__host__ __device__ __forceinline__ int perm32(int rho) { const int n = rho >> 4, i = rho & 15; return 8 * (i >> 2) + 4 * n + (i & 3); }

struct Unit { int pm, pn, ks, uid; };
struct Gemm { const bf16_t* A; const bf16_t* Bt; int K, nM, nN; const int* rowmap; int arow0; const int* tile_e; int tile0; size_t estride; int nS, klen, lim, lbase; int gG; const bf16_t* Bt2; int esplit; };

__device__ __forceinline__ void tile_of(int nM, int nN, int L, Unit& u) {
    const int nwg = nM * nN; int wgid = L; { const int q = nwg / NXCD, r = nwg % NXCD, xcd = wgid % NXCD, off = wgid / NXCD; wgid = (xcd < r ? xcd * (q + 1) : r * (q + 1) + (xcd - r) * q) + off; }
    const int nig = WGM * nN, gid = wgid / nig, fm = gid * WGM, gsz = (nM - fm) < WGM ? (nM - fm) : WGM;
    u.pm = fm + ((wgid % nig) % gsz); u.pn = (wgid % nig) / gsz;
}
__device__ __forceinline__ bool next_unit(const Gemm& g, int G, int c, int i, Unit& u) {
    const int nM = g.nM, nN = g.nN; const long L = (long)i * G + c;
    if (g.nS > 1) {
        const int ntile = g.lbase >= 0 ? nM * nN - g.lbase : nM * nN;
        if (L >= (long)ntile * g.nS) return false;
        u.ks = (int)(L % g.nS); const int t = (int)(L / g.nS); u.uid = t;
        if (g.lbase >= 0) tile_of(nM, nN, g.lbase + t, u); else { u.pn = t % nN; u.pm = t / nN; }
        return true;
    }
    u.ks = 0; u.uid = 0;
    const int nwg = nM * nN < g.lim ? nM * nN : g.lim; if (L >= nwg) return false;
    tile_of(nM, nN, (int)L, u); return true;
}
__device__ __forceinline__ unsigned cvt_pk_bf16(float lo, float hi) { return pk2(lo, hi); }

struct EpiBf16 {
    static constexpr bool PERM = true;
    bf16_t* O; int ldc; int row0;
    __device__ __forceinline__ void operator()(const f32x4 (&acc)[2][2][4][2], const Unit& u, int wr, int wc, int fr, int fq) const {
        const int rowb = row0 + u.pm * BM + wr * 64 + fr; const int col0 = u.pn * BM + wc * 32 + 8 * fq;
#pragma unroll
        for (int ai = 0; ai < 2; ++ai)
#pragma unroll
            for (int m = 0; m < 4; ++m) { bf16_t* rowp = O + (size_t)(rowb + ai * HALF + m * 16) * ldc + col0;
#pragma unroll
                for (int bj = 0; bj < 2; ++bj) { const f32x4 v0 = acc[ai][bj][m][0], v1 = acc[ai][bj][m][1];
                    u32x4 w; w.x = cvt_pk_bf16(v0[0], v0[1]); w.y = cvt_pk_bf16(v0[2], v0[3]); w.z = cvt_pk_bf16(v1[0], v1[1]); w.w = cvt_pk_bf16(v1[2], v1[3]);
                    *(u32x4*)(rowp + bj * HALF) = w; } }
    }
};
struct EpiSwiGLU {
    static constexpr bool PERM = true;
    bf16_t* O; int ldc;
    __device__ __forceinline__ void operator()(const f32x4 (&acc)[2][2][4][2], const Unit& u, int wr, int wc, int fr, int fq) const {
        const int rowb = u.pm * BM + wr * 64 + fr; const int col0 = u.pn * HALF + wc * 32 + 8 * fq;
#pragma unroll
        for (int ai = 0; ai < 2; ++ai)
#pragma unroll
            for (int m = 0; m < 4; ++m) { bf16_t* rowp = O + (size_t)(rowb + ai * HALF + m * 16) * ldc + col0;
                float a[8];
#pragma unroll
                for (int n = 0; n < 2; ++n) { const f32x4 g = acc[ai][0][m][n], v = acc[ai][1][m][n];
#pragma unroll
                    for (int e = 0; e < 4; ++e) a[4 * n + e] = g[e] * __builtin_amdgcn_rcpf(1.f + __expf(-g[e])) * v[e]; }
                u32x4 w; w.x = cvt_pk_bf16(a[0], a[1]); w.y = cvt_pk_bf16(a[2], a[3]); w.z = cvt_pk_bf16(a[4], a[5]); w.w = cvt_pk_bf16(a[6], a[7]);
                *(u32x4*)rowp = w; }
    }
};
template<bool F32B>
struct EpiResid {
    static constexpr bool PERM = true;
    const float* base_f; bf16_t* xb; const float* gate;
    __device__ __forceinline__ void operator()(const f32x4 (&acc)[2][2][4][2], const Unit& u, int wr, int wc, int fr, int fq) const {
        const int s = u.pm >> 5;
        const int rowb = u.pm * BM + wr * 64 + fr; const int col0 = u.pn * BM + wc * 32 + 8 * fq;
        f32x4 gv[2][2];
#pragma unroll
        for (int bj = 0; bj < 2; ++bj)
#pragma unroll
            for (int n = 0; n < 2; ++n) gv[bj][n] = *(const f32x4*)(gate + s * 6144 + col0 + bj * HALF + n * 4);
#pragma unroll
        for (int ai = 0; ai < 2; ++ai)
#pragma unroll
            for (int m = 0; m < 4; ++m) { const size_t off = (size_t)(rowb + ai * HALF + m * 16) * D + col0;
#pragma unroll
                for (int bj = 0; bj < 2; ++bj) { f32x4 b0, b1;
                    if (F32B) { b0 = *(const f32x4*)(base_f + off + bj * HALF); b1 = *(const f32x4*)(base_f + off + bj * HALF + 4); }
                    else { const u32x4 w = *(const u32x4*)(xb + off + bj * HALF);
                        b0 = (f32x4){__uint_as_float(w.x << 16), __uint_as_float(w.x & 0xffff0000u), __uint_as_float(w.y << 16), __uint_as_float(w.y & 0xffff0000u)};
                        b1 = (f32x4){__uint_as_float(w.z << 16), __uint_as_float(w.z & 0xffff0000u), __uint_as_float(w.w << 16), __uint_as_float(w.w & 0xffff0000u)}; }
                    b0 += gv[bj][0] * acc[ai][bj][m][0]; b1 += gv[bj][1] * acc[ai][bj][m][1];
                    u32x4 o; o.x = cvt_pk_bf16(b0[0], b0[1]); o.y = cvt_pk_bf16(b0[2], b0[3]); o.z = cvt_pk_bf16(b1[0], b1[1]); o.w = cvt_pk_bf16(b1[2], b1[3]);
                    *(u32x4*)(xb + off + bj * HALF) = o; } }
    }
};

struct EpiPartial {
    static constexpr bool PERM = false;
    float* P; int ldc; int rows;
    __device__ __forceinline__ void operator()(const f32x4 (&acc)[2][2][4][2], const Unit& u, int wr, int wc, int fr, int fq) const {
        const int rowb = u.pm * BM + wr * 64 + fr; const int col0 = u.pn * BM + wc * 32 + 4 * fq;
        float* base = P + (size_t)u.ks * rows * ldc;
#pragma unroll
        for (int ai = 0; ai < 2; ++ai)
#pragma unroll
            for (int m = 0; m < 4; ++m) { float* rowp = base + (size_t)(rowb + ai * HALF + m * 16) * ldc + col0;
#pragma unroll
                for (int bj = 0; bj < 2; ++bj)
#pragma unroll
                    for (int n = 0; n < 2; ++n) *(f32x4*)(rowp + bj * HALF + n * 16) = acc[ai][bj][m][n]; }
    }
};

struct EpiPartialTile {
    static constexpr bool PERM = false;
    float* P; int nS;
    __device__ __forceinline__ void operator()(const f32x4 (&acc)[2][2][4][2], const Unit& u, int wr, int wc, int fr, int fq) const {
        float* base = P + (size_t)(u.uid * nS + u.ks) * 65536 + (size_t)(wr * 64 + fr) * 256 + wc * 32 + 4 * fq;
#pragma unroll
        for (int ai = 0; ai < 2; ++ai)
#pragma unroll
            for (int m = 0; m < 4; ++m) { float* rowp = base + (size_t)(ai * HALF + m * 16) * 256;
#pragma unroll
                for (int bj = 0; bj < 2; ++bj)
#pragma unroll
                    for (int n = 0; n < 2; ++n) *(f32x4*)(rowp + bj * HALF + n * 16) = acc[ai][bj][m][n]; }
    }
};

__device__ __forceinline__ void a_offsets(const Gemm& g, const Unit& u, int tid, unsigned (&o)[2][2]) {
#pragma unroll
    for (int h = 0; h < 2; ++h)
#pragma unroll
        for (int i = 0; i < 2; ++i) {
            int R, C; stage_rc(tid * 16 + i * 8192, R, C);
            const int lr = u.pm * BM + h * HALF + R;
            const int row = g.rowmap ? g.rowmap[g.tile0 * BM + lr] : g.arow0 + lr;
            o[h][i] = ((unsigned)row * (unsigned)g.K + (unsigned)(u.ks * g.klen + C)) * 2u;
        }
}
__device__ __forceinline__ const char* b_base(const Gemm& g, const Unit& u) {
    const bf16_t* bb = g.Bt;
    if (g.tile_e) { const int ex = g.tile_e[g.tile0 + u.pm]; bb = (ex < g.esplit ? g.Bt2 : g.Bt) + (size_t)ex * g.estride; }
    return (const char*)(bb + (size_t)u.pn * BM * g.K + (size_t)u.ks * g.klen);
}

template <class Epi>
__device__ __forceinline__ void gemm_phase(LAS unsigned char* lds, const Gemm g, const Epi& E, int tid, int wid) {
    const int lane = tid & 63, wr = wid >> 2, wc = wid & 3, fr = lane & 15, fq = lane >> 4;
    const int K = g.K, nt = g.klen / BK, G = g.gG ? g.gG : (int)gridDim.x, cidx = blockIdx.x;
    if (cidx >= G) return;
    unsigned voffB[2];
#pragma unroll
    for (int i = 0; i < 2; ++i) { int R, C; stage_rc(tid * 16 + i * 8192, R, C); const int Rb = Epi::PERM ? ((R & ~31) + perm32(R & 31)) : R; voffB[i] = (unsigned)(Rb * K + C) * 2u; }
    const size_t kstep = (size_t)(BK * 2);
    const size_t hstep = (size_t)HALF * K * 2;
    const unsigned ldsw = (unsigned)wid * 1024u;
    const int aoff = lds_byte(wr * 64 + fr, fq * 8), boff = lds_byte(wc * 32 + fr, fq * 8);
#define PG8_SA(b, h) (((b) * 2 + (h)) * HTB)
#define PG8_SB(b, h) ((4 + (b) * 2 + (h)) * HTB)
#define PG8_STAGE(bufoff, gbase, voff) do { _Pragma("unroll") for (int _i = 0; _i < 2; ++_i) \
        __builtin_amdgcn_global_load_lds((const unsigned*)((const char*)(gbase) + (voff)[_i]), (LAS unsigned*)(lds + (bufoff) + ldsw + _i * 8192), 16, 0, 0); } while (0)
#define PG8_LDA(dst, b, h) do { _Pragma("unroll") for (int m = 0; m < 4; ++m) _Pragma("unroll") for (int k = 0; k < 2; ++k) dst[m][k] = *(const LAS bf16x8*)(lds + PG8_SA(b, h) + aoff + m * 2048 + k * 1024); } while (0)
#define PG8_LDB(dst, b, h) do { _Pragma("unroll") for (int n = 0; n < 2; ++n) _Pragma("unroll") for (int k = 0; k < 2; ++k) dst[n][k] = *(const LAS bf16x8*)(lds + PG8_SB(b, h) + boff + n * 2048 + k * 1024); } while (0)
#define PG8_MMA(ai, bj, At, Bt) do { __builtin_amdgcn_s_setprio(1); _Pragma("unroll") for (int m = 0; m < 4; ++m) _Pragma("unroll") for (int n = 0; n < 2; ++n) _Pragma("unroll") for (int k = 0; k < 2; ++k) \
        acc[ai][bj][m][n] = __builtin_amdgcn_mfma_f32_16x16x32_bf16(Bt[n][k], At[m][k], acc[ai][bj][m][n], 0, 0, 0); __builtin_amdgcn_s_setprio(0); } while (0)
#define PG8_WAIT_V(n) asm volatile("s_waitcnt vmcnt(" #n ")" ::: "memory")
#define PG8_WAIT_L(n) asm volatile("s_waitcnt lgkmcnt(" #n ")" ::: "memory")
#define PG8_BAR __builtin_amdgcn_s_barrier()
#define PG8_SCHED __builtin_amdgcn_sched_barrier(0)
    Unit cur, nxt; int ui = 0;
    if (!next_unit(g, G, cidx, 0, cur)) return;
    f32x4 acc[2][2][4][2];
#pragma unroll
    for (int a = 0; a < 2; ++a)
#pragma unroll
        for (int b = 0; b < 2; ++b)
#pragma unroll
            for (int m = 0; m < 4; ++m)
#pragma unroll
                for (int n = 0; n < 2; ++n) acc[a][b][m][n] = (f32x4){0.f, 0.f, 0.f, 0.f};
    bf16x8 At[4][2], B0[2][2], B1[2][2];
    const char* const Ab = (const char*)g.A;
    unsigned oc[2][2];
    a_offsets(g, cur, tid, oc);
    const char* cB = b_base(g, cur);
    PG8_STAGE(PG8_SB(0, 0), cB, voffB); PG8_STAGE(PG8_SB(0, 1), cB + hstep, voffB); PG8_STAGE(PG8_SA(0, 0), Ab, oc[0]); PG8_STAGE(PG8_SA(0, 1), Ab, oc[1]);
    if (wr == 1) PG8_BAR;
    PG8_WAIT_V(2); PG8_BAR;
    PG8_STAGE(PG8_SB(1, 0), cB + kstep, voffB); PG8_STAGE(PG8_SA(1, 0), Ab + kstep, oc[0]); PG8_STAGE(PG8_SB(1, 1), cB + hstep + kstep, voffB);
    PG8_WAIT_V(6); PG8_BAR;
    for (;;) {
        bool has_next = false; const char* nB = cB;
        for (int t = 0; t < nt; t += 2) {
            const bool last = (t == nt - 2);
            const char* a1 = Ab + (size_t)(t + 1) * kstep;
            PG8_LDB(B0, 0, 0); PG8_LDB(B1, 0, 1); PG8_SCHED; PG8_LDA(At, 0, 0); PG8_STAGE(PG8_SA(1, 1), a1, oc[1]);
            PG8_WAIT_V(8); PG8_WAIT_L(0); PG8_BAR; PG8_MMA(0, 0, At, B0); PG8_MMA(0, 1, At, B1); PG8_BAR; PG8_SCHED;
            if (last) { has_next = next_unit(g, G, cidx, ui + 1, nxt); if (has_next) { a_offsets(g, nxt, tid, oc); nB = b_base(g, nxt); } }
            const char* a2 = last ? Ab : Ab + (size_t)(t + 2) * kstep; const char* b2 = last ? nB : cB + (size_t)(t + 2) * kstep;
            const char* a3 = a2 + kstep; const char* b3 = b2 + kstep;
            PG8_LDA(At, 0, 1); PG8_STAGE(PG8_SB(0, 0), b2, voffB); PG8_STAGE(PG8_SB(0, 1), b2 + hstep, voffB); PG8_STAGE(PG8_SA(0, 0), a2, oc[0]);
            PG8_WAIT_V(8); PG8_WAIT_L(0); PG8_BAR; PG8_MMA(1, 0, At, B0); PG8_MMA(1, 1, At, B1); PG8_BAR; PG8_SCHED;
            PG8_LDB(B0, 1, 0); PG8_LDB(B1, 1, 1); PG8_SCHED; PG8_LDA(At, 1, 0); PG8_STAGE(PG8_SA(0, 1), a2, oc[1]);
            PG8_WAIT_V(8); PG8_WAIT_L(0); PG8_BAR; PG8_MMA(0, 0, At, B0); PG8_MMA(0, 1, At, B1); PG8_BAR; PG8_SCHED;
            PG8_LDA(At, 1, 1); PG8_STAGE(PG8_SB(1, 0), b3, voffB); PG8_STAGE(PG8_SB(1, 1), b3 + hstep, voffB); PG8_STAGE(PG8_SA(1, 0), a3, oc[0]);
            PG8_WAIT_V(8); PG8_WAIT_L(0); PG8_BAR; PG8_MMA(1, 0, At, B0); PG8_MMA(1, 1, At, B1); PG8_BAR; PG8_SCHED;
        }
        if (wr == 0) PG8_BAR;
        E(acc, cur, wr, wc, fr, fq);
        if (!has_next) break;
#pragma unroll
        for (int a = 0; a < 2; ++a)
#pragma unroll
            for (int b = 0; b < 2; ++b)
#pragma unroll
                for (int m = 0; m < 4; ++m)
#pragma unroll
                    for (int n = 0; n < 2; ++n) acc[a][b][m][n] = (f32x4){0.f, 0.f, 0.f, 0.f};
        cur = nxt; cB = nB; ++ui;
        if (wr == 1) PG8_BAR;
    }
    PG8_WAIT_V(0);
    PG8_BAR;
#undef PG8_SA
#undef PG8_SB
#undef PG8_STAGE
#undef PG8_LDA
#undef PG8_LDB
#undef PG8_MMA
#undef PG8_WAIT_V
#undef PG8_WAIT_L
#undef PG8_BAR
#undef PG8_SCHED
}
}
struct Ctx {
    const Params* p;
    unsigned char* lds;
    unsigned char* ws;
    int tid, lane, wave, bid, G;
};
#define INP(i) (c.p->in[i])
#define WSP(T, off) ((T*)(c.ws + (off)))

__device__ __forceinline__ void cvt_item(const Ctx& c, const float* s0, const float* s1, int ldsrc, int mode, int k0, int n0, bf16_t* dst, int Kdst) {
    float* tile = (float*)c.lds;
    f32x4 v[4][2];
#pragma unroll
    for (int q = 0; q < 4; ++q)
#pragma unroll
        for (int i = 0; i < 2; ++i) {
            const int idx = c.tid + 512 * i, kk = idx >> 4, nn = (idx & 15) * 4, n = n0 + 64 * q + nn;
            const float* sp = s0; int col = n;
            if (mode == 0) col = n + (n >= 2304 ? 16 : 0);
            else if (mode == 2) { const int r = n & 255; sp = r < 128 ? s0 : s1; col = (n >> 8) * 128 + (r & 127); }
            v[q][i] = *(const f32x4*)(sp + (size_t)(k0 + kk) * ldsrc + col);
        }
#pragma unroll
    for (int q = 0; q < 4; ++q)
#pragma unroll
        for (int i = 0; i < 2; ++i) { const int idx = c.tid + 512 * i, kk = idx >> 4, nn = (idx & 15) * 4; const float sc = (mode == 0 && n0 + 64 * q + nn < 256) ? 0.125f : 1.f;
#pragma unroll
            for (int e = 0; e < 4; ++e) tile[q * 4160 + kk * 65 + nn + e] = v[q][i][e] * sc; }
    __syncthreads();
#pragma unroll
    for (int q = 0; q < 4; ++q) {
        const int r = c.tid >> 3, ch = c.tid & 7; float f[8];
#pragma unroll
        for (int e = 0; e < 8; ++e) f[e] = tile[q * 4160 + (8 * ch + e) * 65 + r];
        *(u32x4*)(dst + (size_t)(n0 + 64 * q + r) * Kdst + k0 + 8 * ch) = pack8(f);
    }
    __syncthreads();
}
constexpr int CI_WIN = 16 * 15, CI_WOUT = 16 * 4, CI_W13 = 16 * 28, CI_W2 = 56 * 4;
constexpr int CI_DENSE = 2 * CI_WIN + 2 * CI_WOUT + CI_W13 + CI_W2;
__device__ __forceinline__ void cvt_dense_item(const Ctx& c, int it) {
    if (it < 2 * CI_WIN) { const int l = it / CI_WIN, r = it % CI_WIN; cvt_item(c, INP(8) + (size_t)l * D * DPROJ, nullptr, DPROJ, 0, (r / 15) * 64, (r % 15) * 256, WSP(bf16_t, WS_WIN) + (size_t)l * NP * D, D); return; }
    it -= 2 * CI_WIN;
    if (it < 2 * CI_WOUT) { const int l = it / CI_WOUT, r = it % CI_WOUT; cvt_item(c, INP(9) + (size_t)l * D * D, nullptr, D, 1, (r / 4) * 64, (r % 4) * 256, WSP(bf16_t, WS_WOUT) + (size_t)l * D * D, D); return; }
    it -= 2 * CI_WOUT;
    if (it < CI_W13) { cvt_item(c, INP(19), INP(20), DFF, 2, (it / 28) * 64, (it % 28) * 256, WSP(bf16_t, WS_W13), D); return; }
    it -= CI_W13;
    cvt_item(c, INP(21), nullptr, D, 1, (it / 4) * 64, (it % 4) * 256, WSP(bf16_t, WS_W2), DFF);
}
constexpr int CI_EARLY = 8 * CI_W2 + NE13 * CI_W13, CI_LATE = (8 - NE13) * CI_W13;
struct CvtJob { const float* s0; const float* s1; int ldsrc, mode, k0, n0; bf16_t* dst; int Kdst; };
__device__ __forceinline__ void cvt_job(const Ctx& c, int pool, int it, CvtJob& j) {
    if (pool == 2) {
        if (it < 2 * CI_WIN) { const int l = it / CI_WIN, r = it % CI_WIN;
            j.s0 = INP(8) + (size_t)l * D * DPROJ; j.s1 = j.s0; j.ldsrc = DPROJ; j.mode = 0; j.k0 = (r / 15) * 64; j.n0 = (r % 15) * 256; j.dst = WSP(bf16_t, WS_WIN) + (size_t)l * NP * D; j.Kdst = D; return; }
        it -= 2 * CI_WIN;
        if (it < 2 * CI_WOUT) { const int l = it / CI_WOUT, r = it % CI_WOUT;
            j.s0 = INP(9) + (size_t)l * D * D; j.s1 = j.s0; j.ldsrc = D; j.mode = 1; j.k0 = (r / 4) * 64; j.n0 = (r % 4) * 256; j.dst = WSP(bf16_t, WS_WOUT) + (size_t)l * D * D; j.Kdst = D; return; }
        it -= 2 * CI_WOUT;
        if (it < CI_W13) { j.s0 = INP(19); j.s1 = INP(20); j.ldsrc = DFF; j.mode = 2; j.k0 = (it / 28) * 64; j.n0 = (it % 28) * 256; j.dst = WSP(bf16_t, WS_W13); j.Kdst = D; return; }
        it -= CI_W13;
        j.s0 = INP(21); j.s1 = j.s0; j.ldsrc = D; j.mode = 1; j.k0 = (it / 4) * 64; j.n0 = (it % 4) * 256; j.dst = WSP(bf16_t, WS_W2); j.Kdst = DFF; return;
    }
    if (pool == 0 && it < 8 * CI_W2) { const int e = it / CI_W2, r = it % CI_W2;
        j.s0 = INP(26) + (size_t)e * DFF * D; j.s1 = j.s0; j.ldsrc = D; j.mode = 1; j.k0 = (r / 4) * 64; j.n0 = (r % 4) * 256; j.dst = (bf16_t*)c.p->out + (size_t)e * D * DFF; j.Kdst = DFF; return; }
    int e, r; bf16_t* base;
    if (pool == 0) { it -= 8 * CI_W2; e = it / CI_W13; r = it % CI_W13; base = WSP(bf16_t, WS_MOEW13E); }
    else { e = NE13 + it / CI_W13; r = it % CI_W13; base = WSP(bf16_t, WS_MOEW13); }
    j.s0 = INP(24) + (size_t)e * D * DFF; j.s1 = INP(25) + (size_t)e * D * DFF; j.ldsrc = DFF; j.mode = 2; j.k0 = (r / 28) * 64; j.n0 = (r % 28) * 256; j.dst = base + (size_t)e * 7168 * D; j.Kdst = D;
}
__device__ __forceinline__ void cvt_issue(const Ctx& c, const CvtJob& j, f32x4 (&v)[4][2]) {
#pragma unroll
    for (int q = 0; q < 4; ++q)
#pragma unroll
        for (int i = 0; i < 2; ++i) {
            const int idx = c.tid + 512 * i, kk = idx >> 4, nn = (idx & 15) * 4, n = j.n0 + 64 * q + nn;
            const float* sp = j.s0; int col = n;
            if (j.mode == 0) col = n + (n >= 2304 ? 16 : 0);
            else if (j.mode == 2) { const int r = n & 255; sp = r < 128 ? j.s0 : j.s1; col = (n >> 8) * 128 + (r & 127); }
            v[q][i] = __builtin_nontemporal_load((const f32x4*)(sp + (size_t)(j.k0 + kk) * j.ldsrc + col));
        }
}
__device__ __forceinline__ void cvt_stream(const Ctx& c, int pool, int nitems, unsigned* q, unsigned* busy, unsigned nshort) {
    float* tile = (float*)c.lds; int* slot = (int*)(c.lds + LDS_CTLOFF + 1024);
#define CVT_PULL(dst_) do { if (c.tid == 0) { int v_ = -1; if (busy == nullptr || __hip_atomic_load(busy, __ATOMIC_RELAXED, __HIP_MEMORY_SCOPE_AGENT) <= nshort) v_ = (int)__hip_atomic_fetch_add(q, 1u, __ATOMIC_RELAXED, __HIP_MEMORY_SCOPE_AGENT); dst_ = v_; } } while (0)
    int it; { int tk = 0; CVT_PULL(tk); if (c.tid == 0) *slot = tk; __syncthreads(); it = *slot; __syncthreads(); }
    if (it < 0 || it >= nitems) return;
    CvtJob j; cvt_job(c, pool, it, j);
    f32x4 v[4][2]; cvt_issue(c, j, v);
    for (;;) {
        int tk = 0; CVT_PULL(tk);
#pragma unroll
        for (int qq = 0; qq < 4; ++qq)
#pragma unroll
            for (int i = 0; i < 2; ++i) { const int idx = c.tid + 512 * i, kk = idx >> 4, nn = (idx & 15) * 4; const float sc = (j.mode == 0 && j.n0 + 64 * qq + nn < 256) ? 0.125f : 1.f;
#pragma unroll
                for (int e = 0; e < 4; ++e) tile[qq * 4160 + kk * 65 + nn + e] = v[qq][i][e] * sc; }
        if (c.tid == 0) *slot = tk;
        __syncthreads();
        const int itn = *slot; const bool more = itn >= 0 && itn < nitems;
        CvtJob jn = j; if (more) { cvt_job(c, pool, itn, jn); cvt_issue(c, jn, v); }
#pragma unroll
        for (int qq = 0; qq < 4; ++qq) {
            const int r = c.tid >> 3, ch = c.tid & 7; float f[8];
#pragma unroll
            for (int e = 0; e < 8; ++e) f[e] = tile[qq * 4160 + (8 * ch + e) * 65 + r];
            *(u32x4*)(j.dst + (size_t)(j.n0 + 64 * qq + r) * j.Kdst + j.k0 + 8 * ch) = pack8(f);
        }
        __syncthreads();
        if (!more) break;
        j = jn;
    }
#undef CVT_PULL
}
__device__ __forceinline__ void early_cvt(const Ctx& c, int slot, int nG, int nunits) {
    unsigned* q = WSP(unsigned, WS_CTL) + CW_CV; unsigned* done = WSP(unsigned, WS_CTL) + CW_CV + 32 + 16 * slot;
    if (c.bid < nG) { if (c.tid == 0) __hip_atomic_fetch_add(done, 1u, __ATOMIC_RELAXED, __HIP_MEMORY_SCOPE_AGENT); return; }
    const unsigned nshort = (nunits % nG) ? (unsigned)(nG - nunits % nG) : 0u;
    cvt_stream(c, 0, CI_EARLY, q, done, nshort);
}
__device__ __forceinline__ void late_cvt(const Ctx& c) {
    unsigned* q = WSP(unsigned, WS_CTL) + CW_CV;
    cvt_stream(c, 0, CI_EARLY, q, nullptr, 0u);
    cvt_stream(c, 1, CI_LATE, q + 16, nullptr, 0u);
}

__device__ __forceinline__ void phase_prologue(const Ctx& c) {
    {
        float* sv = (float*)c.lds;
        float* red = sv + 3 * 1024;
        for (int i = c.tid; i < 3 * 1024; i += 512) { const int s = i >> 10, k = i & 1023; const float x = s < 2 ? INP(1)[s * D + k] : INP(3)[k]; sv[i] = siluf_(x); }
        __syncthreads();
        for (int it = c.bid; it < 2 * 96; it += c.G) {
            const int l = it / 96, n0 = (it % 96) * 64, c4 = c.tid & 15, kg = c.tid >> 4;
            const float* w = INP(4) + (size_t)l * D * 6144 + n0 + 4 * c4;
            f32x4 a0 = (f32x4){0.f, 0.f, 0.f, 0.f}, a1 = a0, a2 = a0;
#pragma unroll 16
            for (int jj = 0; jj < 32; ++jj) { const int k = kg + 32 * jj; const f32x4 wv = __builtin_nontemporal_load((const f32x4*)(w + (size_t)k * 6144)); a0 += sv[k] * wv; a1 += sv[1024 + k] * wv; a2 += sv[2048 + k] * wv; }
            *(f32x4*)(red + (kg * 3 + 0) * 64 + 4 * c4) = a0; *(f32x4*)(red + (kg * 3 + 1) * 64 + 4 * c4) = a1; *(f32x4*)(red + (kg * 3 + 2) * 64 + 4 * c4) = a2;
            __syncthreads();
            if (c.tid < 192) { const int s = c.tid >> 6, col = c.tid & 63; float a = INP(5)[l * 6144 + n0 + col];
#pragma unroll 8
                for (int q = 0; q < 32; ++q) a += red[(q * 3 + s) * 64 + col];
                WSP(float, WS_MOD)[(l * 3 + s) * 6144 + n0 + col] = a; }
            __syncthreads();
        }
    }
    {
        const int gt = c.bid * 512 + c.tid, GT = c.G * 512;
        for (int i = gt; i < 2 * 16 * 1024; i += GT) { const int l = i >> 14, j = (i >> 10) & 15, k = i & 1023; WSP(float, WS_WG)[i] = INP(8)[(size_t)l * D * DPROJ + (size_t)k * DPROJ + 2304 + j]; }
        for (int i = gt; i < 8 * 1024; i += GT) { const int e = i >> 10, k = i & 1023; WSP(float, WS_WR)[i] = INP(22)[k * 8 + e]; }
        for (int i = gt; i < 128 * 16; i += GT) { const int pos = i >> 4, f = i & 15; const float inv = powf(10000.f, -(float)f / 16.f); const float ang = (float)pos * inv;
            WSP(float, WS_ROPE)[i] = cosf(ang); WSP(float, WS_ROPE)[2048 + i] = sinf(ang); }
        for (int i = gt; i < NSLOTS; i += GT) WSP(int, WS_SLOTTOK)[i] = 0;
    }
    __syncthreads();
    cvt_stream(c, 2, CI_DENSE, WSP(unsigned, WS_CTL) + CW_CV + 96, nullptr, 0u);
}

__device__ __forceinline__ void norm_row(const Ctx& c, int l, int which, int NG, int row, f32x4 (&v)[4], const float* wl, unsigned* hist) {
    const int s = row < SEQ ? 0 : (row < NLAT ? 1 : 2);
    const float* ng = INP(which == 1 ? 6 : 7) + l * D;
    const float* mod = WSP(float, WS_MOD) + (size_t)l * 3 * 6144;
    bf16_t* H = WSP(bf16_t, WS_H);
    float ss = 0.f;
#pragma unroll
    for (int j = 0; j < 4; ++j) ss += (v[j].x * v[j].x + v[j].y * v[j].y) + (v[j].z * v[j].z + v[j].w * v[j].w);
    const float r = rsqrtf(wave_sum(ss) * (1.f / D) + EPS);
    const float* sh = mod + s * 6144 + (which == 1 ? 0 : 3072); const float* sc = sh + 1024;
#pragma unroll
    for (int j = 0; j < 4; ++j) { const int col = 4 * c.lane + 256 * j;
        const f32x4 g = *(const f32x4*)(ng + col), a = *(const f32x4*)(sc + col), b = *(const f32x4*)(sh + col);
        v[j] = (v[j] * r) * g * (a + 1.f) + b;
        u32x2 w; w.x = pk2(v[j].x, v[j].y); w.y = pk2(v[j].z, v[j].w);
        *(u32x2*)(H + (size_t)row * D + col) = w; }
    if (NG) {
        float mine = 0.f;
#pragma unroll 2
        for (int q = 0; q < NG; ++q) { float a = 0.f;
#pragma unroll
            for (int j = 0; j < 4; ++j) { const f32x4 w = *(const f32x4*)(wl + q * 1024 + 4 * c.lane + 256 * j); a += (v[j].x * w.x + v[j].y * w.y) + (v[j].z * w.z + v[j].w * w.w); }
            a = wave_sum(a); if (c.lane == q) mine = a; }
        if (NG == 16) { if (c.lane < 16) WSP(float, WS_GATES)[(size_t)row * 16 + c.lane] = mine; }
        else {
            float lg[8];
#pragma unroll
            for (int q = 0; q < 8; ++q) lg[q] = __shfl(mine, q) + INP(23)[q];
            int e0 = 0; float m0 = lg[0];
#pragma unroll
            for (int q = 1; q < 8; ++q) if (lg[q] > m0) { m0 = lg[q]; e0 = q; }
            int e1 = -1; float m1 = -3.0e38f;
#pragma unroll
            for (int q = 0; q < 8; ++q) if (q != e0 && lg[q] > m1) { m1 = lg[q]; e1 = q; }
            const float g0 = 1.f / (1.f + expf(m1 - m0)), g1 = 1.f - g0;
            if (c.lane == 0) { WSP(int, WS_TOKE)[row * 2] = e0; WSP(int, WS_TOKE)[row * 2 + 1] = e1; WSP(float, WS_TOKG)[row * 2] = g0; WSP(float, WS_TOKG)[row * 2 + 1] = g1;
                atomicAdd(&hist[e0], 1u); atomicAdd(&hist[e1], 1u); }
        }
    }
}
__device__ __forceinline__ void phase_norm(const Ctx& c, int l, int which) {
    const int NG = which == 1 ? 16 : (l == 1 ? 8 : 0);
    float* wl = (float*)c.lds;
    unsigned* hist = (unsigned*)(c.lds + 65536);
    if (NG) { const float* src = which == 1 ? WSP(float, WS_WG) + l * 16 * 1024 : WSP(float, WS_WR);
        for (int i = c.tid; i < NG * 1024; i += 512) wl[i] = src[i]; }
    if (c.tid < 8) hist[c.tid] = 0u;
    __syncthreads();
    if (l == 0 && which == 1) {
        const float* xl = INP(0);
        f32x4 nx[4];
        { const int row0 = c.bid * 8 + c.wave; if (row0 < NLAT) {
#pragma unroll
            for (int j = 0; j < 4; ++j) nx[j] = *(const f32x4*)(xl + (size_t)row0 * D + 4 * c.lane + 256 * j); } }
        for (int row = c.bid * 8 + c.wave; row < NLAT; row += c.G * 8) {
            f32x4 v[4];
#pragma unroll
            for (int j = 0; j < 4; ++j) v[j] = nx[j];
            { const int nrow = row + c.G * 8; if (nrow < NLAT) {
#pragma unroll
                for (int j = 0; j < 4; ++j) nx[j] = *(const f32x4*)(xl + (size_t)nrow * D + 4 * c.lane + 256 * j); } }
            norm_row(c, l, which, NG, row, v, wl, hist);
        }
    } else {
        const bf16_t* xl = WSP(bf16_t, WS_XB);
        u32x2 nx[4];
        { const int row0 = c.bid * 8 + c.wave; if (row0 < NLAT) {
#pragma unroll
            for (int j = 0; j < 4; ++j) nx[j] = *(const u32x2*)(xl + (size_t)row0 * D + 4 * c.lane + 256 * j); } }
        for (int row = c.bid * 8 + c.wave; row < NLAT; row += c.G * 8) {
            f32x4 v[4];
#pragma unroll
            for (int j = 0; j < 4; ++j) v[j] = (f32x4){__uint_as_float(nx[j].x << 16), __uint_as_float(nx[j].x & 0xffff0000u), __uint_as_float(nx[j].y << 16), __uint_as_float(nx[j].y & 0xffff0000u)};
            { const int nrow = row + c.G * 8; if (nrow < NLAT) {
#pragma unroll
                for (int j = 0; j < 4; ++j) nx[j] = *(const u32x2*)(xl + (size_t)nrow * D + 4 * c.lane + 256 * j); } }
            norm_row(c, l, which, NG, row, v, wl, hist);
        }
    }
    if (!(l == 1 && which == 2)) {
        for (int r = c.bid * 8 + c.wave; r < NCTX; r += c.G * 8) {
            const float* xb = (l == 0) ? INP(2) + (size_t)r * D : WSP(float, WS_XC) + (size_t)r * D;
            f32x4 v[4];
#pragma unroll
            for (int j = 0; j < 4; ++j) v[j] = *(const f32x4*)(xb + 4 * c.lane + 256 * j);
            if (!(l == 0 && which == 1)) {
                const int S = (l == 0) ? CTX_SPLIT_O : CTX_SPLIT_F;
                const float* part = ((l == 0) ? WSP(float, WS_PARTO) : WSP(float, WS_PARTF)) + (size_t)r * D;
                const float* gate = WSP(float, WS_MOD) + 2 * 6144 + ((l == 0) ? 2048 : 5120);
                f32x4 acc[4];
#pragma unroll
                for (int j = 0; j < 4; ++j) acc[j] = (f32x4){0.f, 0.f, 0.f, 0.f};
                for (int ks = 0; ks < S; ++ks) {
#pragma unroll
                    for (int j = 0; j < 4; ++j) acc[j] += *(const f32x4*)(part + (size_t)ks * NCTX * D + 4 * c.lane + 256 * j); }
#pragma unroll
                for (int j = 0; j < 4; ++j) { v[j] += *(const f32x4*)(gate + 4 * c.lane + 256 * j) * acc[j];
                    if (l == 0) *(f32x4*)(WSP(float, WS_XC) + (size_t)r * D + 4 * c.lane + 256 * j) = v[j]; }
            }
            norm_row(c, l, which, NG, NLAT + r, v, wl, hist);
        }
    }
    __syncthreads();
    if (NG == 8) {
        if (c.tid < 8) atomicAdd(WSP(unsigned, WS_CTL) + CW_CNT + c.tid, hist[c.tid]);
        asm volatile("s_waitcnt vmcnt(0)" ::: "memory");
        __syncthreads();
        if (c.tid == 0) { __builtin_amdgcn_fence(__ATOMIC_RELEASE, "agent"); __hip_atomic_fetch_add(WSP(unsigned, WS_CTL) + CW_RT, 1u, __ATOMIC_RELAXED, __HIP_MEMORY_SCOPE_AGENT); }
    }
    __syncthreads();
}
#ifndef AMP_ITEM
#define AMP_ITEM 0
#endif
#if AMP_ITEM
#define AMP_T0() const unsigned long long at0_ = __builtin_amdgcn_s_memrealtime()
#define AMP_SPIN(bit) do { if ((AMP_ITEM >> (bit)) & 1) { const unsigned long long at1_ = __builtin_amdgcn_s_memrealtime(); while (__builtin_amdgcn_s_memrealtime() < at1_ + (at1_ - at0_)) __builtin_amdgcn_s_sleep(4); } } while (0)
#else
#define AMP_T0() do {} while (0)
#define AMP_SPIN(bit) do {} while (0)
#endif
#define AMP_T1() const unsigned long long at0_ = __builtin_amdgcn_s_memrealtime()
__device__ __forceinline__ float gdn_gates(const Ctx& c, int l, int h, int dir, int base, int tau, float& beta) {
    const int tok = dir ? 63 - tau : tau;
    const float* gr = WSP(float, WS_GATES) + (size_t)(base + tok) * 16;
    const float a = gr[dir * 4 + h], bb = gr[8 + dir * 4 + h];
    const float xs = a + INP(14)[l * 8 + dir * 4 + h];
    const float la = -__expf(INP(13)[l * 8 + dir * 4 + h]) * (xs > 20.f ? xs : __logf(1.f + __expf(xs)));
    beta = __builtin_amdgcn_rcpf(1.f + __expf(-bb));
    return wave_scan(la);
}

__device__ __forceinline__ void m1_gdn_item(const Ctx& c, int l, int b, int h, int cid) {
    unsigned char* L0 = c.lds;
    float* raw = (float*)L0;
    float* Lm = (float*)L0;
    bf16_t* QKm = (bf16_t*)L0;
    bf16_t* WT = (bf16_t*)(L0 + 32768);
    float* cw = (float*)(L0 + 53312);
    float* gl = (float*)(L0 + 57344);
    bf16_t* Qf = (bf16_t*)(L0 + 58368);
    bf16_t* Kf = Qf + 64 * LDP; bf16_t* Vf = Kf + 64 * LDP;
    bf16_t* KdT = Vf + 64 * LDP;
    bf16_t* U0T = KdT + 2 * 64 * LDP;
    const int base = chunk_row(b, cid), t0 = cid < 128 ? cid * 64 : (cid - 128) * 64, slen = cid < 128 ? SEQ : CTXL;
    const bf16_t* P = WSP(bf16_t, WS_P);
    { AMP_T0();
    u32x4 rv[4]; float cwv[2]; f32x4 rcs[2], rsn[2]; float ga_ = 0.f, gb_ = 0.f, gdt_ = 0.f, gal_ = 0.f;
#pragma unroll
    for (int i = 0; i < 4; ++i) { const int idx = c.tid + 512 * i, rr = idx / 24, ch = idx % 24, part = ch >> 3, c8 = ch & 7, tt = t0 + rr - 2;
        rv[i] = (u32x4){0u, 0u, 0u, 0u};
        if (idx < 68 * 24 && tt >= 0 && tt < slen) rv[i] = *(const u32x4*)(P + (size_t)(base + rr - 2) * NP + C_GQ + part * 256 + h * 64 + c8 * 8); }
#pragma unroll
    for (int i = 0; i < 2; ++i) { const int ii = c.tid + 512 * i; cwv[i] = 0.f;
        if (ii < 5 * 192) { const int k = ii / 192, j = ii % 192, part = j >> 6, d = j & 63; cwv[i] = INP(12)[(size_t)l * 5 * 768 + k * 768 + part * 256 + h * 64 + d]; } }
    {
        const int t = c.tid >> 3, sub = c.tid & 7; const int i0 = (sub & 3) * 8, pos = i0 < 16 ? (cid < 128 ? cid : 0) : t, f0 = i0 & 15;
        const float* ct = WSP(float, WS_ROPE) + pos * 16 + f0; const float* st = ct + 2048;
        rcs[0] = *(const f32x4*)ct; rcs[1] = *(const f32x4*)(ct + 4); rsn[0] = *(const f32x4*)st; rsn[1] = *(const f32x4*)(st + 4);
    }
    if (c.wave < 2) { const int dirw = c.wave, tok = dirw ? 63 - c.lane : c.lane; const float* gr = WSP(float, WS_GATES) + (size_t)(base + tok) * 16;
        ga_ = gr[dirw * 4 + h]; gb_ = gr[8 + dirw * 4 + h]; gdt_ = INP(14)[l * 8 + dirw * 4 + h]; gal_ = INP(13)[l * 8 + dirw * 4 + h]; }
#pragma unroll
    for (int i = 0; i < 4; ++i) { const int idx = c.tid + 512 * i, rr = idx / 24, ch = idx % 24, part = ch >> 3, c8 = ch & 7;
        if (idx < 68 * 24) { float f[8]; unpack8(rv[i], f);
            *(f32x4*)(raw + rr * 196 + part * 64 + c8 * 8) = (f32x4){f[0], f[1], f[2], f[3]}; *(f32x4*)(raw + rr * 196 + part * 64 + c8 * 8 + 4) = (f32x4){f[4], f[5], f[6], f[7]}; } }
#pragma unroll
    for (int i = 0; i < 2; ++i) { const int ii = c.tid + 512 * i; if (ii < 5 * 192) cw[ii] = cwv[i]; }
    if (c.wave < 2) {
        const float xs = ga_ + gdt_;
        const float la = -__expf(gal_) * (xs > 20.f ? xs : __logf(1.f + __expf(xs)));
        gl[128 + c.wave * 64 + c.lane] = __builtin_amdgcn_rcpf(1.f + __expf(-gb_));
        gl[c.wave * 64 + c.lane] = wave_scan(la); }
    __syncthreads();
    {
        const int t = c.tid >> 3, sub = c.tid & 7;
        float y[3][8];
#pragma unroll
        for (int part = 0; part < 3; ++part) { const int j0 = part * 64 + sub * 8; f32x4 a0 = (f32x4){0.f, 0.f, 0.f, 0.f}, a1 = a0;
#pragma unroll
            for (int k = 0; k < 5; ++k) { a0 += *(const f32x4*)(cw + k * 192 + j0) * *(const f32x4*)(raw + (t + k) * 196 + j0); a1 += *(const f32x4*)(cw + k * 192 + j0 + 4) * *(const f32x4*)(raw + (t + k) * 196 + j0 + 4); }
#pragma unroll
            for (int e = 0; e < 4; ++e) { y[part][e] = siluf_(a0[e]); y[part][4 + e] = siluf_(a1[e]); } }
#pragma unroll
        for (int part = 0; part < 2; ++part) { float ss = 0.f;
#pragma unroll
            for (int e = 0; e < 8; ++e) ss += y[part][e] * y[part][e];
            ss = sum8(ss);
            const float r = rsqrtf(ss + EPS);
#pragma unroll
            for (int e = 0; e < 8; ++e) y[part][e] *= r; }
        if (cid < 128) {
#pragma unroll
            for (int part = 0; part < 2; ++part)
#pragma unroll
                for (int e = 0; e < 8; ++e) {
                    const float other = __shfl_xor(y[part][e], 4);
                    const float cs = rcs[e >> 2][e & 3], sn = rsn[e >> 2][e & 3];
                    y[part][e] = sub < 4 ? y[part][e] * cs - other * sn : other * sn + y[part][e] * cs;
                }
        }
#pragma unroll
        for (int e = 0; e < 8; ++e) y[0][e] *= 0.125f;
        *(u32x4*)(Qf + t * LDP + sub * 8) = pack8(y[0]); *(u32x4*)(Kf + t * LDP + sub * 8) = pack8(y[1]); *(u32x4*)(Vf + t * LDP + sub * 8) = pack8(y[2]);
    }
    __syncthreads();
    AMP_SPIN(8); }
    const int dir = c.wave >> 2, w4 = c.wave & 3;
    const float* gd = gl + dir * 64; const float* bd = gl + 128 + dir * 64;
    const int r16 = c.lane & 15, g4 = c.lane >> 4;
#define PROW(tau_) (dir ? 63 - (tau_) : (tau_))
#define PTILE(buf, tile_) ((buf) + (dir ? (63 - 16 * (tile_)) * LDP : 16 * (tile_) * LDP))
    const int PLD = dir ? -LDP : LDP;
    { AMP_T0(); {
        const int tt = w4;
        for (int st = 0; st <= tt; ++st) {
            const f32x4 a = mm16(PTILE(Kf, tt), PLD, PTILE(Kf, st), PLD, (f32x4){0.f, 0.f, 0.f, 0.f}, c.lane);
            const int s = 16 * st + r16;
#pragma unroll
            for (int e = 0; e < 4; ++e) { const int t = 16 * tt + 4 * g4 + e; Lm[dir * 4096 + t * 64 + s] = s < t ? bd[t] * a[e] * __expf(gd[t] - gd[s]) : 0.f; }
        }
    }
    __syncthreads(); AMP_SPIN(10); }
    { AMP_T0();
    {
        for (int i = c.tid; i < 8192; i += 512) { const int dd = i >> 12, d = (i >> 6) & 63, tau = i & 63;
            const float* gq = gl + dd * 64;
            KdT[dd * 64 * LDP + d * LDP + tau] = (bf16_t)f2bf(bf2f(Kf[(dd ? 63 - tau : tau) * LDP + d]) * __expf(gq[63] - gq[tau])); }
        float* Lb = Lm + dir * 4096 + (16 * w4) * 64 + 16 * w4;
        const int j = c.lane & 15;
        float X[16];
#pragma unroll
        for (int r = 0; r < 16; ++r) {
            float a = (r == j) ? 1.f : 0.f;
#pragma unroll
            for (int s4 = 0; s4 < (r + 3) / 4; ++s4) { const f32x4 lv = *(const f32x4*)(Lb + r * 64 + 4 * s4);
#pragma unroll
                for (int e = 0; e < 4; ++e) if (4 * s4 + e < r) a -= lv[e] * X[4 * s4 + e]; }
            X[r] = a;
        }
        asm volatile("s_waitcnt lgkmcnt(0)" ::: "memory");
        if (c.lane < 16) {
#pragma unroll
            for (int r = 0; r < 16; ++r) Lb[r * 64 + j] = X[r]; }
    }
    __syncthreads();
    {
        const float* Ls = Lm + dir * 4096;
        f32x4 X[2][4];
#pragma unroll
        for (int i = 0; i < 4; ++i)
#pragma unroll
            for (int q = 0; q < 2; ++q) {
                const int ct = 2 * w4 + q, part = ct >> 2, col = 16 * (ct & 3) + r16;
                const bf16_t* Sp = part ? Vf : Kf;
                f32x4 acc;
#pragma unroll
                for (int e = 0; e < 4; ++e) { const int tau = 16 * i + 4 * g4 + e; const float x = bf2f(Sp[PROW(tau) * LDP + col]); acc[e] = part ? bd[tau] * x : bd[tau] * __expf(gd[tau]) * x; }
#pragma unroll
                for (int jb = 0; jb < 4; ++jb) if (jb < i) { const f32x4 lv = *(const f32x4*)(Ls + (16 * i + r16) * 64 + 16 * jb + 4 * g4);
#pragma unroll
                    for (int e = 0; e < 4; ++e) acc = __builtin_amdgcn_mfma_f32_16x16x4f32(-lv[e], X[q][jb][e], acc, 0, 0, 0); }
                const f32x4 ti = *(const f32x4*)(Ls + (16 * i + r16) * 64 + 16 * i + 4 * g4);
                f32x4 xi = (f32x4){0.f, 0.f, 0.f, 0.f};
#pragma unroll
                for (int e = 0; e < 4; ++e) xi = __builtin_amdgcn_mfma_f32_16x16x4f32(ti[e], acc[e], xi, 0, 0, 0);
                X[q][i] = xi;
            }
#pragma unroll
        for (int q = 0; q < 2; ++q) {
            const int ct = 2 * w4 + q, part = ct >> 2, col = 16 * (ct & 3) + r16;
            bf16_t* ldst = (part ? U0T : WT) + dir * 64 * LDP + col * LDP;
#pragma unroll
            for (int i = 0; i < 4; ++i) { const f32x4 x = X[q][i]; u32x2 w; w.x = pk2(x[0], x[1]); w.y = pk2(x[2], x[3]); *(u32x2*)(ldst + 16 * i + 4 * g4) = w; }
        }
    }
    __syncthreads(); AMP_SPIN(11); }
    const size_t idx = (size_t)(((b * 4 + h) * 2 + dir) * NCH + cid);
    {
        const int dt = w4; const float ge = __expf(gd[63]);
        bf16_t* Ag = WSP(bf16_t, WS_GA) + idx * 4096; float* Bg = WSP(float, WS_GB) + idx * 4096;
        const int d = 16 * dt + r16;
#pragma unroll
        for (int ct = 0; ct < 4; ++ct) {
            const f32x4 a = mm16(WT + dir * 64 * LDP + ct * 16 * LDP, LDP, KdT + dir * 64 * LDP + dt * 16 * LDP, LDP, (f32x4){0.f, 0.f, 0.f, 0.f}, c.lane);
            const int d1 = 16 * ct + 4 * g4; float o[4];
#pragma unroll
            for (int e = 0; e < 4; ++e) o[e] = ((d1 + e == d) ? ge : 0.f) - a[e];
            u32x2 w; w.x = pk2(o[0], o[1]); w.y = pk2(o[2], o[3]); *(u32x2*)(Ag + (((dt * 2 + (ct >> 1)) * 64 + c.lane) * 8 + 4 * (ct & 1))) = w;
        }
#pragma unroll
        for (int vt = 0; vt < 4; ++vt) {
            const f32x4 a = mm16(KdT + dir * 64 * LDP + dt * 16 * LDP, LDP, U0T + dir * 64 * LDP + vt * 16 * LDP, LDP, (f32x4){0.f, 0.f, 0.f, 0.f}, c.lane);
            *(f32x4*)(Bg + ((vt * 4 + dt) * 64 + c.lane) * 4) = a;
        }
        const int tt = w4;
#pragma unroll
        for (int st = 0; st < 4; ++st) {
            f32x4 a = (f32x4){0.f, 0.f, 0.f, 0.f};
            if (st <= tt) a = mm16(PTILE(Qf, tt), PLD, PTILE(Kf, st), PLD, a, c.lane);
            const int sg = 16 * st + r16;
#pragma unroll
            for (int e = 0; e < 4; ++e) { const int t = 16 * tt + 4 * g4 + e; const float v = (sg <= t) ? a[e] * __expf(gd[t] - gd[sg]) : 0.f; QKm[dir * 64 * LDP + t * LDP + sg] = (bf16_t)f2bf(v); }
        }
    }
    __syncthreads();
    {
        const int tt = w4;
        bf16_t* Qg_ = WSP(bf16_t, WS_GW) + idx * 4096; bf16_t* Og_ = WSP(bf16_t, WS_GU) + idx * 4096;
        const int tau = 16 * tt + r16; const float eg = __expf(gd[tau]);
#pragma unroll
        for (int dt = 0; dt < 4; ++dt) {
            const f32x4 a = mm16(WT + dir * 64 * LDP + dt * 16 * LDP, LDP, QKm + dir * 64 * LDP + tt * 16 * LDP, LDP, (f32x4){0.f, 0.f, 0.f, 0.f}, c.lane);
            const u32x2 qv = *(const u32x2*)(Qf + PROW(tau) * LDP + 16 * dt + 4 * g4);
            const float q0 = __uint_as_float(qv.x << 16), q1 = __uint_as_float(qv.x & 0xffff0000u), q2 = __uint_as_float(qv.y << 16), q3 = __uint_as_float(qv.y & 0xffff0000u);
            u32x2 w; w.x = pk2(q0 * eg - a[0], q1 * eg - a[1]); w.y = pk2(q2 * eg - a[2], q3 * eg - a[3]);
            *(u32x2*)(Qg_ + tau * 64 + 16 * dt + 4 * g4) = w;
        }
#pragma unroll
        for (int vt = 0; vt < 4; ++vt) {
            const f32x4 a = mm16(QKm + dir * 64 * LDP + tt * 16 * LDP, LDP, U0T + dir * 64 * LDP + vt * 16 * LDP, LDP, (f32x4){0.f, 0.f, 0.f, 0.f}, c.lane);
            u32x2 w; w.x = pk2(a[0], a[1]); w.y = pk2(a[2], a[3]);
            *(u32x2*)(Og_ + (16 * vt + r16) * 64 + 16 * tt + 4 * g4) = w;
        }
    }
#undef PROW
#undef PTILE
    __syncthreads();
}

__device__ __forceinline__ void hgrn_fk(float z, float lb, float& logf, float& k) {
    const float e = __expf(-fabsf(z)), inv = __builtin_amdgcn_rcpf(1.f + e);
    const float f = (z >= 0.f ? 1.f + lb * e : e + lb) * inv;
    logf = __logf(f);
    k = (1.f - lb) * (z >= 0.f ? e : 1.f) * inv;
}
constexpr int LDS_HLB = 122880;
__device__ __forceinline__ float hgrn_lb(const Ctx& c, int l, int dir, int ch) { return ((const float*)(c.lds + LDS_HLB))[dir * 256 + ch]; }
__device__ __forceinline__ void hgrn_lb_stage(const Ctx& c, int l) {
    float v = 0.f;
    if (l != 0) { const int dir = c.tid >> 8, ch = c.tid & 255; const float r0 = INP(10)[dir * 2 * 256 + ch], r1 = INP(10)[dir * 2 * 256 + 256 + ch]; v = __builtin_amdgcn_rcpf(1.f + __expf(r0 - r1)); }
    ((float*)(c.lds + LDS_HLB))[c.tid] = v;
    __syncthreads();
}
struct M1H { u32x4 z[2], q[2], v[2]; };
__device__ __forceinline__ void m1_hgrn_load(const Ctx& c, int b, int h, int cid, M1H& r) {
    const int base = chunk_row(b, cid), t = c.tid >> 3, sub = c.tid & 7;
#pragma unroll
    for (int dir = 0; dir < 2; ++dir) { const bf16_t* pr = WSP(bf16_t, WS_P) + (size_t)(base + (dir ? 63 - t : t)) * NP + h * 64 + sub * 8;
        r.z[dir] = *(const u32x4*)(pr + (dir ? C_HFB : C_HFF)); r.q[dir] = *(const u32x4*)(pr + C_HQ); r.v[dir] = *(const u32x4*)(pr + C_HI); }
}
__device__ __forceinline__ void m1_hgrn_item(const Ctx& c, int l, int b, int h, int cid, const M1H& rh) {
    unsigned char* L0 = c.lds;
    float* LF = (float*)L0;
    float* OUT = LF + 64 * 65;
    bf16_t* VT = (bf16_t*)(OUT + 64 * 65);
    bf16_t* KtT = VT + 64 * LDP;
    bf16_t* Qd = KtT + 64 * LDP; bf16_t* Kd = Qd + 64 * LDP; bf16_t* Ko = Kd + 64 * LDP;
    bf16_t* Qo = Ko + 64 * LDP;
    bf16_t* Am = Qo + 3 * 64 * LDP;
    const int t = c.tid >> 3, sub = c.tid & 7, r16 = c.lane & 15, g4 = c.lane >> 4;
#pragma unroll
    for (int dir = 0; dir < 2; ++dir) {
        const size_t idx = (size_t)(((b * 4 + h) * 2 + dir) * NCH + cid);
        float q[8], kk[8];
        {
            float z[8], vv[8];
            unpack8(rh.z[dir], z); unpack8(rh.q[dir], q); unpack8(rh.v[dir], vv);
#pragma unroll
            for (int e = 0; e < 8; ++e) { const int d = sub * 8 + e; float lf; hgrn_fk(z[e], hgrn_lb(c, l, dir, h * 64 + d), lf, kk[e]); LF[t * 65 + d] = lf; VT[d * LDP + t] = (bf16_t)f2bf(vv[e]); }
            *(u32x4*)(Am + t * LDP + sub * 8) = (u32x4){0u, 0u, 0u, 0u};
        }
        __syncthreads();
#pragma unroll
        for (int j = 0; j < 8; ++j) { float* col = LF + c.wave * 8 + j; const float a = wave_scan(col[c.lane * 65]); col[c.lane * 65] = a;
            if (c.lane == 63) WSP(float, WS_HA)[idx * 64 + c.wave * 8 + j] = __expf(a); }
        __syncthreads();
        {
            const int i = t >> 4;
            float fd[8], fkd[8], fko[8], fg[8], fo[3][8];
#pragma unroll
            for (int e = 0; e < 8; ++e) { const int d = sub * 8 + e; const float bt = LF[t * 65 + d];
                const float refd = i > 0 ? LF[(16 * i - 1) * 65 + d] : 0.f;
                fd[e] = q[e] * __expf(bt - refd); fkd[e] = kk[e] * __expf(refd - bt);
                fko[e] = kk[e] * __expf(LF[(16 * i + 15) * 65 + d] - bt);
                fg[e] = q[e] * __expf(bt);
                KtT[d * LDP + t] = (bf16_t)f2bf(kk[e] * __expf(LF[63 * 65 + d] - bt));
#pragma unroll
                for (int j = 0; j < 3; ++j) fo[j][e] = i > j ? q[e] * __expf(bt - LF[(16 * j + 15) * 65 + d]) : 0.f; }
            *(u32x4*)(Qd + t * LDP + sub * 8) = pack8(fd); *(u32x4*)(Kd + t * LDP + sub * 8) = pack8(fkd); *(u32x4*)(Ko + t * LDP + sub * 8) = pack8(fko);
            *(u32x4*)(WSP(bf16_t, WS_HQ) + idx * 4096 + t * 64 + sub * 8) = pack8(fg);
#pragma unroll
            for (int j = 0; j < 3; ++j) *(u32x4*)(Qo + j * 64 * LDP + t * LDP + sub * 8) = pack8(fo[j]);
        }
        __syncthreads();
        for (int ti = c.wave; ti < 10; ti += 8) {
            const int i = ti < 1 ? 0 : (ti < 3 ? 1 : (ti < 6 ? 2 : 3)), j = ti - (i * (i + 1)) / 2;
            f32x4 a;
            if (i == j) a = mm16(Qd + i * 16 * LDP, LDP, Kd + j * 16 * LDP, LDP, (f32x4){0.f, 0.f, 0.f, 0.f}, c.lane);
            else a = mm16(Qo + j * 64 * LDP + i * 16 * LDP, LDP, Ko + j * 16 * LDP, LDP, (f32x4){0.f, 0.f, 0.f, 0.f}, c.lane);
#pragma unroll
            for (int e = 0; e < 4; ++e) { const int tl = 4 * g4 + e; const float v = (i != j || r16 <= tl) ? a[e] : 0.f; Am[(16 * i + tl) * LDP + 16 * j + r16] = (bf16_t)f2bf(v); }
        }
        {
            const int dt = c.wave >> 1; float* Bg = WSP(float, WS_HB) + idx * 4096;
#pragma unroll
            for (int q2 = 0; q2 < 2; ++q2) { const int vt = 2 * (c.wave & 1) + q2;
                const f32x4 a = mm16(KtT + dt * 16 * LDP, LDP, VT + vt * 16 * LDP, LDP, (f32x4){0.f, 0.f, 0.f, 0.f}, c.lane);
                *(f32x4*)(Bg + (16 * vt + r16) * 64 + 16 * dt + 4 * g4) = a; }
        }
        __syncthreads();
        {
            const int tt = c.wave >> 1;
#pragma unroll
            for (int q2 = 0; q2 < 2; ++q2) { const int vt = 2 * (c.wave & 1) + q2;
                const f32x4 a = mm16(Am + tt * 16 * LDP, LDP, VT + vt * 16 * LDP, LDP, (f32x4){0.f, 0.f, 0.f, 0.f}, c.lane);
#pragma unroll
                for (int e = 0; e < 4; ++e) { const int tau = 16 * tt + 4 * g4 + e; float* op = OUT + (dir ? 63 - tau : tau) * 65 + 16 * vt + r16; if (dir) *op += a[e]; else *op = a[e]; }
            }
        }
        __syncthreads();
    }
    {
        float f[8];
#pragma unroll
        for (int e = 0; e < 8; ++e) f[e] = OUT[t * 65 + sub * 8 + e];
        float* og = WSP(float, WS_HO) + (size_t)((b * 4 + h) * NCH + cid) * 4096 + t * 64 + sub * 8;
        *(f32x4*)og = (f32x4){f[0], f[1], f[2], f[3]}; *(f32x4*)(og + 4) = (f32x4){f[4], f[5], f[6], f[7]};
    }
    __syncthreads();
}

struct M1N { u32x4 q[4], k[4], v[4]; };
__device__ __forceinline__ void m1_na_load(const Ctx& c, int b, int hq, int cid, M1N& r) {
    const int t = c.tid >> 3, sub = c.tid & 7;
    const bf16_t* pr = WSP(bf16_t, WS_P) + (size_t)(chunk_row(b, cid) + t) * NP + hq * 256 + sub * 8;
#pragma unroll
    for (int hh = 0; hh < 4; ++hh) { r.q[hh] = *(const u32x4*)(pr + hh * 64 + C_NQ); r.k[hh] = *(const u32x4*)(pr + hh * 64 + C_NK); r.v[hh] = *(const u32x4*)(pr + hh * 64 + C_NV); }
}
__device__ __forceinline__ void m1_na_item4(const Ctx& c, int l, int b, int hq, int cid, const M1N& rn_) {
    bf16_t* VTt = (bf16_t*)c.lds;
    const int base = chunk_row(b, cid), t = c.tid >> 3, sub = c.tid & 7;
    bf16_t* pr = WSP(bf16_t, WS_P) + (size_t)(base + t) * NP + hq * 256 + sub * 8;
#pragma unroll
    for (int hh = 0; hh < 4; ++hh) {
#pragma unroll
        for (int part = 0; part < 2; ++part) {
            float f[8]; unpack8(part ? rn_.k[hh] : rn_.q[hh], f);
            float ss = 0.f;
#pragma unroll
            for (int e = 0; e < 8; ++e) ss += f[e] * f[e];
            ss = sum8(ss);
            const float r = rsqrtf(ss * (1.f / 64.f) + EPS) * (part ? 1.f : 0.125f);
            const float* gw = INP(part ? 17 : 16) + l * 64 + sub * 8;
#pragma unroll
            for (int e = 0; e < 8; ++e) f[e] = f[e] * r * gw[e];
            *(u32x4*)(pr + hh * 64 + (part ? C_NK : C_NQ)) = pack8(f);
        }
        {
            const u32x4 v = rn_.v[hh]; bf16_t* vt = VTt + hh * 64 * LDP;
#pragma unroll
            for (int i = 0; i < 4; ++i) { vt[(sub * 8 + 2 * i) * LDP + t] = (bf16_t)(v[i] & 0xffffu); vt[(sub * 8 + 2 * i + 1) * LDP + t] = (bf16_t)(v[i] >> 16); }
        }
    }
    __syncthreads();
    {
        const int d = c.tid >> 3, s8 = c.tid & 7;
        const int tok = cid < 128 ? cid * 64 : SEQ + (cid - 128) * 64;
#pragma unroll
        for (int hh = 0; hh < 4; ++hh)
            *(u32x4*)(WSP(bf16_t, WS_VT) + ((size_t)(b * 8 + 4 * hq + hh) * 64 + d) * VT_LD + tok + s8 * 8) = *(const u32x4*)(VTt + hh * 64 * LDP + d * LDP + s8 * 8);
    }
    __syncthreads();
}

constexpr int M1_GDN = NB * 4 * NCH, M1_HGRN = NB * 4 * NCH, M1_NA = NB * NCH * 8;
#define QPULL(ctr_) ((c0.tid == 0) ? __hip_atomic_fetch_add((ctr_), 1u, __ATOMIC_RELAXED, __HIP_MEMORY_SCOPE_AGENT) : 0u)
#define QNEXT(var_, tk_) do { int* slot_ = (int*)(c0.lds + LDS_CTLOFF + 1024); if (c0.tid == 0) *slot_ = (int)(tk_); __syncthreads(); var_ = *slot_; __syncthreads(); } while (0)
#define QLOOP2(RT_, LOADF_, ITEMF_, ctr_, nh_, ncid_, ampbit_) do { \
    const int n_ = NB * (nh_) * (ncid_); \
    int it, itn; { const unsigned tk0_ = (c0.tid == 0) ? __hip_atomic_fetch_add((ctr_), 2u, __ATOMIC_RELAXED, __HIP_MEMORY_SCOPE_AGENT) : 0u; QNEXT(it, tk0_); itn = it + 1; } \
    RT_ r; \
    if (it < n_) { RELANE(cl_, c0); LOADF_(cl_, it / ((nh_) * (ncid_)), (it / (ncid_)) % (nh_), it % (ncid_), r); } \
    while (it < n_) { \
        const unsigned tk = QPULL(ctr_); \
        RELANE(c, c0); \
        RT_ rn = r; \
        if (itn < n_) LOADF_(c, itn / ((nh_) * (ncid_)), (itn / (ncid_)) % (nh_), itn % (ncid_), rn); \
        AMP_T0(); \
        ITEMF_(c, l, it / ((nh_) * (ncid_)), (it / (ncid_)) % (nh_), it % (ncid_), r); AMP_SPIN(ampbit_); \
        int it2; QNEXT(it2, tk); \
        r = rn; it = itn; itn = it2; \
    } } while (0)
#define RELANE(cn, co) Ctx cn = co; { int ln_ = (co).lane; asm volatile("" : "+v"(ln_)); cn.lane = ln_; cn.tid = (co).wave * 64 + ln_; }
__device__ __forceinline__ void phase_m1(const Ctx& c0, int l) {
    unsigned* ctr = (unsigned*)(c0.ws + WS_CTL) + CW_BQ + 16 + l * 4;
    hgrn_lb_stage(c0, l);
    {
        int it; { const unsigned tk = QPULL(ctr); QNEXT(it, tk); }
        while (it < M1_GDN) {
            const unsigned tk = QPULL(ctr);
            RELANE(c, c0);
            AMP_T0();
            m1_gdn_item(c, l, it / (4 * NCH), (it / NCH) % 4, it % NCH); AMP_SPIN(0);
            QNEXT(it, tk);
        }
    }
    QLOOP2(M1H, m1_hgrn_load, m1_hgrn_item, ctr + 1, 4, NCH, 1);
    QLOOP2(M1N, m1_na_load, m1_na_item4, ctr + 2, 2, NCH, 2);
}
__device__ __forceinline__ void st_wt16(float* p, const f32x4 v) {
    __hip_atomic_store((unsigned long long*)p, ((unsigned long long)__float_as_uint(v[1]) << 32) | __float_as_uint(v[0]), __ATOMIC_RELAXED, __HIP_MEMORY_SCOPE_AGENT);
    __hip_atomic_store((unsigned long long*)p + 1, ((unsigned long long)__float_as_uint(v[3]) << 32) | __float_as_uint(v[2]), __ATOMIC_RELAXED, __HIP_MEMORY_SCOPE_AGENT);
}
__device__ __forceinline__ void wave_arrive(unsigned* ctr, int lane) {
    asm volatile("s_waitcnt vmcnt(0)" ::: "memory");
    if (lane == 0) __hip_atomic_fetch_add(ctr, 1u, __ATOMIC_RELAXED, __HIP_MEMORY_SCOPE_AGENT);
}
__device__ __forceinline__ void wave_wait_ge(unsigned* ctr, unsigned want) {
    unsigned spins = 0;
    while ((unsigned)__builtin_amdgcn_readfirstlane((int)__hip_atomic_load(ctr, __ATOMIC_RELAXED, __HIP_MEMORY_SCOPE_AGENT)) < want) { __builtin_amdgcn_s_sleep(8); if (++spins > (1u << 21)) break; }
    __builtin_amdgcn_fence(__ATOMIC_ACQUIRE, "agent");
    asm volatile("s_waitcnt vmcnt(0)" ::: "memory");
}

template <int MODE>
__device__ __forceinline__ void gdn_wtask(const Ctx& c, int chain, int seg, int cg) {
    const int dir = chain & 1, r16 = c.lane & 15, g4 = c.lane >> 4;
    const int vt = cg & 3;
    constexpr bool HASB = MODE != 0;
    constexpr int NST = MODE == 2 ? NSEG : SEGL;
    const bf16_t* Ag = MODE == 2 ? WSP(bf16_t, WS_SA) + (size_t)chain * NSEG * 4096 : WSP(bf16_t, WS_GA) + (size_t)chain * NCH * 4096;
    const float* Bg = MODE == 2 ? WSP(float, WS_SB) + (size_t)chain * NSEG * 4096 : WSP(float, WS_GB) + (size_t)chain * NCH * 4096;
    f32x4 S[4];
#pragma unroll
    for (int dt = 0; dt < 4; ++dt) {
        if (MODE == 0) {
#pragma unroll
            for (int e = 0; e < 4; ++e) S[dt][e] = (16 * dt + 4 * g4 + e == 16 * cg + r16) ? 1.f : 0.f;
        } else S[dt] = (f32x4){0.f, 0.f, 0.f, 0.f};
    }
    if (MODE == 3) {
        const bf16_t* Tg = WSP(bf16_t, WS_SA) + (size_t)chain * NSEG * 4096; const float* Og = WSP(float, WS_SB) + (size_t)chain * NSEG * 4096;
        bf16x8 pa[2][4][2]; f32x4 pb[2][4];
#define PRE_LOAD(set, j_) do { _Pragma("unroll") for (int dt_ = 0; dt_ < 4; ++dt_) { \
            _Pragma("unroll") for (int kk_ = 0; kk_ < 2; ++kk_) pa[set][dt_][kk_] = *(const bf16x8*)(Tg + (size_t)(j_) * 4096 + ((dt_ * 2 + kk_) * 64 + c.lane) * 8); \
            pb[set][dt_] = *(const f32x4*)(Og + (size_t)(j_) * 4096 + ((vt * 4 + dt_) * 64 + c.lane) * 4); } } while (0)
#define PRE_STEP(set, j_) do { if ((j_) + 1 < seg) PRE_LOAD((set) ^ 1, (j_) + 1); \
            u32x4 w0_, w1_; \
            w0_.x = pk2(S[0][0], S[0][1]); w0_.y = pk2(S[0][2], S[0][3]); w0_.z = pk2(S[1][0], S[1][1]); w0_.w = pk2(S[1][2], S[1][3]); \
            w1_.x = pk2(S[2][0], S[2][1]); w1_.y = pk2(S[2][2], S[2][3]); w1_.z = pk2(S[3][0], S[3][1]); w1_.w = pk2(S[3][2], S[3][3]); \
            const bf16x8 s0_ = __builtin_bit_cast(bf16x8, w0_), s1_ = __builtin_bit_cast(bf16x8, w1_); \
            _Pragma("unroll") for (int dt_ = 0; dt_ < 4; ++dt_) { f32x4 a_ = pb[set][dt_]; \
                a_ = __builtin_amdgcn_mfma_f32_16x16x32_bf16(pa[set][dt_][0], s0_, a_, 0, 0, 0); a_ = __builtin_amdgcn_mfma_f32_16x16x32_bf16(pa[set][dt_][1], s1_, a_, 0, 0, 0); S[dt_] = a_; } } while (0)
        if (seg > 0) PRE_LOAD(0, 0);
        for (int j = 0; j < seg; j += 2) { PRE_STEP(0, j); if (j + 1 < seg) PRE_STEP(1, j + 1); }
#undef PRE_LOAD
#undef PRE_STEP
    }
    bf16x8 af[4][4][2]; f32x4 bf[4][4];
#define G2_IDX(step) (MODE == 2 ? (step) : seq_cid(dir, seg * SEGL + (step)))
#define G2_LOAD(set, step) do { const int i_ = G2_IDX(step); \
        _Pragma("unroll") for (int dt_ = 0; dt_ < 4; ++dt_) { \
            _Pragma("unroll") for (int kk_ = 0; kk_ < 2; ++kk_) af[set][dt_][kk_] = *(const bf16x8*)(Ag + (size_t)i_ * 4096 + ((dt_ * 2 + kk_) * 64 + c.lane) * 8); } } while (0)
#define G2_LOADB(set, step) do { if (HASB) { const int i_ = G2_IDX(step); \
        _Pragma("unroll") for (int dt_ = 0; dt_ < 4; ++dt_) bf[set][dt_] = *(const f32x4*)(Bg + (size_t)i_ * 4096 + ((vt * 4 + dt_) * 64 + c.lane) * 4); } } while (0)
#define G2_STEP(set, bset, step) do { const int i_ = G2_IDX(step); \
        u32x4 w0_, w1_; \
        w0_.x = pk2(S[0][0], S[0][1]); w0_.y = pk2(S[0][2], S[0][3]); w0_.z = pk2(S[1][0], S[1][1]); w0_.w = pk2(S[1][2], S[1][3]); \
        w1_.x = pk2(S[2][0], S[2][1]); w1_.y = pk2(S[2][2], S[2][3]); w1_.z = pk2(S[3][0], S[3][1]); w1_.w = pk2(S[3][2], S[3][3]); \
        if (MODE == 3) { bf16_t* sp_ = WSP(bf16_t, WS_GS) + ((size_t)chain * NCH + i_) * 4096 + (vt * 128 + c.lane) * 8;     \
            *(u32x4*)(sp_) = w0_; *(u32x4*)(sp_ + 512) = w1_; } \
        if (MODE == 2) { float* sp_ = WSP(float, WS_SS) + ((size_t)chain * NSEG + i_) * 4096 + (16 * vt + r16) * 64 + 4 * g4;     \
            _Pragma("unroll") for (int dt_ = 0; dt_ < 4; ++dt_) *(f32x4*)(sp_ + 16 * dt_) = S[dt_]; } \
        if ((step) + 3 < NST) G2_LOAD(((set) + 3) & 3, (step) + 3); \
        if ((step) + 3 < NST) G2_LOADB(((bset) + 3) & 3, (step) + 3); \
        const bf16x8 s0_ = __builtin_bit_cast(bf16x8, w0_), s1_ = __builtin_bit_cast(bf16x8, w1_); \
        _Pragma("unroll") for (int dt_ = 0; dt_ < 4; ++dt_) { f32x4 a_ = HASB ? bf[bset][dt_] : (f32x4){0.f, 0.f, 0.f, 0.f}; \
            a_ = __builtin_amdgcn_mfma_f32_16x16x32_bf16(af[set][dt_][0], s0_, a_, 0, 0, 0); a_ = __builtin_amdgcn_mfma_f32_16x16x32_bf16(af[set][dt_][1], s1_, a_, 0, 0, 0); S[dt_] = a_; } } while (0)
    G2_LOAD(0, 0); G2_LOAD(1, 1); G2_LOAD(2, 2); G2_LOADB(0, 0); G2_LOADB(1, 1); G2_LOADB(2, 2);
    {
#pragma unroll 1
        for (int s4 = 0; s4 < SEGL; s4 += 4) { G2_STEP(0, 0, s4); G2_STEP(1, 1, s4 + 1); G2_STEP(2, 2, s4 + 2); G2_STEP(3, 3, s4 + 3); }
        if (MODE == 0) {
            const int dq = 16 * cg + r16, pos = 32 * (dq >> 5) + 8 * ((dq >> 2) & 3) + 4 * ((dq >> 4) & 1) + (dq & 3);
            bf16_t* tp = WSP(bf16_t, WS_SA) + ((size_t)chain * NSEG + seg) * 4096;
#pragma unroll
            for (int dt = 0; dt < 4; ++dt)
#pragma unroll
                for (int e = 0; e < 4; ++e) { const int d = 16 * dt + 4 * g4 + e;
                    __hip_atomic_store(tp + ((dt * 2 + (pos >> 5)) * 64 + 16 * ((pos >> 3) & 3) + (d & 15)) * 8 + (pos & 7), (bf16_t)f2bf(S[dt][e]), __ATOMIC_RELAXED, __HIP_MEMORY_SCOPE_AGENT); }
        } else if (MODE == 1) {
            float* op = WSP(float, WS_SB) + ((size_t)chain * NSEG + seg) * 4096;
#pragma unroll
            for (int dt = 0; dt < 4; ++dt) st_wt16(op + ((vt * 4 + dt) * 64 + c.lane) * 4, S[dt]);
        }
    }
#undef G2_IDX
#undef G2_LOAD
#undef G2_LOADB
#undef G2_STEP
}
__device__ __forceinline__ void m2_hgrn_wscan(const Ctx& c, int wt) {
    const int gt = wt * 128 + c.lane, chain = gt >> 12, e = gt & 4095, d = e & 63, dir = chain & 1;
    float* Bg = WSP(float, WS_HB) + (size_t)chain * NCH * 4096 + e;
    const float* Ag = WSP(float, WS_HA) + (size_t)chain * NCH * 64 + d;
    float S0 = 0.f, S1 = 0.f;
    for (int s0 = 0; s0 < NCH; s0 += 33) {
        float b0[33], b1[33], av[33];
#pragma unroll
        for (int j = 0; j < 33; ++j) { const int cid = seq_cid(dir, s0 + j); b0[j] = Bg[(size_t)cid * 4096]; b1[j] = Bg[(size_t)cid * 4096 + 64]; av[j] = Ag[cid * 64]; }
#pragma unroll
        for (int j = 0; j < 33; ++j) { const int cid = seq_cid(dir, s0 + j); Bg[(size_t)cid * 4096] = S0; Bg[(size_t)cid * 4096 + 64] = S1; S0 = av[j] * S0 + b0[j]; S1 = av[j] * S1 + b1[j]; }
    }
}

struct NaState { float m, l; f32x4 o[4]; };
__device__ __forceinline__ void na2_update(NaState& st, const f32x4 s0, const f32x4 s1, bf16x8& pf) {
    float cm = fmaxf(fmaxf(fmaxf(s0[0], s0[1]), fmaxf(s0[2], s0[3])), fmaxf(fmaxf(s1[0], s1[1]), fmaxf(s1[2], s1[3])));
    cm = xmax32(xmax16(cm));
    const float mn = fmaxf(st.m, cm), sc = __expf(st.m - mn); st.m = mn;
    float p[8];
#pragma unroll
    for (int e = 0; e < 4; ++e) { p[e] = __expf(s0[e] - mn); p[4 + e] = __expf(s1[e] - mn); }
    st.l = st.l * sc + ((p[0] + p[1]) + (p[2] + p[3])) + ((p[4] + p[5]) + (p[6] + p[7]));
#pragma unroll
    for (int dt = 0; dt < 4; ++dt) st.o[dt] = st.o[dt] * sc;
    const u32x4 pw = pack8(p); pf = __builtin_bit_cast(bf16x8, pw);
}
constexpr int NA_SLOT = 2 * 64 * LDP * 2;
template <bool MASKED, bool FENCE>
__device__ __forceinline__ void na3_chunk(NaState& st, const bf16x8 (&qf)[2], const bf16_t* Ks, const bf16_t* Vs, int tok, int kperm, int q16, int g4, bool rowok, unsigned cmask, int bcol, const float* brow) {
    f32x4 a[2];
#pragma unroll
    for (int tile = 0; tile < 2; ++tile) {
        const bf16_t* kp = Ks + (tok + kperm + 4 * tile) * LDP + g4 * 8;
        const bf16x8 k0 = *(const bf16x8*)kp, k1 = *(const bf16x8*)(kp + 32);
        const f32x4 x = __builtin_amdgcn_mfma_f32_16x16x32_bf16(k0, qf[0], (f32x4){0.f, 0.f, 0.f, 0.f}, 0, 0, 0);
        a[tile] = __builtin_amdgcn_mfma_f32_16x16x32_bf16(k1, qf[1], x, 0, 0, 0);
    }
    if (MASKED) {
        const int jq = (int)cmask, c0 = min(max(jq - 8, 0), 48), kc0 = tok + 8 * g4;
#pragma unroll
        for (int tile = 0; tile < 2; ++tile)
#pragma unroll
            for (int e = 0; e < 4; ++e) { const int kc = kc0 + 4 * tile + e; const bool ok = kc >= c0 && kc < c0 + 16; const float bv = brow[min(max(kc - jq + 15, 0), 30)]; a[tile][e] = ok ? a[tile][e] + bv : -1.0e30f; }
    }
    bf16x8 vf[4];
#pragma unroll
    for (int dt = 0; dt < 4; ++dt) vf[dt] = *(const bf16x8*)(Vs + (16 * dt + q16) * LDP + tok + 8 * g4);
    bf16x8 pf; na2_update(st, a[0], a[1], pf);
#pragma unroll
    for (int dt = 0; dt < 4; ++dt) st.o[dt] = __builtin_amdgcn_mfma_f32_16x16x32_bf16(vf[dt], pf, st.o[dt], 0, 0, 0);
    if (FENCE) asm volatile("" ::: "memory");
}
__device__ __forceinline__ void na3_store(const Ctx& c, const NaState& st, int qrow, int h, int g4) {
    const float l = xadd32(xadd16(st.l));
    const float inv = __builtin_amdgcn_rcpf(l);
    bf16_t* yr = WSP(bf16_t, WS_H) + (size_t)qrow * D + 512 + h * 64 + 4 * g4;
#pragma unroll
    for (int dt = 0; dt < 4; ++dt) { const f32x4 o = st.o[dt]; u32x2 w; w.x = pk2(o[0] * inv, o[1] * inv); w.y = pk2(o[2] * inv, o[3] * inv); *(u32x2*)(yr + 16 * dt) = w; }
}
__device__ __forceinline__ void na3_block(const Ctx& c, int l) {
    const int bh = c.bid >> 4, b = bh >> 3, h = bh & 7, rg = c.bid & 15;
    unsigned char* ring = c.lds; float* rpbh = (float*)(c.lds + 3 * NA_SLOT);
    const int q16 = c.lane & 15, g4 = c.lane >> 4;
    const int rq = 8 * rg + c.wave, r0q = min(max(rq - 4, 0), 120);
    const int klo = min(max(8 * rg - 4, 0), 120), khi = min(max(8 * rg + 3, 0), 120) + 7, nsteps = 4 + (khi - klo + 1);
    const bf16_t* P = WSP(bf16_t, WS_P);
    const bf16_t* VT = WSP(bf16_t, WS_VT) + (size_t)(b * 8 + h) * 64 * VT_LD;
    for (int i = c.tid; i < 465; i += 512) rpbh[i] = INP(18)[(size_t)(l * 8 + h) * 465 + i];
    const int sj = c.tid >> 3, sc8 = c.tid & 7;
    u32x4 kreg, vreg;
#define NA3_LOAD(s_) do { const int s__ = (s_); const bool cx_ = s__ < 4; const int kr_ = klo + s__ - 4; \
        const size_t prow_ = cx_ ? (size_t)(NLAT + b * CTXL + 64 * s__ + sj) : (size_t)(b * SEQ + kr_ * 64 + sj); const int tk_ = cx_ ? SEQ + 64 * s__ : kr_ * 64; \
        kreg = *(const u32x4*)(P + prow_ * NP + C_NK + h * 64 + sc8 * 8); vreg = *(const u32x4*)(VT + (size_t)sj * VT_LD + tk_ + sc8 * 8); } while (0)
#define NA3_STORE(s_) do { unsigned char* sl_ = ring + ((s_) % 3) * NA_SLOT; *(u32x4*)(sl_ + (sj * LDP + sc8 * 8) * 2) = kreg; *(u32x4*)(sl_ + 64 * LDP * 2 + (sj * LDP + sc8 * 8) * 2) = vreg; } while (0)
    NA3_LOAD(0); NA3_STORE(0); NA3_LOAD(1);
    bf16x8 qf[4][2]; NaState st[4];
    const int kperm = 8 * (q16 >> 2) + (q16 & 3);
#pragma unroll
    for (int m = 0; m < 4; ++m) {
        const size_t qrow = (size_t)(b * SEQ + rq * 64 + 16 * m + q16);
#pragma unroll
        for (int kk = 0; kk < 2; ++kk) qf[m][kk] = *(const bf16x8*)(P + qrow * NP + C_NQ + h * 64 + kk * 32 + g4 * 8);
        st[m].m = -1.0e30f; st[m].l = 0.f;
#pragma unroll
        for (int dt = 0; dt < 4; ++dt) st[m].o[dt] = (f32x4){0.f, 0.f, 0.f, 0.f};
    }
    __syncthreads();
    for (int s = 0; s < nsteps; ++s) {
        if (s + 1 < nsteps) NA3_STORE(s + 1);
        if (s + 2 < nsteps) NA3_LOAD(s + 2);
        const bf16_t* Ks = (const bf16_t*)(ring + (s % 3) * NA_SLOT); const bf16_t* Vs = Ks + 64 * LDP;
        if (s < 4) {
#pragma unroll
            for (int m = 0; m < 4; ++m) { na3_chunk<false, false>(st[m], qf[m], Ks, Vs, 0, kperm, q16, g4, true, 0u, 0, rpbh); na3_chunk<false, true>(st[m], qf[m], Ks, Vs, 32, kperm, q16, g4, true, 0u, 0, rpbh); }
        } else {
            const int kr = klo + s - 4;
            if (kr >= r0q && kr < r0q + 8) {
                const float* brow = rpbh + (kr - rq + 7) * 31;
#pragma unroll
                for (int m = 0; m < 4; ++m) { if (m & 1) na3_chunk<true, true>(st[m], qf[m], Ks, Vs, m == 1 ? 8 : 32, kperm, q16, g4, true, (unsigned)(16 * m + q16), 0, brow); else na3_chunk<true, false>(st[m], qf[m], Ks, Vs, m == 0 ? 0 : 24, kperm, q16, g4, true, (unsigned)(16 * m + q16), 0, brow); }
            }
        }
        __syncthreads();
    }
#undef NA3_LOAD
#undef NA3_STORE
#pragma unroll
    for (int m = 0; m < 4; ++m) na3_store(c, st[m], b * SEQ + rq * 64 + 16 * m + q16, h, g4);
}
__device__ __forceinline__ void na_ctx_item(const Ctx& c, int b, int h, int m2) {
    int lane = c.lane; asm volatile("" : "+v"(lane));
    const int q16 = lane & 15, g4 = lane >> 4, kperm = 8 * (q16 >> 2) + (q16 & 3);
    const bf16_t* P = WSP(bf16_t, WS_P);
    const bf16_t* VT = WSP(bf16_t, WS_VT) + (size_t)(b * 8 + h) * 64 * VT_LD + SEQ;
    bf16x8 qf[2][2]; NaState st[2];
#pragma unroll
    for (int t = 0; t < 2; ++t) { const size_t qrow = (size_t)(NLAT + b * CTXL + (2 * m2 + t) * 16 + q16);
#pragma unroll
        for (int kk = 0; kk < 2; ++kk) qf[t][kk] = *(const bf16x8*)(P + qrow * NP + C_NQ + h * 64 + kk * 32 + g4 * 8);
        st[t].m = -1.0e30f; st[t].l = 0.f;
#pragma unroll
        for (int dt = 0; dt < 4; ++dt) st[t].o[dt] = (f32x4){0.f, 0.f, 0.f, 0.f}; }
#pragma unroll 1
    for (int sp = 0; sp < 8; ++sp) {
        const int tok = 32 * sp; f32x4 a[2][2];
#pragma unroll
        for (int tile = 0; tile < 2; ++tile) {
            const bf16_t* kp = P + (size_t)(NLAT + b * CTXL + tok + kperm + 4 * tile) * NP + C_NK + h * 64 + g4 * 8;
            const bf16x8 k0 = *(const bf16x8*)kp, k1 = *(const bf16x8*)(kp + 32);
#pragma unroll
            for (int t = 0; t < 2; ++t) { const f32x4 x = __builtin_amdgcn_mfma_f32_16x16x32_bf16(k0, qf[t][0], (f32x4){0.f, 0.f, 0.f, 0.f}, 0, 0, 0); a[t][tile] = __builtin_amdgcn_mfma_f32_16x16x32_bf16(k1, qf[t][1], x, 0, 0, 0); }
        }
        bf16x8 vf[4];
#pragma unroll
        for (int dt = 0; dt < 4; ++dt) vf[dt] = *(const bf16x8*)(VT + (size_t)(16 * dt + q16) * VT_LD + tok + 8 * g4);
#pragma unroll
        for (int t = 0; t < 2; ++t) { bf16x8 pf; na2_update(st[t], a[t][0], a[t][1], pf);
#pragma unroll
            for (int dt = 0; dt < 4; ++dt) st[t].o[dt] = __builtin_amdgcn_mfma_f32_16x16x32_bf16(vf[dt], pf, st[t].o[dt], 0, 0, 0); }
    }
#pragma unroll
    for (int t = 0; t < 2; ++t) na3_store(c, st[t], NLAT + b * CTXL + (2 * m2 + t) * 16 + q16, h, g4);
}

template <int MODE>
__device__ __forceinline__ void gdn_p1task(const Ctx& c, int chain, int seg, int cg) {
    const int dir = chain & 1, r16 = c.lane & 15, g4 = c.lane >> 4;
    const int vt = cg & 3;
    constexpr bool HASB = MODE != 0;
    const bf16_t* Ag = WSP(bf16_t, WS_GA) + (size_t)chain * NCH * 4096;
    const float* Bg = WSP(float, WS_GB) + (size_t)chain * NCH * 4096;
    LAS unsigned char* L = (LAS unsigned char*)c.lds;
#pragma unroll
    for (int q = 0; q < SEGL; ++q) { const int i = c.wave + 8 * q, step = i >> 3, part = i & 7; const int ci = seq_cid(dir, seg * SEGL + step);
        __builtin_amdgcn_global_load_lds((const unsigned*)(Ag + (size_t)ci * 4096 + part * 512 + c.lane * 8), (LAS unsigned*)(L + i * 1024), 16, 0, 0); }
    f32x4 S[4];
#pragma unroll
    for (int dt = 0; dt < 4; ++dt) {
        if (MODE == 0) {
#pragma unroll
            for (int e = 0; e < 4; ++e) S[dt][e] = (16 * dt + 4 * g4 + e == 16 * cg + r16) ? 1.f : 0.f;
        } else S[dt] = (f32x4){0.f, 0.f, 0.f, 0.f};
    }
    f32x4 bf[6][4];
#define P1_LOADB(set, step) do { if (HASB) { const int i_ = seq_cid(dir, seg * SEGL + (step)); \
        _Pragma("unroll") for (int dt_ = 0; dt_ < 4; ++dt_) bf[set][dt_] = *(const f32x4*)(Bg + (size_t)i_ * 4096 + ((vt * 4 + dt_) * 64 + c.lane) * 4); } } while (0)
#define P1_STEP(set, step) do { \
        u32x4 w0_, w1_; \
        w0_.x = pk2(S[0][0], S[0][1]); w0_.y = pk2(S[0][2], S[0][3]); w0_.z = pk2(S[1][0], S[1][1]); w0_.w = pk2(S[1][2], S[1][3]); \
        w1_.x = pk2(S[2][0], S[2][1]); w1_.y = pk2(S[2][2], S[2][3]); w1_.z = pk2(S[3][0], S[3][1]); w1_.w = pk2(S[3][2], S[3][3]); \
        if ((step) + 5 < SEGL) P1_LOADB(((set) + 5) % 6, (step) + 5); \
        const bf16x8 s0_ = __builtin_bit_cast(bf16x8, w0_), s1_ = __builtin_bit_cast(bf16x8, w1_); \
        const LAS unsigned char* ap_ = L + (step) * 8192 + c.lane * 16; \
        _Pragma("unroll") for (int dt_ = 0; dt_ < 4; ++dt_) { f32x4 a_ = HASB ? bf[set][dt_] : (f32x4){0.f, 0.f, 0.f, 0.f}; \
            const bf16x8 a0_ = *(const LAS bf16x8*)(ap_ + (dt_ * 2) * 1024), a1_ = *(const LAS bf16x8*)(ap_ + (dt_ * 2 + 1) * 1024); \
            a_ = __builtin_amdgcn_mfma_f32_16x16x32_bf16(a0_, s0_, a_, 0, 0, 0); a_ = __builtin_amdgcn_mfma_f32_16x16x32_bf16(a1_, s1_, a_, 0, 0, 0); S[dt_] = a_; } } while (0)
    P1_LOADB(0, 0); P1_LOADB(1, 1); P1_LOADB(2, 2); P1_LOADB(3, 3); P1_LOADB(4, 4);
    asm volatile("s_waitcnt vmcnt(0)" ::: "memory");
    __syncthreads();
#pragma unroll 1
    for (int s6 = 0; s6 < SEGL; s6 += 6) { P1_STEP(0, s6); P1_STEP(1, s6 + 1); P1_STEP(2, s6 + 2); P1_STEP(3, s6 + 3); P1_STEP(4, s6 + 4); P1_STEP(5, s6 + 5); }
    if (MODE == 0) {
        const int dq = 16 * cg + r16, pos = 32 * (dq >> 5) + 8 * ((dq >> 2) & 3) + 4 * ((dq >> 4) & 1) + (dq & 3);
        bf16_t* tp = WSP(bf16_t, WS_SA) + ((size_t)chain * NSEG + seg) * 4096;
#pragma unroll
        for (int dt = 0; dt < 4; ++dt)
#pragma unroll
            for (int e = 0; e < 4; ++e) { const int d = 16 * dt + 4 * g4 + e;
                __hip_atomic_store(tp + ((dt * 2 + (pos >> 5)) * 64 + 16 * ((pos >> 3) & 3) + (d & 15)) * 8 + (pos & 7), (bf16_t)f2bf(S[dt][e]), __ATOMIC_RELAXED, __HIP_MEMORY_SCOPE_AGENT); }
    } else {
        float* op = WSP(float, WS_SB) + ((size_t)chain * NSEG + seg) * 4096;
#pragma unroll
        for (int dt = 0; dt < 4; ++dt) st_wt16(op + ((vt * 4 + dt) * 64 + c.lane) * 4, S[dt]);
    }
#undef P1_LOADB
#undef P1_STEP
}

__device__ __forceinline__ void phase_m2(const Ctx& c0, int l) {
    unsigned* cnt1 = (unsigned*)(c0.ws + WS_CTL) + CW_TQ + l * 64;
    const int cs = c0.bid, chain = cs / NSEG, seg = cs % NSEG;
    { RELANE(c, c0); AMP_T0();
      if (cs < 16 * NSEG) { if (c.wave < 4) gdn_p1task<0>(c, chain, seg, c.wave); else gdn_p1task<1>(c, chain, seg, c.wave);
          wave_arrive(cnt1 + chain, c.lane); AMP_SPIN(5); }
      else { const int t = (cs - 16 * NSEG) * 8 + c.wave; if (t < 512) { m2_hgrn_wscan(c, t); AMP_SPIN(6); } } }
    __syncthreads();
    { RELANE(c, c0); AMP_T0(); na3_block(c, l); AMP_SPIN(7); }
    { RELANE(c, c0); AMP_T0();
        if (cs < 16 * NSEG) { if (c.wave < 4) { wave_wait_ge(cnt1 + chain, (unsigned)(NSEG * 8)); gdn_wtask<3>(c, chain, seg, c.wave); AMP_SPIN(13); } }
        else if (l == 0) { const int j = (cs - 16 * NSEG) * 8 + c.wave; if (j < 128) na_ctx_item(c, j >> 6, (j >> 3) & 7, j & 7); } }
}
__device__ __forceinline__ void gated_norm_store(const Ctx& c, const float* OUT, const float* gw, int base, const u32x4 gtv, int ycol) {
    const int t = c.tid >> 3, sub = c.tid & 7;
    float o[8], gt[8]; float ss = 0.f;
#pragma unroll
    for (int e = 0; e < 8; ++e) { o[e] = OUT[t * 65 + sub * 8 + e]; ss += o[e] * o[e]; }
    ss = sum8(ss);
    const float r = rsqrtf(ss * (1.f / 64.f) + EPS);
    unpack8(gtv, gt);
#pragma unroll
    for (int e = 0; e < 8; ++e) o[e] = o[e] * r * gw[sub * 8 + e] * siluf_(gt[e]);
    *(u32x4*)(WSP(bf16_t, WS_H) + (size_t)(base + t) * D + ycol + sub * 8) = pack8(o);
}

struct M3G { u32x4 q[2], o[2], s[2], gt; };
__device__ __forceinline__ void m3_gdn_load(const Ctx& c, int b, int h, int cid, M3G& r) {
    const int t = c.tid >> 3, sub = c.tid & 7;
#pragma unroll
    for (int dir = 0; dir < 2; ++dir) { const size_t idx = (size_t)(((b * 4 + h) * 2 + dir) * NCH + cid);
        r.q[dir] = *(const u32x4*)(WSP(bf16_t, WS_GW) + idx * 4096 + t * 64 + sub * 8);
        r.o[dir] = *(const u32x4*)(WSP(bf16_t, WS_GU) + idx * 4096 + t * 64 + sub * 8);
        r.s[dir] = *(const u32x4*)(WSP(bf16_t, WS_GS) + idx * 4096 + c.tid * 8); }
    r.gt = *(const u32x4*)(WSP(bf16_t, WS_P) + (size_t)(chunk_row(b, cid) + t) * NP + C_GG + h * 64 + sub * 8);
}
__device__ __forceinline__ void m3_gdn_item(const Ctx& c, int l, int b, int h, int cid, const M3G& rg) {
    unsigned char* L0 = c.lds;
    bf16_t* Ql = (bf16_t*)L0;
    bf16_t* Ol = Ql + 2 * 64 * LDP;
    bf16_t* Sl = Ol + 2 * 64 * LDP;
    float* OUT = (float*)(Sl + 2 * 64 * LDP);
    const int base = chunk_row(b, cid);
    {
        const int t = c.tid >> 3, sub = c.tid & 7;
#pragma unroll
        for (int dir = 0; dir < 2; ++dir) {
            *(u32x4*)(Ql + dir * 64 * LDP + t * LDP + sub * 8) = rg.q[dir];
            *(u32x4*)(Ol + dir * 64 * LDP + t * LDP + sub * 8) = rg.o[dir];
            {
                const u32x4 sv = rg.s[dir];
                const int vt_ = c.tid >> 7, hf_ = (c.tid >> 6) & 1, r16_ = c.tid & 15, g4_ = (c.tid >> 4) & 3;
                bf16_t* srow = Sl + dir * 64 * LDP + (16 * vt_ + r16_) * LDP + 32 * hf_ + 4 * g4_;
                *(u32x2*)srow = (u32x2){sv.x, sv.y}; *(u32x2*)(srow + 16) = (u32x2){sv.z, sv.w}; } }
    }
    __syncthreads();
    const int dir = c.wave >> 2, tt = c.wave & 3, r16 = c.lane & 15, g4 = c.lane >> 4;
    f32x4 o[4];
#pragma unroll
    for (int vt = 0; vt < 4; ++vt) {
        const u32x2 ov = *(const u32x2*)(Ol + dir * 64 * LDP + (16 * vt + r16) * LDP + 16 * tt + 4 * g4);
        f32x4 a = (f32x4){__uint_as_float(ov.x << 16), __uint_as_float(ov.x & 0xffff0000u), __uint_as_float(ov.y << 16), __uint_as_float(ov.y & 0xffff0000u)};
        o[vt] = mm16(Ql + dir * 64 * LDP + tt * 16 * LDP, LDP, Sl + dir * 64 * LDP + vt * 16 * LDP, LDP, a, c.lane);
    }
    if (dir == 0) {
#pragma unroll
        for (int vt = 0; vt < 4; ++vt)
#pragma unroll
            for (int e = 0; e < 4; ++e) OUT[(16 * tt + 4 * g4 + e) * 65 + 16 * vt + r16] = o[vt][e];
    }
    __syncthreads();
    if (dir == 1) {
#pragma unroll
        for (int vt = 0; vt < 4; ++vt)
#pragma unroll
            for (int e = 0; e < 4; ++e) OUT[(63 - (16 * tt + 4 * g4 + e)) * 65 + 16 * vt + r16] += o[vt][e];
    }
    __syncthreads();
    gated_norm_store(c, OUT, INP(15) + l * 64, base, rg.gt, 256 + h * 64);
    __syncthreads();
}

struct M3H { f32x4 o0, o1; u32x4 q[2]; f32x4 s0[2], s1[2]; u32x4 gt; };
__device__ __forceinline__ void m3_hgrn_load(const Ctx& c, int b, int h, int cid, M3H& r) {
    const int t = c.tid >> 3, sub = c.tid & 7;
    const float* og = WSP(float, WS_HO) + (size_t)((b * 4 + h) * NCH + cid) * 4096 + t * 64 + sub * 8;
    r.o0 = *(const f32x4*)og; r.o1 = *(const f32x4*)(og + 4);
#pragma unroll
    for (int dir = 0; dir < 2; ++dir) { const size_t idx = (size_t)(((b * 4 + h) * 2 + dir) * NCH + cid);
        r.q[dir] = *(const u32x4*)(WSP(bf16_t, WS_HQ) + idx * 4096 + t * 64 + sub * 8);
        const float* sg = WSP(float, WS_HB) + idx * 4096 + t * 64 + sub * 8;
        r.s0[dir] = *(const f32x4*)sg; r.s1[dir] = *(const f32x4*)(sg + 4); }
    r.gt = *(const u32x4*)(WSP(bf16_t, WS_P) + (size_t)(chunk_row(b, cid) + t) * NP + C_HG + h * 64 + sub * 8);
}
__device__ __forceinline__ void m3_hgrn_item(const Ctx& c, int l, int b, int h, int cid, const M3H& rh) {
    unsigned char* L0 = c.lds;
    float* OUT = (float*)L0;
    bf16_t* Ql = (bf16_t*)(OUT + 64 * 65);
    bf16_t* Sl = Ql + 2 * 64 * LDP;
    const int base = chunk_row(b, cid);
    const int t = c.tid >> 3, sub = c.tid & 7, r16 = c.lane & 15, g4 = c.lane >> 4;
    {
#pragma unroll
        for (int e = 0; e < 4; ++e) { OUT[t * 65 + sub * 8 + e] = rh.o0[e]; OUT[t * 65 + sub * 8 + 4 + e] = rh.o1[e]; }
#pragma unroll
        for (int dir = 0; dir < 2; ++dir) {
            *(u32x4*)(Ql + dir * 64 * LDP + t * LDP + sub * 8) = rh.q[dir];
            float sf[8]; *(f32x4*)sf = rh.s0[dir]; *(f32x4*)(sf + 4) = rh.s1[dir];
            *(u32x4*)(Sl + dir * 64 * LDP + t * LDP + sub * 8) = pack8(sf); }
    }
    __syncthreads();
    const int dir = c.wave >> 2, tt = c.wave & 3;
    f32x4 o[4];
#pragma unroll
    for (int vt = 0; vt < 4; ++vt) o[vt] = mm16(Ql + dir * 64 * LDP + tt * 16 * LDP, LDP, Sl + dir * 64 * LDP + vt * 16 * LDP, LDP, (f32x4){0.f, 0.f, 0.f, 0.f}, c.lane);
    if (dir == 0) {
#pragma unroll
        for (int vt = 0; vt < 4; ++vt)
#pragma unroll
            for (int e = 0; e < 4; ++e) OUT[(16 * tt + 4 * g4 + e) * 65 + 16 * vt + r16] += o[vt][e];
    }
    __syncthreads();
    if (dir == 1) {
#pragma unroll
        for (int vt = 0; vt < 4; ++vt)
#pragma unroll
            for (int e = 0; e < 4; ++e) OUT[(63 - (16 * tt + 4 * g4 + e)) * 65 + 16 * vt + r16] += o[vt][e];
    }
    __syncthreads();
    gated_norm_store(c, OUT, INP(11) + l * 64, base, rh.gt, h * 64);
    __syncthreads();
}

__device__ __forceinline__ void phase_m3(const Ctx& c0, int l) {
    const int ncid = l == 0 ? NCH : 128;
    unsigned* ctrh = (unsigned*)(c0.ws + WS_CTL) + CW_BQ + l * 2 + 1;
    unsigned* ctrg = (unsigned*)(c0.ws + WS_CTL) + CW_BQ + 8 + l;
    QLOOP2(M3H, m3_hgrn_load, m3_hgrn_item, ctrh, 4, ncid, 4);
    QLOOP2(M3G, m3_gdn_load, m3_gdn_item, ctrg, 4, ncid, 3);
}
__device__ __forceinline__ void phase_moe_assign(const Ctx& c) {
    if (c.tid == 0) { unsigned* rt = WSP(unsigned, WS_CTL) + CW_RT; unsigned sp = 0;
        while (__hip_atomic_load(rt, __ATOMIC_RELAXED, __HIP_MEMORY_SCOPE_AGENT) < (unsigned)c.G) { __builtin_amdgcn_s_sleep(2); if (++sp > (1u << 22)) break; } }
    __syncthreads();
    __builtin_amdgcn_fence(__ATOMIC_ACQUIRE, "agent");
    int* sh = (int*)c.lds;
    if (c.tid == 0) { int acc = 0; for (int e = 0; e < NEXP; ++e) { const int cnt = (int)__hip_atomic_load(WSP(unsigned, WS_CTL) + CW_CNT + e, __ATOMIC_RELAXED, __HIP_MEMORY_SCOPE_AGENT); sh[e] = acc; acc += (cnt + 255) / 256 * 256; sh[8 + e] = acc; } }
    __syncthreads();
    if (c.bid == 0 && c.tid <= NSLOT_TILES) {
        if (c.tid == NSLOT_TILES) WSP(int, WS_TILEE)[NSLOT_TILES] = sh[15] / 256;
        else { int e = 0; while (e < NEXP - 1 && sh[8 + e] <= c.tid * 256) ++e; WSP(int, WS_TILEE)[c.tid] = e; }
    }
    if (c.bid == 1) {
        const int nt = sh[15] / 256, nleft = nt * 4 - MOE2_MAIN;
        for (int i = c.tid; i < NSLOT_TILES * 4; i += 512) WSP(int, WS_TILEP)[i] = -1;
        __syncthreads();
        if (c.tid < nleft) { pg8::Unit u; pg8::tile_of(nt, 4, MOE2_MAIN + c.tid, u); WSP(int, WS_TILEP)[u.pm * 4 + u.pn] = c.tid; }
    }
    if (c.wave == 0) {
        for (int ch = c.bid; ch < NLAT / 64; ch += c.G) {
            const int tok = ch * 64 + c.lane;
            const int e0 = WSP(int, WS_TOKE)[tok * 2], e1 = WSP(int, WS_TOKE)[tok * 2 + 1];
            unsigned mycnt = 0u; int rank0 = 0, rank1 = 0;
#pragma unroll
            for (int k = 0; k < 2; ++k)
#pragma unroll
                for (int ee = 0; ee < NEXP; ++ee) { const int e = k ? e1 : e0; const unsigned long long m = __ballot(e == ee);
                    if (c.lane == k * 8 + ee) mycnt = (unsigned)__popcll(m);
                    if (e == ee) { const int rk = __popcll(m & ((1ull << c.lane) - 1ull)); if (k) rank1 = rk; else rank0 = rk; } }
            unsigned base = 0u;
            if (c.lane < 16) base = atomicAdd(WSP(unsigned, WS_CTL) + CW_CUR + (c.lane & 7), mycnt);
            const int s0 = sh[e0] + (int)__shfl(base, e0) + rank0, s1 = sh[e1] + (int)__shfl(base, 8 + e1) + rank1;
            WSP(int, WS_TOKS)[tok * 2] = s0; WSP(int, WS_TOKS)[tok * 2 + 1] = s1;
            WSP(int, WS_SLOTTOK)[s0] = tok; WSP(int, WS_SLOTTOK)[s1] = tok;
        }
    }
    __syncthreads();
}
__device__ __forceinline__ void phase_moe_combine(const Ctx& c) {
    const float* mod = WSP(float, WS_MOD) + (size_t)1 * 3 * 6144 + 5120;
    const bf16_t* YP = WSP(bf16_t, WS_YP);
    for (int row = c.bid * 8 + c.wave; row < NLAT; row += c.G * 8) {
        const int s = row < SEQ ? 0 : 1;
        const int sa = WSP(int, WS_TOKS)[row * 2], sb = WSP(int, WS_TOKS)[row * 2 + 1];
        const float ga = WSP(float, WS_TOKG)[row * 2], gb = WSP(float, WS_TOKG)[row * 2 + 1];
        float* xr = c.p->out + (size_t)row * D; const bf16_t* xb = WSP(bf16_t, WS_XB) + (size_t)row * D;
#pragma unroll
        for (int j = 0; j < 2; ++j) { const int col = 8 * c.lane + 512 * j, pn = col >> 8;
            float ya[8], yb[8];
#pragma unroll
            for (int q = 0; q < 2; ++q) { const int sl = q ? sb : sa; float (&y)[8] = q ? yb : ya;
                const int uid = WSP(int, WS_TILEP)[(sl >> 8) * 4 + pn];
                if (uid < 0) unpack8(*(const u32x4*)(YP + (size_t)sl * D + col), y);
                else { const float* pp = WSP(float, WS_PART2) + (size_t)uid * MOE2_SPLIT * 65536 + (size_t)(sl & 255) * 256 + (col & 255);
                    f32x4 a0 = (f32x4){0.f, 0.f, 0.f, 0.f}, a1 = a0;
#pragma unroll
                    for (int ks = 0; ks < MOE2_SPLIT; ++ks) { a0 += *(const f32x4*)(pp + (size_t)ks * 65536); a1 += *(const f32x4*)(pp + (size_t)ks * 65536 + 4); }
#pragma unroll
                    for (int e = 0; e < 4; ++e) { y[e] = a0[e]; y[4 + e] = a1[e]; } } }
            float xv[8]; unpack8(*(const u32x4*)(xb + col), xv);
            f32x4 x0 = (f32x4){xv[0], xv[1], xv[2], xv[3]}, x1 = (f32x4){xv[4], xv[5], xv[6], xv[7]};
            const f32x4 g0 = *(const f32x4*)(mod + s * 6144 + col), g1 = *(const f32x4*)(mod + s * 6144 + col + 4);
#pragma unroll
            for (int e = 0; e < 4; ++e) { x0[e] += g0[e] * (ga * ya[e] + gb * yb[e]); x1[e] += g1[e] * (ga * ya[4 + e] + gb * yb[4 + e]); }
            *(f32x4*)(xr + col) = x0; *(f32x4*)(xr + col + 4) = x1; }
    }
}

constexpr int G_INPROJ = 248, G_FFN1 = 232;
__device__ __forceinline__ void phase_inproj(const Ctx& c, int l) {
    pg8::Gemm g{WSP(bf16_t, WS_H), WSP(bf16_t, WS_WIN) + (size_t)l * NP * D, D, MTOK / 256, NP / 256, nullptr, 0, nullptr, 0, 0, 1, D, 1 << 30, -1, G_INPROJ};
    pg8::EpiBf16 E{WSP(bf16_t, WS_P), NP, 0};
    pg8::gemm_phase((LAS unsigned char*)c.lds, g, E, c.tid, c.wave);
    early_cvt(c, l, G_INPROJ, (MTOK / 256) * (NP / 256));
}
__device__ __forceinline__ void phase_outproj(const Ctx& c, int l) {
    pg8::Gemm g{WSP(bf16_t, WS_H), WSP(bf16_t, WS_WOUT) + (size_t)l * D * D, D, NLAT / 256, D / 256, nullptr, 0, nullptr, 0, 0, 1, D, 1 << 30, -1};
    if (l == 0) { pg8::EpiResid<true> E{INP(0), WSP(bf16_t, WS_XB), WSP(float, WS_MOD) + 2048}; pg8::gemm_phase((LAS unsigned char*)c.lds, g, E, c.tid, c.wave); }
    else { pg8::EpiResid<false> E{nullptr, WSP(bf16_t, WS_XB), WSP(float, WS_MOD) + (size_t)3 * 6144 + 2048}; pg8::gemm_phase((LAS unsigned char*)c.lds, g, E, c.tid, c.wave); }
    if (l == 0) {
        pg8::Gemm gc{WSP(bf16_t, WS_H), WSP(bf16_t, WS_WOUT), D, 2, D / 256, nullptr, NLAT, nullptr, 0, 0, CTX_SPLIT_O, D / CTX_SPLIT_O, 1 << 30, -1};
        pg8::EpiPartial Ec{WSP(float, WS_PARTO), D, NCTX};
        pg8::gemm_phase((LAS unsigned char*)c.lds, gc, Ec, c.tid, c.wave);
    }
}
__device__ __forceinline__ void phase_ffn1(const Ctx& c) {
    pg8::Gemm g{WSP(bf16_t, WS_H), WSP(bf16_t, WS_W13), D, MTOK / 256, 7168 / 256, nullptr, 0, nullptr, 0, 0, 1, D, 1 << 30, -1, G_FFN1};
    pg8::EpiSwiGLU E{WSP(bf16_t, WS_P), DFF};
    pg8::gemm_phase((LAS unsigned char*)c.lds, g, E, c.tid, c.wave);
    early_cvt(c, 2, G_FFN1, (MTOK / 256) * (7168 / 256));
}
__device__ __forceinline__ void phase_ffn2(const Ctx& c) {
    pg8::Gemm g{WSP(bf16_t, WS_P), WSP(bf16_t, WS_W2), DFF, NLAT / 256, D / 256, nullptr, 0, nullptr, 0, 0, 1, DFF, 1 << 30, -1};
    pg8::EpiResid<false> E{nullptr, WSP(bf16_t, WS_XB), WSP(float, WS_MOD) + 5120};
    pg8::gemm_phase((LAS unsigned char*)c.lds, g, E, c.tid, c.wave);
    {
        pg8::Gemm gc{WSP(bf16_t, WS_P), WSP(bf16_t, WS_W2), DFF, 2, D / 256, nullptr, NLAT, nullptr, 0, 0, CTX_SPLIT_F, DFF / CTX_SPLIT_F, 1 << 30, -1};
        pg8::EpiPartial Ec{WSP(float, WS_PARTF), D, NCTX};
        pg8::gemm_phase((LAS unsigned char*)c.lds, gc, Ec, c.tid, c.wave);
    }
}
__device__ __forceinline__ void phase_moe1(const Ctx& c) {
    const int nt = WSP(int, WS_TILEE)[NSLOT_TILES];
    pg8::Gemm g{WSP(bf16_t, WS_H), WSP(bf16_t, WS_MOEW13), D, nt, 7168 / 256, WSP(int, WS_SLOTTOK), 0, WSP(int, WS_TILEE), 0, (size_t)7168 * D, 1, D, 1 << 30, -1, 0, WSP(bf16_t, WS_MOEW13E), NE13};
    pg8::EpiSwiGLU E{WSP(bf16_t, WS_ACTP), DFF};
    pg8::gemm_phase((LAS unsigned char*)c.lds, g, E, c.tid, c.wave);
}
__device__ __forceinline__ void phase_moe2(const Ctx& c) {
    const int nt = WSP(int, WS_TILEE)[NSLOT_TILES];
    pg8::Gemm g{WSP(bf16_t, WS_ACTP), (const bf16_t*)c.p->out, DFF, nt, D / 256, nullptr, 0, WSP(int, WS_TILEE), 0, (size_t)D * DFF, 1, DFF, MOE2_MAIN, -1};
    pg8::EpiBf16 E{WSP(bf16_t, WS_YP), D, 0};
    pg8::gemm_phase((LAS unsigned char*)c.lds, g, E, c.tid, c.wave);
    if (nt * 4 > MOE2_MAIN) {
        pg8::Gemm gl{WSP(bf16_t, WS_ACTP), (const bf16_t*)c.p->out, DFF, nt, D / 256, nullptr, 0, WSP(int, WS_TILEE), 0, (size_t)D * DFF, MOE2_SPLIT, DFF / MOE2_SPLIT, 1 << 30, MOE2_MAIN};
        pg8::EpiPartialTile El{WSP(float, WS_PART2), MOE2_SPLIT};
        pg8::gemm_phase((LAS unsigned char*)c.lds, gl, El, c.tid, c.wave);
    }
}

constexpr int N_PHASES = 20;
__device__ __forceinline__ void run_phase(const Ctx& c, int ph) {
    switch (ph) {
        case 0: phase_prologue(c); break;
        case 1: phase_norm(c, 0, 1); break;
        case 2: phase_inproj(c, 0); break;
        case 3: phase_m1(c, 0); break;
        case 4: phase_m2(c, 0); break;
        case 5: phase_m3(c, 0); break;
        case 6: phase_outproj(c, 0); break;
        case 7: phase_norm(c, 0, 2); break;
        case 8: phase_ffn1(c); break;
        case 9: phase_ffn2(c); break;
        case 10: phase_norm(c, 1, 1); break;
        case 11: phase_inproj(c, 1); break;
        case 12: phase_m1(c, 1); break;
        case 13: phase_m2(c, 1); break;
        case 14: phase_m3(c, 1); break;
        case 15: phase_outproj(c, 1); break;
        case 16: phase_norm(c, 1, 2); late_cvt(c); phase_moe_assign(c); break;
        case 17: phase_moe1(c); break;
        case 18: phase_moe2(c); break;
        case 19: phase_moe_combine(c); break;
        default: break;
    }
}

#define XB_TMO      128
#define XB_XCNT(j)  (256  + 64 * (j))
#define XB_XSUB(j)  (1280 + 64 * (j))
#define XB_XGEN(j)  (2304 + 64 * (j))
#define XB_TOP      3328
#define XB_TOPGEN   3392
#define XCD_BAR_WORDS 3456
#define XB_SPIN_CAP (1u << 18)
__device__ __forceinline__ unsigned xb_ld(unsigned* p)              { return __hip_atomic_load(p, __ATOMIC_RELAXED, __HIP_MEMORY_SCOPE_AGENT); }
__device__ __forceinline__ unsigned xb_add(unsigned* p, unsigned v) { return __hip_atomic_fetch_add(p, v, __ATOMIC_RELAXED, __HIP_MEMORY_SCOPE_AGENT); }
__device__ __forceinline__ unsigned xb_xcc_id() { return (unsigned)__builtin_amdgcn_s_getreg((3 << 11) | 20) & 0xFu; }
#define XB_SPIN(cond, bar) do { unsigned _sp = 0; while (cond) { __builtin_amdgcn_s_sleep(1); \
    if ((++_sp & 255u) == 0u) { if (xb_ld(&(bar)[XB_TMO])) break; if (_sp > XB_SPIN_CAP) { atomicAdd(&(bar)[XB_TMO], 1u); break; } } } } while (0)
struct XcdBarrier { unsigned* bar; unsigned x; volatile LAS unsigned* st; };
__device__ __forceinline__ XcdBarrier xcd_barrier_post(unsigned* bar, volatile LAS unsigned* st) {
    XcdBarrier b; b.bar = bar; b.x = xb_xcc_id(); b.st = st;
    if (threadIdx.x == 0) (void)xb_add(&bar[XB_XCNT(b.x)], 1u);
    return b;
}
__device__ __forceinline__ void xcd_barrier_complete(unsigned* bar, unsigned x, unsigned& nloc, unsigned& nx) {
    const unsigned G = gridDim.x * gridDim.y * gridDim.z;
    unsigned sum, cnt, mine, sp = 0u;
    for (;;) {
        sum = 0u; cnt = 0u; mine = 0u;
#pragma unroll
        for (unsigned j = 0; j < 16; ++j) { const unsigned c = xb_ld(&bar[XB_XCNT(j)]); sum += c; cnt += (c > 0u) ? 1u : 0u; mine = (j == x) ? c : mine; }
        if (sum == G) break;
        __builtin_amdgcn_s_sleep(1);
        if ((++sp & 255u) == 0u) { if (xb_ld(&bar[XB_TMO])) break; if (sp > XB_SPIN_CAP) { atomicAdd(&bar[XB_TMO], 1u); break; } }
    }
    nloc = mine > 0u ? mine : 1u; nx = cnt > 0u ? cnt : 1u;
}
__device__ __forceinline__ void xcd_barrier(const XcdBarrier& b, int wave_id) {
    asm volatile("s_waitcnt vmcnt(0)" ::: "memory");
    __syncthreads();
    if (wave_id == 0 && __builtin_amdgcn_mbcnt_lo(~0u, 0u) == 0u) {
        unsigned* bar = b.bar;
        __builtin_amdgcn_s_waitcnt(0);
        unsigned nloc = b.st[0], nx = b.st[1];
        if (nloc == 0u) { xcd_barrier_complete(bar, b.x, nloc, nx); b.st[0] = nloc; b.st[1] = nx; }
        const unsigned old = xb_add(&bar[XB_XSUB(b.x)], 1u);
        const unsigned gen = old / nloc;
        if (old + 1u == (gen + 1u) * nloc) {
            __builtin_amdgcn_fence(__ATOMIC_RELEASE, "agent");
            asm volatile("s_waitcnt vmcnt(0)" ::: "memory");
            const unsigned og = xb_add(&bar[XB_TOP], 1u);
            const unsigned tg = og / nx;
            if (og + 1u == (tg + 1u) * nx) xb_add(&bar[XB_TOPGEN], 1u);
            else XB_SPIN(xb_ld(&bar[XB_TOPGEN]) == tg, bar);
            __builtin_amdgcn_fence(__ATOMIC_ACQUIRE, "agent");
            xb_add(&bar[XB_XGEN(b.x)], 1u);
            asm volatile("s_waitcnt vmcnt(0)" ::: "memory");
        } else {
            XB_SPIN(xb_ld(&bar[XB_XGEN(b.x)]) == gen, bar);
            __builtin_amdgcn_fence(__ATOMIC_ACQUIRE, "agent");
            asm volatile("s_waitcnt vmcnt(0)" ::: "memory");
        }
    }
    __syncthreads();
}

#ifndef MK_CG_SEAM
#define MK_CG_SEAM 1
#endif
#ifndef MK_MEGA
#define MK_MEGA 1
#endif
__global__ void __launch_bounds__(512, 2) fwd_kernel(Params p) {
    extern __shared__ __attribute__((aligned(16))) unsigned char lds[];
    const int wave_ = __builtin_amdgcn_readfirstlane(threadIdx.x >> 6);
#define MKCTX() Ctx c; c.p = &p; c.lds = lds; c.ws = p.ws; c.wave = wave_; c.bid = blockIdx.x; c.G = gridDim.x; \
    { int ln_ = (int)__builtin_amdgcn_mbcnt_hi(~0u, __builtin_amdgcn_mbcnt_lo(~0u, 0u)); asm volatile("" : "+v"(ln_)); c.lane = ln_; c.tid = wave_ * 64 + ln_; }
#if MK_MEGA
#if MK_CG_SEAM
    cg::grid_group grid = cg::this_grid();
#endif
    volatile LAS unsigned* MISC = (volatile LAS unsigned*)((LAS unsigned char*)lds + LDS_CTLOFF);
    if (threadIdx.x < 64) MISC[threadIdx.x] = 0u;
    __syncthreads();
    const XcdBarrier bar = xcd_barrier_post((unsigned*)(p.ws + WS_CTL) + CW_BAR, MISC + 8);
#if MK_CG_SEAM
    if (p.cg_seams) grid.sync();
#define SEAM() xcd_barrier(bar, wave_)
#else
#define SEAM() xcd_barrier(bar, wave_)
#endif
#ifndef AMP_MASK
#define AMP_MASK 0x0
#endif
#if AMP_MASK
#define PH(k) if (p.ph_lo <= (k) && (k) < p.ph_hi) { MKCTX(); const unsigned long long t0_ = __builtin_amdgcn_s_memrealtime(); run_phase(c, (k)); if ((k) + 1 < p.ph_hi) { SEAM(); } \
        if ((AMP_MASK >> (k)) & 1) { const unsigned long long t1_ = __builtin_amdgcn_s_memrealtime(); while (__builtin_amdgcn_s_memrealtime() < t1_ + (t1_ - t0_)) __builtin_amdgcn_s_sleep(8); } }
#else
#define PH(k) if (p.ph_lo <= (k) && (k) < p.ph_hi) { MKCTX(); run_phase(c, (k)); if ((k) + 1 < p.ph_hi) { SEAM(); } }
#endif
#else
#define PH(k) if (p.ph_lo <= (k) && (k) < p.ph_hi) { MKCTX(); run_phase(c, (k)); }
#endif
#ifdef ONLY_PHASE
    PH(ONLY_PHASE)
#else
    PH(0) PH(1) PH(2) PH(3) PH(4) PH(5) PH(6) PH(7) PH(8) PH(9) PH(10) PH(11) PH(12) PH(13) PH(14) PH(15) PH(16) PH(17) PH(18) PH(19)
#endif
#undef PH
}

extern "C" void kernel_launch(void* const* d_in, const int* in_sizes, int n_in, void* d_out, int out_size, void* d_ws, size_t ws_size, hipStream_t stream) {
    static int grid = 0;
    if (grid == 0) {
        if (n_in != 27 || out_size != NLAT * D || ws_size < WS_END) { fprintf(stderr, "kernel_launch: unexpected sizes (n_in %d, out %d, ws %zu, need %zu)\n", n_in, out_size, ws_size, (size_t)WS_END); grid = -1; return; }
        int dev = 0, cus = 0, per_cu = 0;
        hipGetDevice(&dev); hipDeviceGetAttribute(&cus, hipDeviceAttributeMultiprocessorCount, dev);
        hipFuncSetAttribute((const void*)fwd_kernel, hipFuncAttributeMaxDynamicSharedMemorySize, LDS_BYTES);
        hipOccupancyMaxActiveBlocksPerMultiprocessor(&per_cu, (const void*)fwd_kernel, 512, LDS_BYTES);
        if (per_cu < 1) { fprintf(stderr, "kernel_launch: occupancy query says %d blocks/CU\n", per_cu); per_cu = 1; }
        grid = cus;
        if (grid != 256) { fprintf(stderr, "kernel_launch: built for a 256-CU device (the mixer phases deal their work over exactly 256 workgroups); found %d CUs, nothing launched\n", cus); grid = -1; return; }
        (void)hipGetLastError();
    }
    if (grid < 0) return;
    hipMemsetAsync((char*)d_ws + WS_CTL, 0, CTL_BYTES, stream);
    Params p{};
    for (int i = 0; i < 27; ++i) p.in[i] = (const float*)d_in[i];
    p.out = (float*)d_out; p.ws = (unsigned char*)d_ws;
#if MK_MEGA
    p.ph_lo = 0; p.ph_hi = N_PHASES;
    void* args[] = {&p};
    hipError_t e = hipLaunchCooperativeKernel((const void*)fwd_kernel, dim3(grid), dim3(512), args, LDS_BYTES, stream);
    if (e != hipSuccess) fprintf(stderr, "cooperative launch failed: %s (grid %d)\n", hipGetErrorString(e), grid);
#else
    for (int ph = 0; ph < N_PHASES; ++ph) { p.ph_lo = ph; p.ph_hi = ph + 1; hipLaunchKernelGGL(fwd_kernel, dim3(grid), dim3(512), LDS_BYTES, stream, p); }
#endif
}
```

```cpp
#include <hip/hip_runtime.h>
#include <hip/hip_cooperative_groups.h>
#include <cstdio>
#include <cstdint>
namespace cg = cooperative_groups;

#define LAS __attribute__((address_space(3)))
typedef unsigned short bf16_t;
typedef short bf16x8 __attribute__((ext_vector_type(8)));
typedef float f32x4 __attribute__((ext_vector_type(4)));
typedef float f32x2 __attribute__((ext_vector_type(2)));
typedef unsigned u32x4 __attribute__((ext_vector_type(4)));
typedef unsigned u32x2 __attribute__((ext_vector_type(2)));

constexpr int D = 1024, NB = 2, SEQ = 8192, CTXL = 256, NLAT = NB * SEQ, NCTX = NB * CTXL, MTOK = NLAT + NCTX;
constexpr int NP = 3840;
constexpr int C_HQ = 0, C_HFF = 256, C_HFB = 512, C_HI = 768, C_HG = 1024, C_GQ = 1280, C_GK = 1536, C_GV = 1792, C_GG = 2048, C_NQ = 2304, C_NK = 2816, C_NV = 3328;
constexpr int DPROJ = 3856, DFF = 3584, NEXP = 8;
constexpr int NCH = 132;
constexpr int NSLOT_TILES = 136, NSLOTS = NSLOT_TILES * 256;
constexpr int VT_LD = 8448;
constexpr float EPS = 1e-6f;

constexpr size_t KiB = 1024, MiB = 1024 * 1024;
constexpr size_t WS_CTL = 0, CTL_BYTES = 64 * KiB;
constexpr size_t WS_MOD = 64 * KiB;
constexpr size_t WS_ROPE = 256 * KiB;
constexpr size_t WS_WG = 320 * KiB;
constexpr size_t WS_WR = 448 * KiB;
constexpr size_t WS_TOKE = 512 * KiB, WS_TOKG = 640 * KiB, WS_TOKS = 768 * KiB, WS_SLOTTOK = 896 * KiB;
constexpr size_t WS_TILEE = 1040 * KiB;
constexpr size_t WS_TILEP = 1044 * KiB;
constexpr size_t WS_GATES = 2 * MiB;
constexpr size_t WS_XC = 4 * MiB;
constexpr size_t WS_H = 6 * MiB;
constexpr size_t WS_WIN = 40 * MiB;
constexpr size_t WS_WOUT = 55 * MiB;
constexpr size_t WS_W13 = 59 * MiB;
constexpr size_t WS_W2 = 73 * MiB;
constexpr size_t WS_P = 80 * MiB;
constexpr size_t WS_SCR = 204 * MiB;
constexpr size_t NITEM = 16 * NCH;
constexpr size_t WS_GA = WS_SCR;
constexpr size_t WS_GB = WS_GA + NITEM * 8192;
constexpr size_t WS_GW = WS_GB + NITEM * 16384;
constexpr size_t WS_GU = WS_GW + NITEM * 8192;
constexpr size_t WS_GS = WS_GU + NITEM * 8192;
constexpr size_t WS_GQKV = WS_GS + NITEM * 8192;
constexpr size_t WS_HB = WS_GQKV + (size_t)3 * MTOK * 256 * 2;
constexpr size_t WS_HA = WS_HB + NITEM * 16384;
constexpr size_t WS_VT = WS_HA + NITEM * 256;
constexpr int NSEG = 11, SEGL = 12;
constexpr size_t WS_SA = WS_VT + (size_t)NB * 8 * 64 * VT_LD * 2;
constexpr size_t WS_SB = WS_SA + (size_t)16 * NSEG * 8192;
constexpr size_t WS_SS = WS_SB + (size_t)16 * NSEG * 16384;
constexpr size_t WS_HQ = WS_SS + (size_t)16 * NSEG * 16384;
constexpr size_t WS_HO = WS_GQKV;
constexpr size_t WS_SCR_END = WS_HQ + NITEM * 8192;
constexpr int CTX_SPLIT_O = 4, CTX_SPLIT_F = 7;
constexpr size_t WS_PARTO = WS_SCR;
constexpr size_t WS_PARTF = WS_SCR + 16 * MiB;
constexpr size_t WS_MOEW13 = 40 * MiB;
constexpr int NE13 = 3;
constexpr int MOE2_MAIN = 512, MOE2_SPLIT = 7;
constexpr size_t WS_PART2 = 80 * MiB;
constexpr size_t WS_ACTP = 208 * MiB;
constexpr size_t WS_YP = 6 * MiB;
constexpr size_t WS_XB = 446 * MiB;
constexpr size_t WS_MOEW13E = WS_XB + (size_t)NLAT * 1024 * 2;
constexpr size_t WS_END = WS_MOEW13E + (size_t)NE13 * 7168 * 1024 * 2;
static_assert(WS_SCR_END <= 446 * MiB && WS_MOEW13 + (size_t)8 * 7168 * 1024 * 2 <= WS_ACTP && WS_ACTP + (size_t)NSLOTS * DFF * 2 <= WS_XB && WS_YP + (size_t)NSLOTS * 1024 * 2 <= WS_PART2 && WS_PART2 + (size_t)32 * 7 * 65536 * 4 <= WS_ACTP, "ws map");
static_assert(WS_P + (size_t)MTOK * NP * 2 <= WS_SCR && WS_H + (size_t)MTOK * D * 2 <= WS_WIN && WS_W2 + (size_t)D * DFF * 2 <= WS_P, "ws map");
constexpr int CW_CNT = 64, CW_CUR = 128, CW_NAQ = 192  , CW_TQ = 320  , CW_BQ = 512  , CW_CV = 576  , CW_RT = 704  , CW_BAR = 4096;

constexpr int LDS_BYTES = 147456;
constexpr int LDS_CTLOFF = 135168;

__device__ __forceinline__ float bf2f(unsigned short b) { return __uint_as_float((unsigned)b << 16); }
__device__ __forceinline__ bf16_t bf1(float x);
__device__ __forceinline__ unsigned f2bf(float f) { unsigned u = __float_as_uint(f); return (u + 0x7fffu + ((u >> 16) & 1u)) >> 16; }
typedef __bf16 bf16x2_t __attribute__((ext_vector_type(2)));
__device__ __forceinline__ unsigned pk2(float lo, float hi) { const f32x2 v = {lo, hi}; const bf16x2_t b = __builtin_convertvector(v, bf16x2_t); return __builtin_bit_cast(unsigned, b); }
__device__ __forceinline__ void unpack8(const u32x4 v, float (&f)[8]) {
#pragma unroll
    for (int i = 0; i < 4; ++i) { f[2 * i] = __uint_as_float(v[i] << 16); f[2 * i + 1] = __uint_as_float(v[i] & 0xffff0000u); }
}
__device__ __forceinline__ bf16_t bf1(float x) { return (bf16_t)pk2(x, x); }
__device__ __forceinline__ u32x4 pack8(const float (&f)[8]) { u32x4 v; v.x = pk2(f[0], f[1]); v.y = pk2(f[2], f[3]); v.z = pk2(f[4], f[5]); v.w = pk2(f[6], f[7]); return v; }
__device__ __forceinline__ float wave_sum(float v) {
#define DPP_ADD(ctrl, rmask, bmask) v += __builtin_bit_cast(float, __builtin_amdgcn_update_dpp(0, __builtin_bit_cast(int, v), (ctrl), (rmask), (bmask), true))
    DPP_ADD(0x111, 0xf, 0xf);
    DPP_ADD(0x112, 0xf, 0xf);
    DPP_ADD(0x114, 0xf, 0xf);
    DPP_ADD(0x118, 0xf, 0xf);
    DPP_ADD(0x142, 0xa, 0xf);
    DPP_ADD(0x143, 0xc, 0xf);
#undef DPP_ADD
    return __builtin_bit_cast(float, __builtin_amdgcn_readlane(__builtin_bit_cast(int, v), 63));
}
__device__ __forceinline__ float wave_scan(float v) {
#define DPP_ADD(ctrl, rmask, bmask) v += __builtin_bit_cast(float, __builtin_amdgcn_update_dpp(0, __builtin_bit_cast(int, v), (ctrl), (rmask), (bmask), true))
    DPP_ADD(0x111, 0xf, 0xf); DPP_ADD(0x112, 0xf, 0xf); DPP_ADD(0x114, 0xf, 0xf); DPP_ADD(0x118, 0xf, 0xf); DPP_ADD(0x142, 0xa, 0xf); DPP_ADD(0x143, 0xc, 0xf);
#undef DPP_ADD
    return v;
}
__device__ __forceinline__ float sum8(float v) {
    v += __builtin_bit_cast(float, __builtin_amdgcn_update_dpp(0, __builtin_bit_cast(int, v), 0xB1, 0xf, 0xf, true));
    v += __builtin_bit_cast(float, __builtin_amdgcn_update_dpp(0, __builtin_bit_cast(int, v), 0x4E, 0xf, 0xf, true));
    v += __builtin_bit_cast(float, __builtin_amdgcn_update_dpp(0, __builtin_bit_cast(int, v), 0x141, 0xf, 0xf, true));
    return v;
}
__device__ __forceinline__ float xmax16(float v) { const auto r = __builtin_amdgcn_permlane16_swap(__float_as_uint(v), __float_as_uint(v), false, false); return fmaxf(__uint_as_float(r[0]), __uint_as_float(r[1])); }
__device__ __forceinline__ float xmax32(float v) { const auto r = __builtin_amdgcn_permlane32_swap(__float_as_uint(v), __float_as_uint(v), false, false); return fmaxf(__uint_as_float(r[0]), __uint_as_float(r[1])); }
__device__ __forceinline__ float xadd16(float v) { const auto r = __builtin_amdgcn_permlane16_swap(__float_as_uint(v), __float_as_uint(v), false, false); return __uint_as_float(r[0]) + __uint_as_float(r[1]); }
__device__ __forceinline__ float xadd32(float v) { const auto r = __builtin_amdgcn_permlane32_swap(__float_as_uint(v), __float_as_uint(v), false, false); return __uint_as_float(r[0]) + __uint_as_float(r[1]); }
__device__ __forceinline__ float sigmoidf_(float x) { return __builtin_amdgcn_rcpf(1.f + __expf(-x)); }
__device__ __forceinline__ float siluf_(float x) { return x * __builtin_amdgcn_rcpf(1.f + __expf(-x)); }
__device__ __forceinline__ float softplusf_(float x) { return x > 20.f ? x : log1pf(expf(x)); }
__device__ __forceinline__ float logsigmoidf_(float z) { return fminf(z, 0.f) - log1pf(expf(-fabsf(z))); }
__device__ __forceinline__ int chunk_row(int b, int cid) { return cid < 128 ? b * SEQ + cid * 64 : NLAT + b * CTXL + (cid - 128) * 64; }
__device__ __forceinline__ int seq_cid(int dir, int step) { return dir == 0 ? (step < 4 ? 128 + step : step - 4) : (step < 4 ? 131 - step : 131 - step); }

__device__ __forceinline__ f32x4 mm16s(const bf16_t* As, int lda, int rowa0, const bf16_t* Bs, int ldb, int rowb0, f32x4 acc, int lane) {
    const int r = lane & 15, g = lane >> 4;
    const int swa = rowa0 < 0 ? 0 : ((rowa0 + r) >> 3) & 7, swb = rowb0 < 0 ? 0 : ((rowb0 + r) >> 3) & 7;
#pragma unroll
    for (int kk = 0; kk < 2; ++kk) {
        const bf16x8 a = *(const bf16x8*)(As + r * lda + (((kk * 4 + g) ^ swa) << 3));
        const bf16x8 b = *(const bf16x8*)(Bs + r * ldb + (((kk * 4 + g) ^ swb) << 3));
        acc = __builtin_amdgcn_mfma_f32_16x16x32_bf16(a, b, acc, 0, 0, 0);
    }
    return acc;
}
__device__ __forceinline__ int swz64(int row, int col) { return (((col >> 3) ^ ((row >> 3) & 7)) << 3) | (col & 7); }
__device__ __forceinline__ f32x4 mm16(const bf16_t* As, int lda, const bf16_t* Bs, int ldb, f32x4 acc, int lane) {
    const int r = lane & 15, g = lane >> 4;
#pragma unroll
    for (int kk = 0; kk < 2; ++kk) {
        const bf16x8 a = *(const bf16x8*)(As + r * lda + kk * 32 + g * 8);
        const bf16x8 b = *(const bf16x8*)(Bs + r * ldb + kk * 32 + g * 8);
        acc = __builtin_amdgcn_mfma_f32_16x16x32_bf16(a, b, acc, 0, 0, 0);
    }
    return acc;
}
constexpr int LDP = 72;

struct Params {
    const float* in[27];
    float* out;
    unsigned char* ws;
    int ph_lo, ph_hi;
    int cg_seams, pad;
};
namespace pg8 {
constexpr int BM = 256, BK = 64, HALF = 128, HTB = HALF * BK * 2, STAGE_BYTES = 8 * HTB, NXCD = 8, WGM = 2;
__host__ __device__ __forceinline__ int lds_byte(int r, int c) { const int st = (r >> 4) * 2 + (c >> 5), rr = r & 15, cc = c & 31, ob = rr * 64 + cc * 2; return st * 1024 + (ob ^ (((ob >> 9) & 1) << 5)); }
__host__ __device__ __forceinline__ void stage_rc(int b, int& R, int& C) { const int st = b / 1024, sb = b % 1024, swz = sb ^ (((sb >> 9) & 1) << 5); R = (st >> 1) * 16 + swz / 64; C = (st & 1) * 32 + (swz % 64) / 2; }
__host__ __device__ __forceinline__ int perm32(int rho) { const int n = rho >> 4, i = rho & 15; return 8 * (i >> 2) + 4 * n + (i & 3); }

struct Unit { int pm, pn, ks, uid; };
struct Gemm { const bf16_t* A; const bf16_t* Bt; int K, nM, nN; const int* rowmap; int arow0; const int* tile_e; int tile0; size_t estride; int nS, klen, lim, lbase; int gG; const bf16_t* Bt2; int esplit; int wgm; };

__device__ __forceinline__ void tile_of(int nM, int nN, int L, Unit& u, int wgm = WGM) {
    const int nwg = nM * nN; int wgid = L; { const int q = nwg / NXCD, r = nwg % NXCD, xcd = wgid % NXCD, off = wgid / NXCD; wgid = (xcd < r ? xcd * (q + 1) : r * (q + 1) + (xcd - r) * q) + off; }
    const int nig = wgm * nN, gid = wgid / nig, fm = gid * wgm, gsz = (nM - fm) < wgm ? (nM - fm) : wgm;
    u.pm = fm + ((wgid % nig) % gsz); u.pn = (wgid % nig) / gsz;
}
__device__ __forceinline__ bool next_unit(const Gemm& g, int G, int c, int i, Unit& u) {
    const int nM = g.nM, nN = g.nN; const long L = (long)i * G + c;
    if (g.nS > 1) {
        const int ntile = g.lbase >= 0 ? nM * nN - g.lbase : nM * nN;
        if (L >= (long)ntile * g.nS) return false;
        u.ks = (int)(L % g.nS); const int t = (int)(L / g.nS); u.uid = t;
        if (g.lbase >= 0) tile_of(nM, nN, g.lbase + t, u, g.wgm ? g.wgm : WGM); else { u.pn = t % nN; u.pm = t / nN; }
        return true;
    }
    u.ks = 0; u.uid = 0;
    const int nwg = nM * nN < g.lim ? nM * nN : g.lim; if (L >= nwg) return false;
    tile_of(nM, nN, (int)L, u, g.wgm ? g.wgm : WGM); return true;
}
__device__ __forceinline__ unsigned cvt_pk_bf16(float lo, float hi) { return pk2(lo, hi); }

struct EpiBf16 {
    static constexpr bool PERM = true;
    bf16_t* O; int ldc; int row0;
    __device__ __forceinline__ void operator()(const f32x4 (&acc)[2][2][4][2], const Unit& u, int wr, int wc, int fr, int fq) const {
        const int rowb = row0 + u.pm * BM + wr * 64 + fr; const int col0 = u.pn * BM + wc * 32 + 8 * fq;
#pragma unroll
        for (int ai = 0; ai < 2; ++ai)
#pragma unroll
            for (int m = 0; m < 4; ++m) { bf16_t* rowp = O + (size_t)(rowb + ai * HALF + m * 16) * ldc + col0;
#pragma unroll
                for (int bj = 0; bj < 2; ++bj) { const f32x4 v0 = acc[ai][bj][m][0], v1 = acc[ai][bj][m][1];
                    u32x4 w; w.x = cvt_pk_bf16(v0[0], v0[1]); w.y = cvt_pk_bf16(v0[2], v0[3]); w.z = cvt_pk_bf16(v1[0], v1[1]); w.w = cvt_pk_bf16(v1[2], v1[3]);
                    *(u32x4*)(rowp + bj * HALF) = w; } }
    }
};
struct EpiSwiGLU {
    static constexpr bool PERM = true;
    bf16_t* O; int ldc;
    __device__ __forceinline__ void operator()(const f32x4 (&acc)[2][2][4][2], const Unit& u, int wr, int wc, int fr, int fq) const {
        const int rowb = u.pm * BM + wr * 64 + fr; const int col0 = u.pn * HALF + wc * 32 + 8 * fq;
#pragma unroll
        for (int ai = 0; ai < 2; ++ai)
#pragma unroll
            for (int m = 0; m < 4; ++m) { bf16_t* rowp = O + (size_t)(rowb + ai * HALF + m * 16) * ldc + col0;
                float a[8];
#pragma unroll
                for (int n = 0; n < 2; ++n) { const f32x4 g = acc[ai][0][m][n], v = acc[ai][1][m][n];
#pragma unroll
                    for (int e2 = 0; e2 < 2; ++e2) {
                        const f32x2 gg = (f32x2){g[2 * e2], g[2 * e2 + 1]}, vv = (f32x2){v[2 * e2], v[2 * e2 + 1]};
                        const f32x2 x = gg * (f32x2){-1.4426950408889634f, -1.4426950408889634f};
                        f32x2 d; d.x = __builtin_amdgcn_exp2f(x.x); d.y = __builtin_amdgcn_exp2f(x.y);
                        d = d + (f32x2){1.f, 1.f};
                        f32x2 r; r.x = __builtin_amdgcn_rcpf(d.x); r.y = __builtin_amdgcn_rcpf(d.y);
                        const f32x2 o = (gg * r) * vv;
                        a[4 * n + 2 * e2] = o.x; a[4 * n + 2 * e2 + 1] = o.y; } }
                u32x4 w; w.x = cvt_pk_bf16(a[0], a[1]); w.y = cvt_pk_bf16(a[2], a[3]); w.z = cvt_pk_bf16(a[4], a[5]); w.w = cvt_pk_bf16(a[6], a[7]);
                *(u32x4*)rowp = w; }
    }
};
template<bool F32B>
struct EpiResid {
    static constexpr bool PERM = true;
    const float* base_f; bf16_t* xb; const float* gate;
    __device__ __forceinline__ void operator()(const f32x4 (&acc)[2][2][4][2], const Unit& u, int wr, int wc, int fr, int fq) const {
        const int s = u.pm >> 5;
        const int rowb = u.pm * BM + wr * 64 + fr; const int col0 = u.pn * BM + wc * 32 + 8 * fq;
        f32x4 gv[2][2];
#pragma unroll
        for (int bj = 0; bj < 2; ++bj)
#pragma unroll
            for (int n = 0; n < 2; ++n) gv[bj][n] = *(const f32x4*)(gate + s * 6144 + col0 + bj * HALF + n * 4);
#pragma unroll
        for (int ai = 0; ai < 2; ++ai)
#pragma unroll
            for (int m = 0; m < 4; ++m) { const size_t off = (size_t)(rowb + ai * HALF + m * 16) * D + col0;
#pragma unroll
                for (int bj = 0; bj < 2; ++bj) { f32x4 b0, b1;
                    if (F32B) { b0 = *(const f32x4*)(base_f + off + bj * HALF); b1 = *(const f32x4*)(base_f + off + bj * HALF + 4); }
                    else { const u32x4 w = *(const u32x4*)(xb + off + bj * HALF);
                        b0 = (f32x4){__uint_as_float(w.x << 16), __uint_as_float(w.x & 0xffff0000u), __uint_as_float(w.y << 16), __uint_as_float(w.y & 0xffff0000u)};
                        b1 = (f32x4){__uint_as_float(w.z << 16), __uint_as_float(w.z & 0xffff0000u), __uint_as_float(w.w << 16), __uint_as_float(w.w & 0xffff0000u)}; }
                    b0 += gv[bj][0] * acc[ai][bj][m][0]; b1 += gv[bj][1] * acc[ai][bj][m][1];
                    u32x4 o; o.x = cvt_pk_bf16(b0[0], b0[1]); o.y = cvt_pk_bf16(b0[2], b0[3]); o.z = cvt_pk_bf16(b1[0], b1[1]); o.w = cvt_pk_bf16(b1[2], b1[3]);
                    *(u32x4*)(xb + off + bj * HALF) = o; } }
    }
};

struct EpiPartial {
    static constexpr bool PERM = false;
    float* P; int ldc; int rows;
    __device__ __forceinline__ void operator()(const f32x4 (&acc)[2][2][4][2], const Unit& u, int wr, int wc, int fr, int fq) const {
        const int rowb = u.pm * BM + wr * 64 + fr; const int col0 = u.pn * BM + wc * 32 + 4 * fq;
        float* base = P + (size_t)u.ks * rows * ldc;
#pragma unroll
        for (int ai = 0; ai < 2; ++ai)
#pragma unroll
            for (int m = 0; m < 4; ++m) { float* rowp = base + (size_t)(rowb + ai * HALF + m * 16) * ldc + col0;
#pragma unroll
                for (int bj = 0; bj < 2; ++bj)
#pragma unroll
                    for (int n = 0; n < 2; ++n) *(f32x4*)(rowp + bj * HALF + n * 16) = acc[ai][bj][m][n]; }
    }
};

struct EpiPartialTile {
    static constexpr bool PERM = false;
    bf16_t* P; int nS;
    __device__ __forceinline__ void operator()(const f32x4 (&acc)[2][2][4][2], const Unit& u, int wr, int wc, int fr, int fq) const {
        bf16_t* base = P + (size_t)(u.uid * nS + u.ks) * 65536 + (size_t)(wr * 64 + fr) * 256 + wc * 32 + 4 * fq;
#pragma unroll
        for (int ai = 0; ai < 2; ++ai)
#pragma unroll
            for (int m = 0; m < 4; ++m) { bf16_t* rowp = base + (size_t)(ai * HALF + m * 16) * 256;
#pragma unroll
                for (int bj = 0; bj < 2; ++bj)
#pragma unroll
                    for (int n = 0; n < 2; ++n) { const f32x4 v = acc[ai][bj][m][n]; u32x2 w; w.x = cvt_pk_bf16(v[0], v[1]); w.y = cvt_pk_bf16(v[2], v[3]); *(u32x2*)(rowp + bj * HALF + n * 16) = w; } }
    }
};

__device__ __forceinline__ void a_offsets(const Gemm& g, const Unit& u, int tid, unsigned (&o)[2][2]) {
#pragma unroll
    for (int h = 0; h < 2; ++h)
#pragma unroll
        for (int i = 0; i < 2; ++i) {
            int R, C; stage_rc(tid * 16 + i * 8192, R, C);
            const int lr = u.pm * BM + h * HALF + R;
            const int row = g.rowmap ? g.rowmap[g.tile0 * BM + lr] : g.arow0 + lr;
            o[h][i] = ((unsigned)row * (unsigned)g.K + (unsigned)(u.ks * g.klen + C)) * 2u;
        }
}
__device__ __forceinline__ const char* b_base(const Gemm& g, const Unit& u) {
    const bf16_t* bb = g.Bt;
    if (g.tile_e) { const int ex = g.tile_e[g.tile0 + u.pm]; bb = (ex < g.esplit ? g.Bt2 : g.Bt) + (size_t)ex * g.estride; }
    return (const char*)(bb + (size_t)u.pn * BM * g.K + (size_t)u.ks * g.klen);
}

template <class Epi>
__device__ __forceinline__ void gemm_phase(LAS unsigned char* lds, const Gemm g, const Epi& E, int tid, int wid) {
    const int lane = tid & 63, wr = wid >> 2, wc = wid & 3, fr = lane & 15, fq = lane >> 4;
    const int K = g.K, nt = g.klen / BK, G = g.gG ? g.gG : (int)gridDim.x, cidx = blockIdx.x;
    if (cidx >= G) return;
    unsigned voffB[2];
#pragma unroll
    for (int i = 0; i < 2; ++i) { int R, C; stage_rc(tid * 16 + i * 8192, R, C); const int Rb = Epi::PERM ? ((R & ~31) + perm32(R & 31)) : R; voffB[i] = (unsigned)(Rb * K + C) * 2u; }
    const size_t kstep = (size_t)(BK * 2);
    const size_t hstep = (size_t)HALF * K * 2;
    const unsigned ldsw = (unsigned)wid * 1024u;
    const int aoff = lds_byte(wr * 64 + fr, fq * 8), boff = lds_byte(wc * 32 + fr, fq * 8);
#define PG8_SA(b, h) (((b) * 2 + (h)) * HTB)
#define PG8_SB(b, h) ((4 + (b) * 2 + (h)) * HTB)
#define PG8_STAGE(bufoff, gbase, voff) do { _Pragma("unroll") for (int _i = 0; _i < 2; ++_i) \
        __builtin_amdgcn_global_load_lds((const unsigned*)((const char*)(gbase) + (voff)[_i]), (LAS unsigned*)(lds + (bufoff) + ldsw + _i * 8192), 16, 0, 0); } while (0)
#define PG8_LDA(dst, b, h) do { _Pragma("unroll") for (int m = 0; m < 4; ++m) _Pragma("unroll") for (int k = 0; k < 2; ++k) dst[m][k] = *(const LAS bf16x8*)(lds + PG8_SA(b, h) + aoff + m * 2048 + k * 1024); } while (0)
#define PG8_LDB(dst, b, h) do { _Pragma("unroll") for (int n = 0; n < 2; ++n) _Pragma("unroll") for (int k = 0; k < 2; ++k) dst[n][k] = *(const LAS bf16x8*)(lds + PG8_SB(b, h) + boff + n * 2048 + k * 1024); } while (0)
#define PG8_MMA(ai, bj, At, Bt) do { __builtin_amdgcn_s_setprio(1); _Pragma("unroll") for (int m = 0; m < 4; ++m) _Pragma("unroll") for (int n = 0; n < 2; ++n) _Pragma("unroll") for (int k = 0; k < 2; ++k) \
        acc[ai][bj][m][n] = __builtin_amdgcn_mfma_f32_16x16x32_bf16(Bt[n][k], At[m][k], acc[ai][bj][m][n], 0, 0, 0); __builtin_amdgcn_s_setprio(0); } while (0)
#define PG8_WAIT_V(n) asm volatile("s_waitcnt vmcnt(" #n ")" ::: "memory")
#define PG8_WAIT_L(n) asm volatile("s_waitcnt lgkmcnt(" #n ")" ::: "memory")
#define PG8_BAR __builtin_amdgcn_s_barrier()
#define PG8_SCHED __builtin_amdgcn_sched_barrier(0)
    Unit cur, nxt; int ui = 0;
    if (!next_unit(g, G, cidx, 0, cur)) return;
    f32x4 acc[2][2][4][2];
#pragma unroll
    for (int a = 0; a < 2; ++a)
#pragma unroll
        for (int b = 0; b < 2; ++b)
#pragma unroll
            for (int m = 0; m < 4; ++m)
#pragma unroll
                for (int n = 0; n < 2; ++n) acc[a][b][m][n] = (f32x4){0.f, 0.f, 0.f, 0.f};
    bf16x8 At[4][2], B0[2][2], B1[2][2];
    const char* const Ab = (const char*)g.A;
    unsigned oc[2][2];
    a_offsets(g, cur, tid, oc);
    const char* cB = b_base(g, cur);
    PG8_STAGE(PG8_SB(0, 0), cB, voffB); PG8_STAGE(PG8_SB(0, 1), cB + hstep, voffB); PG8_STAGE(PG8_SA(0, 0), Ab, oc[0]); PG8_STAGE(PG8_SA(0, 1), Ab, oc[1]);
    if (wr == 1) PG8_BAR;
    PG8_WAIT_V(2); PG8_BAR;
    PG8_STAGE(PG8_SB(1, 0), cB + kstep, voffB); PG8_STAGE(PG8_SA(1, 0), Ab + kstep, oc[0]); PG8_STAGE(PG8_SB(1, 1), cB + hstep + kstep, voffB);
    PG8_WAIT_V(6); PG8_BAR;
    for (;;) {
        bool has_next = false; const char* nB = cB;
        for (int t = 0; t < nt; t += 2) {
            const bool last = (t == nt - 2);
            const char* a1 = Ab + (size_t)(t + 1) * kstep;
            PG8_LDB(B0, 0, 0); PG8_LDB(B1, 0, 1); PG8_SCHED; PG8_LDA(At, 0, 0); PG8_STAGE(PG8_SA(1, 1), a1, oc[1]);
            PG8_WAIT_V(8); PG8_WAIT_L(0); PG8_BAR; PG8_MMA(0, 0, At, B0); PG8_MMA(0, 1, At, B1); PG8_BAR; PG8_SCHED;
            if (last) { has_next = next_unit(g, G, cidx, ui + 1, nxt); if (has_next) { a_offsets(g, nxt, tid, oc); nB = b_base(g, nxt); } }
            const char* a2 = last ? Ab : Ab + (size_t)(t + 2) * kstep; const char* b2 = last ? nB : cB + (size_t)(t + 2) * kstep;
            const char* a3 = a2 + kstep; const char* b3 = b2 + kstep;
            PG8_LDA(At, 0, 1); PG8_STAGE(PG8_SB(0, 0), b2, voffB); PG8_STAGE(PG8_SB(0, 1), b2 + hstep, voffB); PG8_STAGE(PG8_SA(0, 0), a2, oc[0]);
            PG8_WAIT_V(8); PG8_WAIT_L(0); PG8_BAR; PG8_MMA(1, 0, At, B0); PG8_MMA(1, 1, At, B1); PG8_BAR; PG8_SCHED;
            PG8_LDB(B0, 1, 0); PG8_LDB(B1, 1, 1); PG8_SCHED; PG8_LDA(At, 1, 0); PG8_STAGE(PG8_SA(0, 1), a2, oc[1]);
            PG8_WAIT_V(8); PG8_WAIT_L(0); PG8_BAR; PG8_MMA(0, 0, At, B0); PG8_MMA(0, 1, At, B1); PG8_BAR; PG8_SCHED;
            PG8_LDA(At, 1, 1); PG8_STAGE(PG8_SB(1, 0), b3, voffB); PG8_STAGE(PG8_SB(1, 1), b3 + hstep, voffB); PG8_STAGE(PG8_SA(1, 0), a3, oc[0]);
            PG8_WAIT_V(8); PG8_WAIT_L(0); PG8_BAR; PG8_MMA(1, 0, At, B0); PG8_MMA(1, 1, At, B1); PG8_BAR; PG8_SCHED;
        }
        if (wr == 0) PG8_BAR;
        E(acc, cur, wr, wc, fr, fq);
        if (!has_next) break;
#pragma unroll
        for (int a = 0; a < 2; ++a)
#pragma unroll
            for (int b = 0; b < 2; ++b)
#pragma unroll
                for (int m = 0; m < 4; ++m)
#pragma unroll
                    for (int n = 0; n < 2; ++n) acc[a][b][m][n] = (f32x4){0.f, 0.f, 0.f, 0.f};
        cur = nxt; cB = nB; ++ui;
        if (wr == 1) PG8_BAR;
    }
    PG8_WAIT_V(0);
    PG8_BAR;
#undef PG8_SA
#undef PG8_SB
#undef PG8_STAGE
#undef PG8_LDA
#undef PG8_LDB
#undef PG8_MMA
#undef PG8_WAIT_V
#undef PG8_WAIT_L
#undef PG8_BAR
#undef PG8_SCHED
}
}
struct Ctx {
    const Params* p;
    unsigned char* lds;
    unsigned char* ws;
    int tid, lane, wave, bid, G;
};
#define INP(i) (c.p->in[i])
#define WSP(T, off) ((T*)(c.ws + (off)))

constexpr int CI_WIN = 16 * 15, CI_WOUT = 16 * 4, CI_W13 = 16 * 28, CI_W2 = 56 * 4;
constexpr int CI_DENSE = 2 * CI_WIN + 2 * CI_WOUT + CI_W13 + CI_W2;
constexpr int CI_EARLY = 8 * CI_W2 + NE13 * CI_W13, CI_LATE = (8 - NE13) * CI_W13;
struct CvtJob { const float* s0; const float* s1; int ldsrc, mode, k0, n0; bf16_t* dst; int Kdst; };
__device__ __forceinline__ void cvt_job(const Ctx& c, int pool, int it, CvtJob& j) {
    if (pool == 2) {
        if (it < 2 * CI_WIN) { const int l = it / CI_WIN, r = it % CI_WIN;
            j.s0 = INP(8) + (size_t)l * D * DPROJ; j.s1 = j.s0; j.ldsrc = DPROJ; j.mode = 0; j.k0 = (r / 15) * 64; j.n0 = (r % 15) * 256; j.dst = WSP(bf16_t, WS_WIN) + (size_t)l * NP * D; j.Kdst = D; return; }
        it -= 2 * CI_WIN;
        if (it < 2 * CI_WOUT) { const int l = it / CI_WOUT, r = it % CI_WOUT;
            j.s0 = INP(9) + (size_t)l * D * D; j.s1 = j.s0; j.ldsrc = D; j.mode = 1; j.k0 = (r / 4) * 64; j.n0 = (r % 4) * 256; j.dst = WSP(bf16_t, WS_WOUT) + (size_t)l * D * D; j.Kdst = D; return; }
        it -= 2 * CI_WOUT;
        if (it < CI_W13) { j.s0 = INP(19); j.s1 = INP(20); j.ldsrc = DFF; j.mode = 2; j.k0 = (it / 28) * 64; j.n0 = (it % 28) * 256; j.dst = WSP(bf16_t, WS_W13); j.Kdst = D; return; }
        it -= CI_W13;
        j.s0 = INP(21); j.s1 = j.s0; j.ldsrc = D; j.mode = 1; j.k0 = (it / 4) * 64; j.n0 = (it % 4) * 256; j.dst = WSP(bf16_t, WS_W2); j.Kdst = DFF; return;
    }
    if (pool == 0 && it < 8 * CI_W2) { const int e = it / CI_W2, r = it % CI_W2;
        j.s0 = INP(26) + (size_t)e * DFF * D; j.s1 = j.s0; j.ldsrc = D; j.mode = 1; j.k0 = (r / 4) * 64; j.n0 = (r % 4) * 256; j.dst = (bf16_t*)c.p->out + (size_t)e * D * DFF; j.Kdst = DFF; return; }
    int e, r; bf16_t* base;
    if (pool == 0) { it -= 8 * CI_W2; e = it / CI_W13; r = it % CI_W13; base = WSP(bf16_t, WS_MOEW13E); }
    else { e = NE13 + it / CI_W13; r = it % CI_W13; base = WSP(bf16_t, WS_MOEW13); }
    j.s0 = INP(24) + (size_t)e * D * DFF; j.s1 = INP(25) + (size_t)e * D * DFF; j.ldsrc = DFF; j.mode = 2; j.k0 = (r / 28) * 64; j.n0 = (r % 28) * 256; j.dst = base + (size_t)e * 7168 * D; j.Kdst = D;
}
__device__ __forceinline__ void cvt_issue(const Ctx& c, const CvtJob& j, f32x4 (&v)[4][2]) {
#pragma unroll
    for (int q = 0; q < 4; ++q)
#pragma unroll
        for (int i = 0; i < 2; ++i) {
            const int idx = c.tid + 512 * i, kk = idx >> 4, nn = (idx & 15) * 4, n = j.n0 + 64 * q + nn;
            const float* sp = j.s0; int col = n;
            if (j.mode == 0) col = n + (n >= 2304 ? 16 : 0);
            else if (j.mode == 2) { const int r = n & 255; sp = r < 128 ? j.s0 : j.s1; col = (n >> 8) * 128 + (r & 127); }
            v[q][i] = __builtin_nontemporal_load((const f32x4*)(sp + (size_t)(j.k0 + kk) * j.ldsrc + col));
        }
}
__device__ __forceinline__ void cvt_stream(const Ctx& c, int pool, int nitems, unsigned* q, unsigned* busy, unsigned nshort, int ns = 0) {
    float* tile = (float*)c.lds; int* slot = (int*)(c.lds + LDS_CTLOFF + 1024);
#define CVT_PULL(dst_) do { if (c.tid == 0) { int v_ = -1; if (busy == nullptr || __hip_atomic_load(busy, __ATOMIC_RELAXED, __HIP_MEMORY_SCOPE_AGENT) <= nshort) v_ = (int)__hip_atomic_fetch_add(q, 1u, __ATOMIC_RELAXED, __HIP_MEMORY_SCOPE_AGENT); dst_ = v_; } } while (0)
    const int dbase = ns * c.G; int kq = 0;
    int it; if (ns > 0) it = c.bid; else { int tk = 0; CVT_PULL(tk); if (c.tid == 0) *slot = tk; __syncthreads(); it = *slot; __syncthreads(); }
    if (it < 0 || it >= nitems) return;
    CvtJob j; cvt_job(c, pool, it, j);
    f32x4 v[4][2]; cvt_issue(c, j, v);
    for (;;) {
        const bool dynq = kq + 1 >= ns;
        int tk = 0; if (dynq) CVT_PULL(tk);
#pragma unroll
        for (int qq = 0; qq < 4; ++qq)
#pragma unroll
            for (int i = 0; i < 2; ++i) { const int idx = c.tid + 512 * i, kk = idx >> 4, nn = (idx & 15) * 4; const float sc = (j.mode == 0 && j.n0 + 64 * qq + nn < 256) ? 0.125f : 1.f;
#pragma unroll
                for (int e = 0; e < 4; ++e) tile[qq * 4160 + kk * 65 + nn + e] = v[qq][i][e] * sc; }
        if (dynq && c.tid == 0) *slot = tk;
        __syncthreads();
        const int itn = dynq ? ((*slot < 0) ? -1 : *slot + dbase) : c.bid + (kq + 1) * c.G; const bool more = itn >= 0 && itn < nitems;
        CvtJob jn = j; if (more) { cvt_job(c, pool, itn, jn); cvt_issue(c, jn, v); }
#pragma unroll
        for (int qq = 0; qq < 4; ++qq) {
            const int r = c.tid >> 3, ch = c.tid & 7; float f[8];
#pragma unroll
            for (int e = 0; e < 8; ++e) f[e] = tile[qq * 4160 + (8 * ch + e) * 65 + r];
            *(u32x4*)(j.dst + (size_t)(j.n0 + 64 * qq + r) * j.Kdst + j.k0 + 8 * ch) = pack8(f);
        }
        __syncthreads();
        if (!more) break;
        j = jn; ++kq;
    }
#undef CVT_PULL
}
__device__ __forceinline__ void early_cvt(const Ctx& c, int slot, int nG, int nunits) {
    unsigned* q = WSP(unsigned, WS_CTL) + CW_CV; unsigned* done = WSP(unsigned, WS_CTL) + CW_CV + 32 + 16 * slot;
    if (c.bid < nG) { if (c.tid == 0) __hip_atomic_fetch_add(done, 1u, __ATOMIC_RELAXED, __HIP_MEMORY_SCOPE_AGENT); return; }
    const unsigned nshort = (nunits % nG) ? (unsigned)(nG - nunits % nG) : 0u;
    cvt_stream(c, 0, CI_EARLY, q, done, nshort);
}
__device__ __forceinline__ void late_cvt(const Ctx& c) {
    unsigned* q = WSP(unsigned, WS_CTL) + CW_CV;
    cvt_stream(c, 0, CI_EARLY, q, nullptr, 0u);
    cvt_stream(c, 1, CI_LATE, q + 16, nullptr, 0u, CI_LATE / c.G - 1);
}

__device__ __forceinline__ void phase_prologue(const Ctx& c) {
    {
        float* sv = (float*)c.lds;
        float* red = sv + 3 * 1024;
        for (int i = c.tid; i < 3 * 1024; i += 512) { const int s = i >> 10, k = i & 1023; const float x = s < 2 ? INP(1)[s * D + k] : INP(3)[k]; sv[i] = siluf_(x); }
        __syncthreads();
        for (int it = c.bid; it < 2 * 96; it += c.G) {
            const int l = it / 96, n0 = (it % 96) * 64, c4 = c.tid & 15, kg = c.tid >> 4;
            const float* w = INP(4) + (size_t)l * D * 6144 + n0 + 4 * c4;
            f32x4 a0 = (f32x4){0.f, 0.f, 0.f, 0.f}, a1 = a0, a2 = a0;
#pragma unroll 16
            for (int jj = 0; jj < 32; ++jj) { const int k = kg + 32 * jj; const f32x4 wv = __builtin_nontemporal_load((const f32x4*)(w + (size_t)k * 6144)); a0 += sv[k] * wv; a1 += sv[1024 + k] * wv; a2 += sv[2048 + k] * wv; }
            *(f32x4*)(red + (kg * 3 + 0) * 64 + 4 * c4) = a0; *(f32x4*)(red + (kg * 3 + 1) * 64 + 4 * c4) = a1; *(f32x4*)(red + (kg * 3 + 2) * 64 + 4 * c4) = a2;
            __syncthreads();
            if (c.tid < 192) { const int s = c.tid >> 6, col = c.tid & 63; float a = INP(5)[l * 6144 + n0 + col];
#pragma unroll 8
                for (int q = 0; q < 32; ++q) a += red[(q * 3 + s) * 64 + col];
                WSP(float, WS_MOD)[(l * 3 + s) * 6144 + n0 + col] = a; }
            __syncthreads();
        }
    }
    {
        const int gt = c.bid * 512 + c.tid, GT = c.G * 512;
        for (int i = gt; i < 2 * 16 * 1024; i += GT) { const int l = i >> 14, j = (i >> 10) & 15, k = i & 1023; WSP(float, WS_WG)[i] = INP(8)[(size_t)l * D * DPROJ + (size_t)k * DPROJ + 2304 + j]; }
        for (int i = gt; i < 8 * 1024; i += GT) { const int e = i >> 10, k = i & 1023; WSP(float, WS_WR)[i] = INP(22)[k * 8 + e]; }
        for (int i = gt; i < 128 * 16; i += GT) { const int pos = i >> 4, f = i & 15; const float inv = powf(10000.f, -(float)f / 16.f); const float ang = (float)pos * inv;
            WSP(float, WS_ROPE)[i] = cosf(ang); WSP(float, WS_ROPE)[2048 + i] = sinf(ang); }
        for (int i = gt; i < NSLOTS; i += GT) WSP(int, WS_SLOTTOK)[i] = 0;
    }
    __syncthreads();
    cvt_stream(c, 2, CI_DENSE, WSP(unsigned, WS_CTL) + CW_CV + 96, nullptr, 0u, CI_DENSE / c.G - 1);
}

__device__ __forceinline__ void norm_coef(const Ctx& c, int l, int which, int s, f32x4 (&ca)[4], f32x4 (&cb)[4]) {
    const float* ng = INP(which == 1 ? 6 : 7) + l * D;
    const float* sh = WSP(float, WS_MOD) + (size_t)l * 3 * 6144 + s * 6144 + (which == 1 ? 0 : 3072); const float* sc = sh + 1024;
#pragma unroll
    for (int j = 0; j < 4; ++j) { const int col = 4 * c.lane + 256 * j;
        const f32x4 g = *(const f32x4*)(ng + col), a = *(const f32x4*)(sc + col); ca[j] = g * (a + 1.f); cb[j] = *(const f32x4*)(sh + col); }
}
__device__ __forceinline__ void norm_apply(const Ctx& c, int row, f32x4 (&v)[4], const f32x4 (&ca)[4], const f32x4 (&cb)[4]) {
    bf16_t* H = WSP(bf16_t, WS_H);
    float ss = 0.f;
#pragma unroll
    for (int j = 0; j < 4; ++j) ss += (v[j].x * v[j].x + v[j].y * v[j].y) + (v[j].z * v[j].z + v[j].w * v[j].w);
    const float r = rsqrtf(wave_sum(ss) * (1.f / D) + EPS);
#pragma unroll
    for (int j = 0; j < 4; ++j) { const int col = 4 * c.lane + 256 * j;
        v[j] = (v[j] * r) * ca[j] + cb[j];
        u32x2 w; w.x = pk2(v[j].x, v[j].y); w.y = pk2(v[j].z, v[j].w);
        *(u32x2*)(H + (size_t)row * D + col) = w; }
}
__device__ __forceinline__ void norm_tail(const Ctx& c, int NG, int row, float mine, unsigned* hist, const float (&rb)[8]) {
    if (NG == 16) { if (c.lane < 16) WSP(float, WS_GATES)[(size_t)row * 16 + c.lane] = mine; }
    else {
        float lg[8];
#pragma unroll
        for (int q = 0; q < 8; ++q) lg[q] = __shfl(mine, q) + rb[q];
        int e0 = 0; float m0 = lg[0];
#pragma unroll
        for (int q = 1; q < 8; ++q) if (lg[q] > m0) { m0 = lg[q]; e0 = q; }
        int e1 = -1; float m1 = -3.0e38f;
#pragma unroll
        for (int q = 0; q < 8; ++q) if (q != e0 && lg[q] > m1) { m1 = lg[q]; e1 = q; }
        const float g0 = 1.f / (1.f + expf(m1 - m0)), g1 = 1.f - g0;
        if (c.lane == 0) { WSP(int, WS_TOKE)[row * 2] = e0; WSP(int, WS_TOKE)[row * 2 + 1] = e1; WSP(float, WS_TOKG)[row * 2] = g0; WSP(float, WS_TOKG)[row * 2 + 1] = g1;
            atomicAdd(&hist[e0], 1u); atomicAdd(&hist[e1], 1u); }
    }
}
__device__ __forceinline__ void norm_row(const Ctx& c, int l, int which, int NG, int row, f32x4 (&v)[4], const float* wl, unsigned* hist, const f32x4 (&ca)[4], const f32x4 (&cb)[4], const float (&rb)[8]) {
    norm_apply(c, row, v, ca, cb);
    if (NG) {
        float mine = 0.f;
#pragma unroll 2
        for (int q = 0; q < NG; ++q) { float a = 0.f;
#pragma unroll
            for (int j = 0; j < 4; ++j) { const f32x4 w = *(const f32x4*)(wl + q * 1024 + 4 * c.lane + 256 * j); a += (v[j].x * w.x + v[j].y * w.y) + (v[j].z * w.z + v[j].w * w.w); }
            a = wave_sum(a); if (c.lane == q) mine = a; }
        norm_tail(c, NG, row, mine, hist, rb);
    }
}
template <int NGT>
__device__ __forceinline__ void wave_sum_multi(float (&a)[NGT]) {
    static_assert(NGT == 16 || NGT == 8, "");
#pragma unroll
    for (int k = 0; k < NGT / 2; ++k) { const auto r = __builtin_amdgcn_permlane32_swap(__float_as_uint(a[k]), __float_as_uint(a[k + NGT / 2]), false, false); a[k] = __uint_as_float(r[0]) + __uint_as_float(r[1]); }
#pragma unroll
    for (int k = 0; k < NGT / 4; ++k) { const auto r = __builtin_amdgcn_permlane16_swap(__float_as_uint(a[k]), __float_as_uint(a[k + NGT / 4]), false, false); a[k] = __uint_as_float(r[0]) + __uint_as_float(r[1]); }
#pragma unroll
    for (int k = 0; k < NGT / 4; ++k) { float v = a[k];
#define DPP_ADD(ctrl) v += __builtin_bit_cast(float, __builtin_amdgcn_update_dpp(0, __builtin_bit_cast(int, v), (ctrl), 0xf, 0xf, true))
        DPP_ADD(0x111); DPP_ADD(0x112); DPP_ADD(0x114); DPP_ADD(0x118);
#undef DPP_ADD
        a[k] = v; }
}
template <int NGT>
__device__ __forceinline__ void norm_tail_multi(const Ctx& c, int row, float (&a)[NGT], unsigned* hist, const float (&rb)[8]) {
    wave_sum_multi<NGT>(a);
    if (NGT == 16) {
        if ((c.lane & 15) == 15) {
#pragma unroll
            for (int k = 0; k < 4; ++k) WSP(float, WS_GATES)[(size_t)row * 16 + k + 4 * (c.lane >> 4)] = a[k]; }
    } else {
        float lg[8];
#pragma unroll
        for (int q = 0; q < 8; ++q) lg[q] = __builtin_bit_cast(float, __builtin_amdgcn_readlane(__builtin_bit_cast(int, a[q & 1]), 16 * (q >> 1) + 15)) + rb[q];
        int e0 = 0; float m0 = lg[0];
#pragma unroll
        for (int q = 1; q < 8; ++q) if (lg[q] > m0) { m0 = lg[q]; e0 = q; }
        int e1 = -1; float m1 = -3.0e38f;
#pragma unroll
        for (int q = 0; q < 8; ++q) if (q != e0 && lg[q] > m1) { m1 = lg[q]; e1 = q; }
        const float g0 = 1.f / (1.f + expf(m1 - m0)), g1 = 1.f - g0;
        if (c.lane == 0) { WSP(int, WS_TOKE)[row * 2] = e0; WSP(int, WS_TOKE)[row * 2 + 1] = e1; WSP(float, WS_TOKG)[row * 2] = g0; WSP(float, WS_TOKG)[row * 2 + 1] = g1;
            atomicAdd(&hist[e0], 1u); atomicAdd(&hist[e1], 1u); }
    }
}
template <int NGT>
__device__ __forceinline__ void norm_gates2(const Ctx& c, int rowa, int rowb, const f32x4 (&va)[4], const f32x4 (&vb)[4], const float* wl, unsigned* hist, const float (&rb)[8]) {
    float pa[NGT], pb[NGT];
#pragma unroll
    for (int q = 0; q < NGT; ++q) { f32x2 a2 = (f32x2){0.f, 0.f}, b2 = a2;
#pragma unroll
        for (int j = 0; j < 4; ++j) { const f32x4 w = *(const f32x4*)(wl + q * 1024 + 4 * c.lane + 256 * j); const f32x2 wl2 = (f32x2){w.x, w.y}, wh2 = (f32x2){w.z, w.w};
            a2 += (f32x2){va[j].x, va[j].y} * wl2; a2 += (f32x2){va[j].z, va[j].w} * wh2; b2 += (f32x2){vb[j].x, vb[j].y} * wl2; b2 += (f32x2){vb[j].z, vb[j].w} * wh2; }
        pa[q] = a2.x + a2.y; pb[q] = b2.x + b2.y;
        if (q & 1) asm volatile("" : "+v"(pa[q - 1]), "+v"(pb[q - 1]), "+v"(pa[q]), "+v"(pb[q]) :: "memory");
    }
    norm_tail_multi<NGT>(c, rowa, pa, hist, rb); norm_tail_multi<NGT>(c, rowb, pb, hist, rb);
}
__device__ __forceinline__ void norm_row2(const Ctx& c, int l, int which, int NG, int rowa, int rowb, f32x4 (&va)[4], f32x4 (&vb)[4], const float* wl, unsigned* hist, const f32x4 (&ca)[4], const f32x4 (&cb)[4], const float (&rb)[8]) {
    norm_apply(c, rowa, va, ca, cb); norm_apply(c, rowb, vb, ca, cb);
    if (NG == 16) norm_gates2<16>(c, rowa, rowb, va, vb, wl, hist, rb);
    else if (NG == 8) norm_gates2<8>(c, rowa, rowb, va, vb, wl, hist, rb);
}
__device__ __forceinline__ void phase_norm(const Ctx& c, int l, int which) {
    const int NG = which == 1 ? 16 : (l == 1 ? 8 : 0);
    float* wl = (float*)c.lds;
    unsigned* hist = (unsigned*)(c.lds + 65536);
    if (NG) { const float* src = which == 1 ? WSP(float, WS_WG) + l * 16 * 1024 : WSP(float, WS_WR);
        for (int i = c.tid; i < NG * 1024; i += 512) wl[i] = src[i]; }
    if (c.tid < 8) hist[c.tid] = 0u;
    __syncthreads();
    float rb[8];
#pragma unroll
    for (int q = 0; q < 8; ++q) rb[q] = NG == 8 ? INP(23)[q] : 0.f;
    {
        const int stride = c.G * 8, row0 = c.bid * 8 + c.wave;
#define NR_LOADF(dst_, r_) do { _Pragma("unroll") for (int j = 0; j < 4; ++j) dst_[j] = *(const f32x4*)(xl + (size_t)(r_) * D + 4 * c.lane + 256 * j); } while (0)
#define NR_LOADB(dst_, r_) do { _Pragma("unroll") for (int j = 0; j < 4; ++j) dst_[j] = *(const u32x2*)(xl + (size_t)(r_) * D + 4 * c.lane + 256 * j); } while (0)
#define NR_CVF(v_, src_) do { _Pragma("unroll") for (int j = 0; j < 4; ++j) v_[j] = src_[j]; } while (0)
#define NR_CVB(v_, src_) do { _Pragma("unroll") for (int j = 0; j < 4; ++j) v_[j] = (f32x4){__uint_as_float(src_[j].x << 16), __uint_as_float(src_[j].x & 0xffff0000u), __uint_as_float(src_[j].y << 16), __uint_as_float(src_[j].y & 0xffff0000u)}; } while (0)
#define NR_LOOP(LOAD_, CV_) do { \
        for (int s = 0; s < NB; ++s) { \
            const int lo_ = s * SEQ, lim_ = (s + 1) * SEQ; \
            int row = row0 >= lo_ ? row0 : row0 + ((lo_ - row0 + stride - 1) / stride) * stride; \
            f32x4 ca[4], cb[4]; norm_coef(c, l, which, s, ca, cb); \
            if (row < lim_) LOAD_(na, row); if (row + stride < lim_) LOAD_(nb, row + stride); \
            for (; row < lim_; row += 2 * stride) { \
                if (row + stride < lim_) { f32x4 va[4], vb[4]; CV_(va, na); CV_(vb, nb); \
                    if (row + 2 * stride < lim_) LOAD_(na, row + 2 * stride); if (row + 3 * stride < lim_) LOAD_(nb, row + 3 * stride); \
                    norm_row2(c, l, which, NG, row, row + stride, va, vb, wl, hist, ca, cb, rb); } \
                else { f32x4 v[4]; CV_(v, na); norm_row(c, l, which, NG, row, v, wl, hist, ca, cb, rb); } \
            } } } while (0)
        if (l == 0 && which == 1) { const float* xl = INP(0); f32x4 na[4], nb[4]; NR_LOOP(NR_LOADF, NR_CVF); }
        else { const bf16_t* xl = WSP(bf16_t, WS_XB); u32x2 na[4], nb[4]; NR_LOOP(NR_LOADB, NR_CVB); }
#undef NR_LOADF
#undef NR_LOADB
#undef NR_CVF
#undef NR_CVB
#undef NR_LOOP
    }
    if (!(l == 1 && which == 2)) {
        f32x4 ca[4], cb[4]; norm_coef(c, l, which, 2, ca, cb);
        for (int r = ((c.wave & 3) == 0) ? c.bid * 2 + (c.wave >> 2) : NCTX; r < NCTX; r += c.G * 2) {
            const float* xb = (l == 0) ? INP(2) + (size_t)r * D : WSP(float, WS_XC) + (size_t)r * D;
            f32x4 v[4];
#pragma unroll
            for (int j = 0; j < 4; ++j) v[j] = *(const f32x4*)(xb + 4 * c.lane + 256 * j);
            if (!(l == 0 && which == 1)) {
                const int S = (l == 0) ? CTX_SPLIT_O : CTX_SPLIT_F;
                const float* part = ((l == 0) ? WSP(float, WS_PARTO) : WSP(float, WS_PARTF)) + (size_t)r * D;
                const float* gate = WSP(float, WS_MOD) + 2 * 6144 + ((l == 0) ? 2048 : 5120);
                f32x4 acc[4];
#pragma unroll
                for (int j = 0; j < 4; ++j) acc[j] = (f32x4){0.f, 0.f, 0.f, 0.f};
#pragma unroll 1
                for (int ks = 0; ks < S; ks += 4) {
                    f32x4 tq[4][4];
#pragma unroll
                    for (int u = 0; u < 4; ++u)
#pragma unroll
                        for (int j = 0; j < 4; ++j) tq[u][j] = (ks + u < S) ? *(const f32x4*)(part + (size_t)(ks + u) * NCTX * D + 4 * c.lane + 256 * j) : (f32x4){0.f, 0.f, 0.f, 0.f};
#pragma unroll
                    for (int u = 0; u < 4; ++u)
#pragma unroll
                        for (int j = 0; j < 4; ++j) acc[j] += tq[u][j]; }
#pragma unroll
                for (int j = 0; j < 4; ++j) { v[j] += *(const f32x4*)(gate + 4 * c.lane + 256 * j) * acc[j];
                    if (l == 0) *(f32x4*)(WSP(float, WS_XC) + (size_t)r * D + 4 * c.lane + 256 * j) = v[j]; }
            }
            norm_row(c, l, which, NG, NLAT + r, v, wl, hist, ca, cb, rb);
        }
    }
    __syncthreads();
    if (NG == 8) {
        if (c.tid < 8) atomicAdd(WSP(unsigned, WS_CTL) + CW_CNT + c.tid, hist[c.tid]);
        asm volatile("s_waitcnt vmcnt(0)" ::: "memory");
        __syncthreads();
        if (c.tid == 0) { __builtin_amdgcn_fence(__ATOMIC_RELEASE, "agent"); __hip_atomic_fetch_add(WSP(unsigned, WS_CTL) + CW_RT, 1u, __ATOMIC_RELAXED, __HIP_MEMORY_SCOPE_AGENT); }
    }
    __syncthreads();
}
#ifndef AMP_ITEM
#define AMP_ITEM 0
#endif
#if AMP_ITEM
#define AMP_T0() const unsigned long long at0_ = __builtin_amdgcn_s_memrealtime()
#define AMP_SPIN(bit) do { if ((AMP_ITEM >> (bit)) & 1) { const unsigned long long at1_ = __builtin_amdgcn_s_memrealtime(); while (__builtin_amdgcn_s_memrealtime() < at1_ + (at1_ - at0_)) __builtin_amdgcn_s_sleep(4); } } while (0)
#else
#define AMP_T0() do {} while (0)
#define AMP_SPIN(bit) do {} while (0)
#endif
#define AMP_T1() const unsigned long long at0_ = __builtin_amdgcn_s_memrealtime()
__device__ __forceinline__ float gdn_gates(const Ctx& c, int l, int h, int dir, int base, int tau, float& beta) {
    const int tok = dir ? 63 - tau : tau;
    const float* gr = WSP(float, WS_GATES) + (size_t)(base + tok) * 16;
    const float a = gr[dir * 4 + h], bb = gr[8 + dir * 4 + h];
    const float xs = a + INP(14)[l * 8 + dir * 4 + h];
    const float la = -__expf(INP(13)[l * 8 + dir * 4 + h]) * (xs > 20.f ? xs : __logf(1.f + __expf(xs)));
    beta = __builtin_amdgcn_rcpf(1.f + __expf(-bb));
    return wave_scan(la);
}

__device__ __forceinline__ void m1_gdn_item(const Ctx& c, int l, int b, int h, int cid) {
    unsigned char* L0 = c.lds;
    float* raw = (float*)L0;
    float* Lm = (float*)L0;
    bf16_t* QKm = (bf16_t*)L0;
    bf16_t* WT = (bf16_t*)(L0 + 32768);
    float* cw = (float*)(L0 + 53312);
    float* gl = (float*)(L0 + 57344);
    bf16_t* Qf = (bf16_t*)(L0 + 58368);
    bf16_t* Kf = Qf + 64 * LDP; bf16_t* Vf = Kf + 64 * LDP;
    bf16_t* KdT = Vf + 64 * LDP;
    bf16_t* U0T = KdT + 2 * 64 * LDP;
    const int base = chunk_row(b, cid), t0 = cid < 128 ? cid * 64 : (cid - 128) * 64, slen = cid < 128 ? SEQ : CTXL;
    const bf16_t* P = WSP(bf16_t, WS_P);
    { AMP_T0();
    u32x4 rv[4]; float cwv[2]; f32x4 rcs[2], rsn[2]; float ga_ = 0.f, gb_ = 0.f, gdt_ = 0.f, gal_ = 0.f;
#pragma unroll
    for (int i = 0; i < 4; ++i) { const int idx = c.tid + 512 * i, rr = idx / 24, ch = idx % 24, part = ch >> 3, c8 = ch & 7, tt = t0 + rr - 2;
        rv[i] = (u32x4){0u, 0u, 0u, 0u};
        if (idx < 68 * 24 && tt >= 0 && tt < slen) rv[i] = *(const u32x4*)(P + (size_t)(base + rr - 2) * NP + C_GQ + part * 256 + h * 64 + c8 * 8); }
#pragma unroll
    for (int i = 0; i < 2; ++i) { const int ii = c.tid + 512 * i; cwv[i] = 0.f;
        if (ii < 5 * 192) { const int k = ii / 192, j = ii % 192, part = j >> 6, d = j & 63; cwv[i] = INP(12)[(size_t)l * 5 * 768 + k * 768 + part * 256 + h * 64 + d]; } }
    {
        const int t = c.tid >> 3, sub = c.tid & 7; const int i0 = (sub & 3) * 8, pos = i0 < 16 ? (cid < 128 ? cid : 0) : t, f0 = i0 & 15;
        const float* ct = WSP(float, WS_ROPE) + pos * 16 + f0; const float* st = ct + 2048;
        rcs[0] = *(const f32x4*)ct; rcs[1] = *(const f32x4*)(ct + 4); rsn[0] = *(const f32x4*)st; rsn[1] = *(const f32x4*)(st + 4);
    }
    if (c.wave < 2) { const int dirw = c.wave, tok = dirw ? 63 - c.lane : c.lane; const float* gr = WSP(float, WS_GATES) + (size_t)(base + tok) * 16;
        ga_ = gr[dirw * 4 + h]; gb_ = gr[8 + dirw * 4 + h]; gdt_ = INP(14)[l * 8 + dirw * 4 + h]; gal_ = INP(13)[l * 8 + dirw * 4 + h]; }
#pragma unroll
    for (int i = 0; i < 4; ++i) { const int idx = c.tid + 512 * i, rr = idx / 24, ch = idx % 24, part = ch >> 3, c8 = ch & 7;
        if (idx < 68 * 24) { float f[8]; unpack8(rv[i], f);
            *(f32x4*)(raw + rr * 196 + part * 64 + c8 * 8) = (f32x4){f[0], f[1], f[2], f[3]}; *(f32x4*)(raw + rr * 196 + part * 64 + c8 * 8 + 4) = (f32x4){f[4], f[5], f[6], f[7]}; } }
#pragma unroll
    for (int i = 0; i < 2; ++i) { const int ii = c.tid + 512 * i; if (ii < 5 * 192) cw[ii] = cwv[i]; }
    if (c.wave < 2) {
        const float xs = ga_ + gdt_;
        const float la = -__expf(gal_) * (xs > 20.f ? xs : __logf(1.f + __expf(xs)));
        gl[128 + c.wave * 64 + c.lane] = __builtin_amdgcn_rcpf(1.f + __expf(-gb_));
        gl[c.wave * 64 + c.lane] = wave_scan(la); }
    __syncthreads();
    {
        const int t = c.tid >> 3, sub = c.tid & 7;
        float y[3][8];
#pragma unroll
        for (int part = 0; part < 3; ++part) { const int j0 = part * 64 + sub * 8; f32x4 a0 = (f32x4){0.f, 0.f, 0.f, 0.f}, a1 = a0;
#pragma unroll
            for (int k = 0; k < 5; ++k) { a0 += *(const f32x4*)(cw + k * 192 + j0) * *(const f32x4*)(raw + (t + k) * 196 + j0); a1 += *(const f32x4*)(cw + k * 192 + j0 + 4) * *(const f32x4*)(raw + (t + k) * 196 + j0 + 4); }
#pragma unroll
            for (int e = 0; e < 4; ++e) { y[part][e] = siluf_(a0[e]); y[part][4 + e] = siluf_(a1[e]); } }
#pragma unroll
        for (int part = 0; part < 2; ++part) { float ss = 0.f;
#pragma unroll
            for (int e = 0; e < 8; ++e) ss += y[part][e] * y[part][e];
            ss = sum8(ss);
            const float r = rsqrtf(ss + EPS);
#pragma unroll
            for (int e = 0; e < 8; ++e) y[part][e] *= r; }
        if (cid < 128) {
#pragma unroll
            for (int part = 0; part < 2; ++part)
#pragma unroll
                for (int e = 0; e < 8; ++e) {
                    const float other = __shfl_xor(y[part][e], 4);
                    const float cs = rcs[e >> 2][e & 3], sn = rsn[e >> 2][e & 3];
                    y[part][e] = sub < 4 ? y[part][e] * cs - other * sn : other * sn + y[part][e] * cs;
                }
        }
#pragma unroll
        for (int e = 0; e < 8; ++e) y[0][e] *= 0.125f;
        *(u32x4*)(Qf + t * LDP + sub * 8) = pack8(y[0]); *(u32x4*)(Kf + t * LDP + sub * 8) = pack8(y[1]); *(u32x4*)(Vf + t * LDP + sub * 8) = pack8(y[2]);
    }
    __syncthreads();
    AMP_SPIN(8); }
    const int dir = c.wave >> 2, w4 = c.wave & 3;
    const float* gd = gl + dir * 64; const float* bd = gl + 128 + dir * 64;
    const int r16 = c.lane & 15, g4 = c.lane >> 4;
#define PROW(tau_) (dir ? 63 - (tau_) : (tau_))
#define PTILE(buf, tile_) ((buf) + (dir ? (63 - 16 * (tile_)) * LDP : 16 * (tile_) * LDP))
    const int PLD = dir ? -LDP : LDP;
    { AMP_T0(); {
        const int tt = w4;
        for (int st = 0; st <= tt; ++st) {
            const f32x4 a = mm16(PTILE(Kf, tt), PLD, PTILE(Kf, st), PLD, (f32x4){0.f, 0.f, 0.f, 0.f}, c.lane);
            const int s = 16 * st + r16;
#pragma unroll
            for (int e = 0; e < 4; ++e) { const int t = 16 * tt + 4 * g4 + e; Lm[dir * 4096 + t * 64 + s] = s < t ? bd[t] * a[e] * __expf(gd[t] - gd[s]) : 0.f; }
        }
    }
    __syncthreads(); AMP_SPIN(10); }
    { AMP_T0();
    {
        {
            const int tau = c.tid & 63, d0 = c.tid >> 6;
            const float ex0 = __expf(gl[63] - gl[tau]), ex1 = __expf(gl[64 + 63] - gl[64 + tau]);
#pragma unroll
            for (int q = 0; q < 8; ++q) { const int d = d0 + 8 * q;
                KdT[d * LDP + tau] = bf1(bf2f(Kf[tau * LDP + d]) * ex0);
                KdT[64 * LDP + d * LDP + tau] = bf1(bf2f(Kf[(63 - tau) * LDP + d]) * ex1); }
        }
        float* Lb = Lm + dir * 4096 + (16 * w4) * 64 + 16 * w4;
        const int j = c.lane & 15;
        float X[16];
#pragma unroll
        for (int r = 0; r < 16; ++r) {
            float a = (r == j) ? 1.f : 0.f;
#pragma unroll
            for (int s4 = 0; s4 < (r + 3) / 4; ++s4) { const f32x4 lv = *(const f32x4*)(Lb + r * 64 + 4 * s4);
#pragma unroll
                for (int e = 0; e < 4; ++e) if (4 * s4 + e < r) a -= lv[e] * X[4 * s4 + e]; }
            X[r] = a;
        }
        asm volatile("s_waitcnt lgkmcnt(0)" ::: "memory");
        if (c.lane < 16) {
#pragma unroll
            for (int r = 0; r < 16; ++r) Lb[r * 64 + j] = X[r]; }
    }
    __syncthreads();
    {
        const float* Ls = Lm + dir * 4096;
        f32x4 X[2][4];
#pragma unroll
        for (int i = 0; i < 4; ++i)
#pragma unroll
            for (int q = 0; q < 2; ++q) {
                const int ct = 2 * w4 + q, part = ct >> 2, col = 16 * (ct & 3) + r16;
                const bf16_t* Sp = part ? Vf : Kf;
                f32x4 acc;
#pragma unroll
                for (int e = 0; e < 4; ++e) { const int tau = 16 * i + 4 * g4 + e; const float x = bf2f(Sp[PROW(tau) * LDP + col]); acc[e] = part ? bd[tau] * x : bd[tau] * __expf(gd[tau]) * x; }
#pragma unroll
                for (int jb = 0; jb < 4; ++jb) if (jb < i) { const f32x4 lv = *(const f32x4*)(Ls + (16 * i + r16) * 64 + 16 * jb + 4 * g4);
#pragma unroll
                    for (int e = 0; e < 4; ++e) acc = __builtin_amdgcn_mfma_f32_16x16x4f32(-lv[e], X[q][jb][e], acc, 0, 0, 0); }
                const f32x4 ti = *(const f32x4*)(Ls + (16 * i + r16) * 64 + 16 * i + 4 * g4);
                f32x4 xi = (f32x4){0.f, 0.f, 0.f, 0.f};
#pragma unroll
                for (int e = 0; e < 4; ++e) xi = __builtin_amdgcn_mfma_f32_16x16x4f32(ti[e], acc[e], xi, 0, 0, 0);
                X[q][i] = xi;
            }
#pragma unroll
        for (int q = 0; q < 2; ++q) {
            const int ct = 2 * w4 + q, part = ct >> 2, col = 16 * (ct & 3) + r16;
            bf16_t* ldst = (part ? U0T : WT) + dir * 64 * LDP + col * LDP;
#pragma unroll
            for (int i = 0; i < 4; ++i) { const f32x4 x = X[q][i]; u32x2 w; w.x = pk2(x[0], x[1]); w.y = pk2(x[2], x[3]); *(u32x2*)(ldst + 16 * i + 4 * g4) = w; }
        }
    }
    __syncthreads(); AMP_SPIN(11); }
    const size_t idx = (size_t)(((b * 4 + h) * 2 + dir) * NCH + cid);
    {
        const int dt = w4; const float ge = __expf(gd[63]);
        bf16_t* Ag = WSP(bf16_t, WS_GA) + idx * 4096; bf16_t* Bg = WSP(bf16_t, WS_GB) + idx * 4096;
        const int d = 16 * dt + r16;
#pragma unroll
        for (int ct = 0; ct < 4; ++ct) {
            const f32x4 a = mm16(WT + dir * 64 * LDP + ct * 16 * LDP, LDP, KdT + dir * 64 * LDP + dt * 16 * LDP, LDP, (f32x4){0.f, 0.f, 0.f, 0.f}, c.lane);
            const int d1 = 16 * ct + 4 * g4; float o[4];
#pragma unroll
            for (int e = 0; e < 4; ++e) o[e] = ((d1 + e == d) ? ge : 0.f) - a[e];
            u32x2 w; w.x = pk2(o[0], o[1]); w.y = pk2(o[2], o[3]); *(u32x2*)(Ag + (((dt * 2 + (ct >> 1)) * 64 + c.lane) * 8 + 4 * (ct & 1))) = w;
        }
#pragma unroll
        for (int vt = 0; vt < 4; ++vt) {
            const f32x4 a = mm16(KdT + dir * 64 * LDP + dt * 16 * LDP, LDP, U0T + dir * 64 * LDP + vt * 16 * LDP, LDP, (f32x4){0.f, 0.f, 0.f, 0.f}, c.lane);
            u32x2 w; w.x = pk2(a[0], a[1]); w.y = pk2(a[2], a[3]); *(u32x2*)(Bg + ((vt * 2 + (dt >> 1)) * 64 + c.lane) * 8 + 4 * (dt & 1)) = w;
        }
        const int tt = w4;
#pragma unroll
        for (int st = 0; st < 4; ++st) {
            const int sg = 16 * st + r16;
            if (st <= tt) {
                const f32x4 a = mm16(PTILE(Qf, tt), PLD, PTILE(Kf, st), PLD, (f32x4){0.f, 0.f, 0.f, 0.f}, c.lane);
#pragma unroll
                for (int e = 0; e < 4; ++e) { const int t = 16 * tt + 4 * g4 + e; const float v = (sg <= t) ? a[e] * __expf(gd[t] - gd[sg]) : 0.f; QKm[dir * 64 * LDP + t * LDP + sg] = bf1(v); }
            } else {
#pragma unroll
                for (int e = 0; e < 4; ++e) QKm[dir * 64 * LDP + (16 * tt + 4 * g4 + e) * LDP + sg] = (bf16_t)0;
            }
        }
    }
    __syncthreads();
    {
        const int tt = w4;
        bf16_t* Qg_ = WSP(bf16_t, WS_GW) + idx * 4096; bf16_t* Og_ = WSP(bf16_t, WS_GU) + idx * 4096;
        const int tau = 16 * tt + r16; const float eg = __expf(gd[tau]);
#pragma unroll
        for (int dt = 0; dt < 4; ++dt) {
            const f32x4 a = mm16(WT + dir * 64 * LDP + dt * 16 * LDP, LDP, QKm + dir * 64 * LDP + tt * 16 * LDP, LDP, (f32x4){0.f, 0.f, 0.f, 0.f}, c.lane);
            const u32x2 qv = *(const u32x2*)(Qf + PROW(tau) * LDP + 16 * dt + 4 * g4);
            const float q0 = __uint_as_float(qv.x << 16), q1 = __uint_as_float(qv.x & 0xffff0000u), q2 = __uint_as_float(qv.y << 16), q3 = __uint_as_float(qv.y & 0xffff0000u);
            u32x2 w; w.x = pk2(q0 * eg - a[0], q1 * eg - a[1]); w.y = pk2(q2 * eg - a[2], q3 * eg - a[3]);
            *(u32x2*)(Qg_ + tau * 64 + 16 * dt + 4 * g4) = w;
        }
#pragma unroll
        for (int vt = 0; vt < 4; ++vt) {
            const f32x4 a = mm16(QKm + dir * 64 * LDP + tt * 16 * LDP, LDP, U0T + dir * 64 * LDP + vt * 16 * LDP, LDP, (f32x4){0.f, 0.f, 0.f, 0.f}, c.lane);
            u32x2 w; w.x = pk2(a[0], a[1]); w.y = pk2(a[2], a[3]);
            *(u32x2*)(Og_ + (16 * vt + r16) * 64 + 16 * tt + 4 * g4) = w;
        }
    }
#undef PROW
#undef PTILE
    __syncthreads();
}

__device__ __forceinline__ void hgrn_fk(float z, float lb, float& logf, float& k) {
    const float e = __expf(-fabsf(z)), inv = __builtin_amdgcn_rcpf(1.f + e);
    const float f = (z >= 0.f ? 1.f + lb * e : e + lb) * inv;
    logf = __logf(f);
    k = (1.f - lb) * (z >= 0.f ? e : 1.f) * inv;
}
constexpr int LDS_HLB = 122880;
__device__ __forceinline__ float hgrn_lb(const Ctx& c, int l, int dir, int ch) { return ((const float*)(c.lds + LDS_HLB))[dir * 256 + ch]; }
__device__ __forceinline__ void hgrn_lb_stage(const Ctx& c, int l) {
    float v = 0.f;
    if (l != 0) { const int dir = c.tid >> 8, ch = c.tid & 255; const float r0 = INP(10)[dir * 2 * 256 + ch], r1 = INP(10)[dir * 2 * 256 + 256 + ch]; v = __builtin_amdgcn_rcpf(1.f + __expf(r0 - r1)); }
    ((float*)(c.lds + LDS_HLB))[c.tid] = v;
    if (c.tid < 128) ((float*)(c.lds + LDS_HLB))[512 + c.tid] = INP(c.tid < 64 ? 16 : 17)[l * 64 + (c.tid & 63)];
    __syncthreads();
}
struct M1H { u32x4 z[2], q[2], v[2]; };
__device__ __forceinline__ void m1_hgrn_load(const Ctx& c, int b, int h, int cid, M1H& r) {
    const int base = chunk_row(b, cid), t = c.tid >> 3, sub = c.tid & 7;
#pragma unroll
    for (int dir = 0; dir < 2; ++dir) { const bf16_t* pr = WSP(bf16_t, WS_P) + (size_t)(base + (dir ? 63 - t : t)) * NP + h * 64 + sub * 8;
        r.z[dir] = *(const u32x4*)(pr + (dir ? C_HFB : C_HFF)); r.q[dir] = *(const u32x4*)(pr + C_HQ); r.v[dir] = *(const u32x4*)(pr + C_HI); }
}
__device__ __forceinline__ void m1_hgrn_item(const Ctx& c, int l, int b, int h, int cid, const M1H& rh) {
    unsigned char* L0 = c.lds;
    float* LF = (float*)L0;
    float* OUT = LF + 64 * 65;
    bf16_t* VT = (bf16_t*)(OUT + 64 * 65);
    bf16_t* KtT = VT + 64 * LDP;
    bf16_t* Qd = KtT + 64 * LDP; bf16_t* Kd = Qd + 64 * LDP; bf16_t* Ko = Kd + 64 * LDP;
    bf16_t* Qo = Ko + 64 * LDP;
    bf16_t* Am = Qo + 3 * 64 * LDP;
    const int t = c.tid >> 3, sub = c.tid & 7, r16 = c.lane & 15, g4 = c.lane >> 4;
#pragma unroll
    for (int dir = 0; dir < 2; ++dir) {
        const size_t idx = (size_t)(((b * 4 + h) * 2 + dir) * NCH + cid);
        float q[8], kk[8];
        {
            float z[8];
            unpack8(rh.z[dir], z); unpack8(rh.q[dir], q);
#pragma unroll
            for (int e = 0; e < 8; ++e) { const int d = sub * 8 + e; float lf; hgrn_fk(z[e], hgrn_lb(c, l, dir, h * 64 + d), lf, kk[e]); LF[t * 65 + d] = lf; VT[d * LDP + swz64(d, t)] = (bf16_t)((e & 1) ? (rh.v[dir][e >> 1] >> 16) : (rh.v[dir][e >> 1] & 0xffffu)); }
            *(u32x4*)(Am + t * LDP + sub * 8) = (u32x4){0u, 0u, 0u, 0u};
        }
        __syncthreads();
#pragma unroll
        for (int j = 0; j < 8; ++j) { float* col = LF + c.wave * 8 + j; const float a = wave_scan(col[c.lane * 65]); col[c.lane * 65] = a;
            if (c.lane == 63) WSP(float, WS_HA)[idx * 64 + c.wave * 8 + j] = __expf(a); }
        __syncthreads();
        {
            const int i = t >> 4;
            float fd[8], fkd[8], fko[8], fg[8], fo[3][8];
#pragma unroll
            for (int e = 0; e < 8; ++e) { const int d = sub * 8 + e; const float bt = LF[t * 65 + d];
                const float refd = i > 0 ? LF[(16 * i - 1) * 65 + d] : 0.f;
                fd[e] = q[e] * __expf(bt - refd); fkd[e] = kk[e] * __expf(refd - bt);
                fko[e] = kk[e] * __expf(LF[(16 * i + 15) * 65 + d] - bt);
                fg[e] = q[e] * __expf(bt);
                KtT[d * LDP + swz64(d, t)] = bf1(kk[e] * __expf(LF[63 * 65 + d] - bt));
            }
#pragma unroll
            for (int j = 0; j < 3; ++j) {
                if (i > j) {
#pragma unroll
                    for (int e = 0; e < 8; ++e) { const int d = sub * 8 + e; fo[j][e] = q[e] * __expf(LF[t * 65 + d] - LF[(16 * j + 15) * 65 + d]); }
                } else {
#pragma unroll
                    for (int e = 0; e < 8; ++e) fo[j][e] = 0.f;
                } }
            *(u32x4*)(Qd + t * LDP + sub * 8) = pack8(fd); *(u32x4*)(Kd + t * LDP + sub * 8) = pack8(fkd); *(u32x4*)(Ko + t * LDP + sub * 8) = pack8(fko);
            *(u32x4*)(WSP(bf16_t, WS_HQ) + idx * 4096 + t * 64 + sub * 8) = pack8(fg);
#pragma unroll
            for (int j = 0; j < 3; ++j) *(u32x4*)(Qo + j * 64 * LDP + t * LDP + sub * 8) = pack8(fo[j]);
        }
        __syncthreads();
        for (int ti = c.wave; ti < 10; ti += 8) {
            const int i = ti < 1 ? 0 : (ti < 3 ? 1 : (ti < 6 ? 2 : 3)), j = ti - (i * (i + 1)) / 2;
            f32x4 a;
            if (i == j) a = mm16(Qd + i * 16 * LDP, LDP, Kd + j * 16 * LDP, LDP, (f32x4){0.f, 0.f, 0.f, 0.f}, c.lane);
            else a = mm16(Qo + j * 64 * LDP + i * 16 * LDP, LDP, Ko + j * 16 * LDP, LDP, (f32x4){0.f, 0.f, 0.f, 0.f}, c.lane);
#pragma unroll
            for (int e = 0; e < 4; ++e) { const int tl = 4 * g4 + e; const float v = (i != j || r16 <= tl) ? a[e] : 0.f; Am[(16 * i + tl) * LDP + 16 * j + r16] = bf1(v); }
        }
        {
            const int dt = c.wave >> 1; bf16_t* Bg = WSP(bf16_t, WS_HB) + idx * 4096;
#pragma unroll
            for (int q2 = 0; q2 < 2; ++q2) { const int vt = 2 * (c.wave & 1) + q2;
                const f32x4 a = mm16s(KtT + dt * 16 * LDP, LDP, 16 * dt, VT + vt * 16 * LDP, LDP, 16 * vt, (f32x4){0.f, 0.f, 0.f, 0.f}, c.lane);
                u32x2 w; w.x = pk2(a[0], a[1]); w.y = pk2(a[2], a[3]); *(u32x2*)(Bg + (16 * vt + r16) * 64 + 16 * dt + 4 * g4) = w; }
        }
        __syncthreads();
        {
            const int tt = c.wave >> 1;
#pragma unroll
            for (int q2 = 0; q2 < 2; ++q2) { const int vt = 2 * (c.wave & 1) + q2;
                const f32x4 a = mm16s(Am + tt * 16 * LDP, LDP, -1, VT + vt * 16 * LDP, LDP, 16 * vt, (f32x4){0.f, 0.f, 0.f, 0.f}, c.lane);
#pragma unroll
                for (int e = 0; e < 4; ++e) { const int tau = 16 * tt + 4 * g4 + e; float* op = OUT + (dir ? 63 - tau : tau) * 65 + 16 * vt + r16; if (dir) *op += a[e]; else *op = a[e]; }
            }
        }
        __syncthreads();
    }
    {
        float f[8];
#pragma unroll
        for (int e = 0; e < 8; ++e) f[e] = OUT[t * 65 + sub * 8 + e];
        *(u32x4*)(WSP(bf16_t, WS_HO) + (size_t)((b * 4 + h) * NCH + cid) * 4096 + t * 64 + sub * 8) = pack8(f);
    }
    __syncthreads();
}

struct M1N { u32x4 q[4], k[4], v[4]; };
__device__ __forceinline__ void m1_na_load(const Ctx& c, int b, int hq, int cid, M1N& r) {
    const int t = c.tid >> 3, sub = c.tid & 7;
    const bf16_t* pr = WSP(bf16_t, WS_P) + (size_t)(chunk_row(b, cid) + t) * NP + hq * 256 + sub * 8;
#pragma unroll
    for (int hh = 0; hh < 4; ++hh) { r.q[hh] = *(const u32x4*)(pr + hh * 64 + C_NQ); r.k[hh] = *(const u32x4*)(pr + hh * 64 + C_NK); r.v[hh] = *(const u32x4*)(pr + hh * 64 + C_NV); }
}
__device__ __forceinline__ void m1_na_item4(const Ctx& c, int l, int b, int hq, int cid, const M1N& rn_) {
    bf16_t* VTt = (bf16_t*)c.lds;
    const int base = chunk_row(b, cid), t = c.tid >> 3, sub = c.tid & 7;
    bf16_t* pr = WSP(bf16_t, WS_P) + (size_t)(base + t) * NP + hq * 256 + sub * 8;
#pragma unroll
    for (int hh = 0; hh < 4; ++hh) {
#pragma unroll
        for (int part = 0; part < 2; ++part) {
            float f[8]; unpack8(part ? rn_.k[hh] : rn_.q[hh], f);
            float ss = 0.f;
#pragma unroll
            for (int e = 0; e < 8; ++e) ss += f[e] * f[e];
            ss = sum8(ss);
            const float r = rsqrtf(ss * (1.f / 64.f) + EPS) * (part ? 1.f : 0.125f * 1.4426950408889634f);
            const float* gw = (const float*)(c.lds + LDS_HLB) + 512 + part * 64 + sub * 8;
#pragma unroll
            for (int e = 0; e < 8; ++e) f[e] = f[e] * r * gw[e];
            *(u32x4*)(pr + hh * 64 + (part ? C_NK : C_NQ)) = pack8(f);
        }
        {
            const u32x4 v = rn_.v[hh]; bf16_t* vt = VTt + hh * 64 * LDP;
#pragma unroll
            for (int i = 0; i < 4; ++i) { vt[(sub * 8 + 2 * i) * LDP + t] = (bf16_t)(v[i] & 0xffffu); vt[(sub * 8 + 2 * i + 1) * LDP + t] = (bf16_t)(v[i] >> 16); }
        }
    }
    __syncthreads();
    {
        const int d = c.tid >> 3, s8 = c.tid & 7;
        const int tok = cid < 128 ? cid * 64 : SEQ + (cid - 128) * 64;
#pragma unroll
        for (int hh = 0; hh < 4; ++hh)
            *(u32x4*)(WSP(bf16_t, WS_VT) + ((size_t)(b * 8 + 4 * hq + hh) * 64 + d) * VT_LD + tok + s8 * 8) = *(const u32x4*)(VTt + hh * 64 * LDP + d * LDP + s8 * 8);
    }
    __syncthreads();
}

constexpr int M1_GDN = NB * 4 * NCH, M1_HGRN = NB * 4 * NCH, M1_NA = NB * NCH * 8;
#define QPULL(ctr_) ((c0.tid == 0) ? __hip_atomic_fetch_add((ctr_), 1u, __ATOMIC_RELAXED, __HIP_MEMORY_SCOPE_AGENT) : 0u)
#define QNEXT(var_, tk_) do { int* slot_ = (int*)(c0.lds + LDS_CTLOFF + 1024); if (c0.tid == 0) *slot_ = (int)(tk_); __syncthreads(); var_ = *slot_; __syncthreads(); } while (0)
#define QLOOP2(RT_, LOADF_, ITEMF_, ctr_, nh_, ncid_, ampbit_) do { \
    const int n_ = NB * (nh_) * (ncid_); int ns_ = n_ / c0.G - 1; if (ns_ < 0) ns_ = 0; const int dbase_ = ns_ * c0.G; \
    int it, itn; \
    if (ns_ >= 2) { it = c0.bid; itn = c0.bid + c0.G; } \
    else if (ns_ == 1) { it = c0.bid; const unsigned tk0_ = QPULL(ctr_); QNEXT(itn, tk0_); itn += dbase_; } \
    else { const unsigned tk0_ = (c0.tid == 0) ? __hip_atomic_fetch_add((ctr_), 2u, __ATOMIC_RELAXED, __HIP_MEMORY_SCOPE_AGENT) : 0u; QNEXT(it, tk0_); itn = it + 1; } \
    int k_ = 0; \
    RT_ r; \
    if (it < n_) { RELANE(cl_, c0); LOADF_(cl_, it / ((nh_) * (ncid_)), (it / (ncid_)) % (nh_), it % (ncid_), r); } \
    while (it < n_) { \
        const bool dyn_ = k_ + 2 >= ns_; \
        unsigned tk = 0u; if (dyn_) tk = QPULL(ctr_); \
        RELANE(c, c0); \
        RT_ rn = r; \
        if (itn < n_) LOADF_(c, itn / ((nh_) * (ncid_)), (itn / (ncid_)) % (nh_), itn % (ncid_), rn); \
        AMP_T0(); \
        ITEMF_(c, l, it / ((nh_) * (ncid_)), (it / (ncid_)) % (nh_), it % (ncid_), r); AMP_SPIN(ampbit_); \
        int it2; if (dyn_) { QNEXT(it2, tk); it2 += dbase_; } else it2 = c0.bid + (k_ + 2) * c0.G; \
        r = rn; it = itn; itn = it2; ++k_; \
    } } while (0)
#define RELANE(cn, co) Ctx cn = co; { int ln_ = (co).lane; asm volatile("" : "+v"(ln_)); cn.lane = ln_; cn.tid = (co).wave * 64 + ln_; }
__device__ __forceinline__ void phase_m1(const Ctx& c0, int l) {
    unsigned* ctr = (unsigned*)(c0.ws + WS_CTL) + CW_BQ + 16 + l * 4;
    hgrn_lb_stage(c0, l);
    {
        const int ns = M1_GDN / c0.G - 1, dbase = ns * c0.G;
        int it = c0.bid, k = 0;
        while (it < M1_GDN) {
            const bool dyn = k + 1 >= ns;
            unsigned tk = 0u; if (dyn) tk = QPULL(ctr);
            RELANE(c, c0);
            AMP_T0();
            m1_gdn_item(c, l, it / (4 * NCH), (it / NCH) % 4, it % NCH); AMP_SPIN(0);
            if (dyn) { QNEXT(it, tk); it += dbase; } else it = c0.bid + (k + 1) * c0.G;
            ++k;
        }
    }
    QLOOP2(M1H, m1_hgrn_load, m1_hgrn_item, ctr + 1, 4, NCH, 1);
    QLOOP2(M1N, m1_na_load, m1_na_item4, ctr + 2, 2, NCH, 2);
}
__device__ __forceinline__ void st_wt16(float* p, const f32x4 v) {
    __hip_atomic_store((unsigned long long*)p, ((unsigned long long)__float_as_uint(v[1]) << 32) | __float_as_uint(v[0]), __ATOMIC_RELAXED, __HIP_MEMORY_SCOPE_AGENT);
    __hip_atomic_store((unsigned long long*)p + 1, ((unsigned long long)__float_as_uint(v[3]) << 32) | __float_as_uint(v[2]), __ATOMIC_RELAXED, __HIP_MEMORY_SCOPE_AGENT);
}
__device__ __forceinline__ void wave_arrive(unsigned* ctr, int lane) {
    asm volatile("s_waitcnt vmcnt(0)" ::: "memory");
    if (lane == 0) __hip_atomic_fetch_add(ctr, 1u, __ATOMIC_RELAXED, __HIP_MEMORY_SCOPE_AGENT);
}
__device__ __forceinline__ void wave_wait_ge(unsigned* ctr, unsigned want) {
    unsigned spins = 0;
    while ((unsigned)__builtin_amdgcn_readfirstlane((int)__hip_atomic_load(ctr, __ATOMIC_RELAXED, __HIP_MEMORY_SCOPE_AGENT)) < want) { __builtin_amdgcn_s_sleep(8); if (++spins > (1u << 21)) break; }
    __builtin_amdgcn_fence(__ATOMIC_ACQUIRE, "agent");
    asm volatile("s_waitcnt vmcnt(0)" ::: "memory");
}

template <int MODE>
__device__ __forceinline__ void gdn_wtask(const Ctx& c, int chain, int seg, int cg) {
    const int dir = chain & 1, r16 = c.lane & 15, g4 = c.lane >> 4;
    const int vt = cg & 3;
    constexpr bool HASB = MODE != 0;
    constexpr int NST = MODE == 2 ? NSEG : SEGL;
    const bf16_t* Ag = MODE == 2 ? WSP(bf16_t, WS_SA) + (size_t)chain * NSEG * 4096 : WSP(bf16_t, WS_GA) + (size_t)chain * NCH * 4096;
    static_assert(MODE != 2, "the separate segment pass is gone");
    const bf16_t* Bg = WSP(bf16_t, WS_GB) + (size_t)chain * NCH * 4096;
    f32x4 S[4];
#pragma unroll
    for (int dt = 0; dt < 4; ++dt) {
        if (MODE == 0) {
#pragma unroll
            for (int e = 0; e < 4; ++e) S[dt][e] = (16 * dt + 4 * g4 + e == 16 * cg + r16) ? 1.f : 0.f;
        } else S[dt] = (f32x4){0.f, 0.f, 0.f, 0.f};
    }
    if (MODE == 3) {
        const bf16_t* Tg = WSP(bf16_t, WS_SA) + (size_t)chain * NSEG * 4096; const float* Og = WSP(float, WS_SB) + (size_t)chain * NSEG * 4096;
        bf16x8 pa[2][4][2]; f32x4 pb[2][4];
#define PRE_LOAD(set, j_) do { _Pragma("unroll") for (int dt_ = 0; dt_ < 4; ++dt_) { \
            _Pragma("unroll") for (int kk_ = 0; kk_ < 2; ++kk_) pa[set][dt_][kk_] = *(const bf16x8*)(Tg + (size_t)(j_) * 4096 + ((dt_ * 2 + kk_) * 64 + c.lane) * 8); \
            pb[set][dt_] = *(const f32x4*)(Og + (size_t)(j_) * 4096 + ((vt * 4 + dt_) * 64 + c.lane) * 4); } } while (0)
#define PRE_STEP(set, j_) do { if ((j_) + 1 < seg) PRE_LOAD((set) ^ 1, (j_) + 1); \
            u32x4 w0_, w1_; \
            w0_.x = pk2(S[0][0], S[0][1]); w0_.y = pk2(S[0][2], S[0][3]); w0_.z = pk2(S[1][0], S[1][1]); w0_.w = pk2(S[1][2], S[1][3]); \
            w1_.x = pk2(S[2][0], S[2][1]); w1_.y = pk2(S[2][2], S[2][3]); w1_.z = pk2(S[3][0], S[3][1]); w1_.w = pk2(S[3][2], S[3][3]); \
            const bf16x8 s0_ = __builtin_bit_cast(bf16x8, w0_), s1_ = __builtin_bit_cast(bf16x8, w1_); \
            _Pragma("unroll") for (int dt_ = 0; dt_ < 4; ++dt_) { f32x4 a_ = pb[set][dt_]; \
                a_ = __builtin_amdgcn_mfma_f32_16x16x32_bf16(pa[set][dt_][0], s0_, a_, 0, 0, 0); a_ = __builtin_amdgcn_mfma_f32_16x16x32_bf16(pa[set][dt_][1], s1_, a_, 0, 0, 0); S[dt_] = a_; } } while (0)
        if (seg > 0) PRE_LOAD(0, 0);
        for (int j = 0; j < seg; j += 2) { PRE_STEP(0, j); if (j + 1 < seg) PRE_STEP(1, j + 1); }
#undef PRE_LOAD
#undef PRE_STEP
    }
    bf16x8 af[4][4][2]; u32x4 bf[4][2];
#define G2_IDX(step) (MODE == 2 ? (step) : seq_cid(dir, seg * SEGL + (step)))
#define G2_LOAD(set, step) do { const int i_ = G2_IDX(step); \
        _Pragma("unroll") for (int dt_ = 0; dt_ < 4; ++dt_) { \
            _Pragma("unroll") for (int kk_ = 0; kk_ < 2; ++kk_) af[set][dt_][kk_] = *(const bf16x8*)(Ag + (size_t)i_ * 4096 + ((dt_ * 2 + kk_) * 64 + c.lane) * 8); } } while (0)
#define G2_LOADB(set, step) do { if (HASB) { const int i_ = G2_IDX(step); \
        _Pragma("unroll") for (int hf_ = 0; hf_ < 2; ++hf_) bf[set][hf_] = *(const u32x4*)(Bg + (size_t)i_ * 4096 + ((vt * 2 + hf_) * 64 + c.lane) * 8); } } while (0)
#define G2_STEP(set, bset, step) do { const int i_ = G2_IDX(step); \
        u32x4 w0_, w1_; \
        w0_.x = pk2(S[0][0], S[0][1]); w0_.y = pk2(S[0][2], S[0][3]); w0_.z = pk2(S[1][0], S[1][1]); w0_.w = pk2(S[1][2], S[1][3]); \
        w1_.x = pk2(S[2][0], S[2][1]); w1_.y = pk2(S[2][2], S[2][3]); w1_.z = pk2(S[3][0], S[3][1]); w1_.w = pk2(S[3][2], S[3][3]); \
        if (MODE == 3) { bf16_t* sp_ = WSP(bf16_t, WS_GS) + ((size_t)chain * NCH + i_) * 4096 + (vt * 128 + c.lane) * 8;     \
            *(u32x4*)(sp_) = w0_; *(u32x4*)(sp_ + 512) = w1_; } \
        if (MODE == 2) { float* sp_ = WSP(float, WS_SS) + ((size_t)chain * NSEG + i_) * 4096 + (16 * vt + r16) * 64 + 4 * g4;     \
            _Pragma("unroll") for (int dt_ = 0; dt_ < 4; ++dt_) *(f32x4*)(sp_ + 16 * dt_) = S[dt_]; } \
        if ((step) + 3 < NST) G2_LOAD(((set) + 3) & 3, (step) + 3); \
        if ((step) + 3 < NST) G2_LOADB(((bset) + 3) & 3, (step) + 3); \
        const bf16x8 s0_ = __builtin_bit_cast(bf16x8, w0_), s1_ = __builtin_bit_cast(bf16x8, w1_); \
        _Pragma("unroll") for (int dt_ = 0; dt_ < 4; ++dt_) { f32x4 a_ = (f32x4){0.f, 0.f, 0.f, 0.f}; \
            if (HASB) { const unsigned lo_ = (dt_ & 1) ? bf[bset][dt_ >> 1].z : bf[bset][dt_ >> 1].x, hi_ = (dt_ & 1) ? bf[bset][dt_ >> 1].w : bf[bset][dt_ >> 1].y; \
                a_ = (f32x4){__uint_as_float(lo_ << 16), __uint_as_float(lo_ & 0xffff0000u), __uint_as_float(hi_ << 16), __uint_as_float(hi_ & 0xffff0000u)}; } \
            a_ = __builtin_amdgcn_mfma_f32_16x16x32_bf16(af[set][dt_][0], s0_, a_, 0, 0, 0); a_ = __builtin_amdgcn_mfma_f32_16x16x32_bf16(af[set][dt_][1], s1_, a_, 0, 0, 0); S[dt_] = a_; } } while (0)
    G2_LOAD(0, 0); G2_LOAD(1, 1); G2_LOAD(2, 2); G2_LOADB(0, 0); G2_LOADB(1, 1); G2_LOADB(2, 2);
    {
#pragma unroll 1
        for (int s4 = 0; s4 < SEGL; s4 += 4) { G2_STEP(0, 0, s4); G2_STEP(1, 1, s4 + 1); G2_STEP(2, 2, s4 + 2); G2_STEP(3, 3, s4 + 3); }
        if (MODE == 0) {
            const int dq = 16 * cg + r16, pos = 32 * (dq >> 5) + 8 * ((dq >> 2) & 3) + 4 * ((dq >> 4) & 1) + (dq & 3);
            bf16_t* tp = WSP(bf16_t, WS_SA) + ((size_t)chain * NSEG + seg) * 4096;
#pragma unroll
            for (int dt = 0; dt < 4; ++dt)
#pragma unroll
                for (int e = 0; e < 4; ++e) { const int d = 16 * dt + 4 * g4 + e;
                    __hip_atomic_store(tp + ((dt * 2 + (pos >> 5)) * 64 + 16 * ((pos >> 3) & 3) + (d & 15)) * 8 + (pos & 7), (bf16_t)f2bf(S[dt][e]), __ATOMIC_RELAXED, __HIP_MEMORY_SCOPE_AGENT); }
        } else if (MODE == 1) {
            float* op = WSP(float, WS_SB) + ((size_t)chain * NSEG + seg) * 4096;
#pragma unroll
            for (int dt = 0; dt < 4; ++dt) st_wt16(op + ((vt * 4 + dt) * 64 + c.lane) * 4, S[dt]);
        }
    }
#undef G2_IDX
#undef G2_LOAD
#undef G2_LOADB
#undef G2_STEP
}
__device__ __forceinline__ void m2_hgrn_wscan(const Ctx& c, int wt) {
    const int k = wt * 64 + c.lane, chain = k >> 11, e2 = (k & 2047) * 2, d = e2 & 63, dir = chain & 1;
    unsigned* Bg = (unsigned*)(WSP(bf16_t, WS_HB) + (size_t)chain * NCH * 4096 + e2);
    const float* Ag = WSP(float, WS_HA) + (size_t)chain * NCH * 64 + d;
    float S0 = 0.f, S1 = 0.f;
    for (int s0 = 0; s0 < NCH; s0 += 33) {
        unsigned bw[33]; f32x2 av[33];
#pragma unroll
        for (int j = 0; j < 33; ++j) { const int cid = seq_cid(dir, s0 + j); bw[j] = Bg[(size_t)cid * 2048]; av[j] = *(const f32x2*)(Ag + cid * 64); }
#pragma unroll
        for (int j = 0; j < 33; ++j) { const int cid = seq_cid(dir, s0 + j); Bg[(size_t)cid * 2048] = pk2(S0, S1);
            S0 = av[j].x * S0 + __uint_as_float(bw[j] << 16); S1 = av[j].y * S1 + __uint_as_float(bw[j] & 0xffff0000u); }
    }
}

struct NaState { float m, l; f32x4 o[4]; };
__device__ __forceinline__ void na2_update(NaState& st, const f32x4 s0, const f32x4 s1, bf16x8& pf) {
    float cm = fmaxf(fmaxf(fmaxf(s0[0], s0[1]), fmaxf(s0[2], s0[3])), fmaxf(fmaxf(s1[0], s1[1]), fmaxf(s1[2], s1[3])));
    cm = xmax32(xmax16(cm));
    const float mn = fmaxf(st.m, cm), sc = __builtin_amdgcn_exp2f(st.m - mn); st.m = mn;
    float p[8];
#pragma unroll
    for (int e = 0; e < 4; ++e) { p[e] = __builtin_amdgcn_exp2f(s0[e] - mn); p[4 + e] = __builtin_amdgcn_exp2f(s1[e] - mn); }
    st.l = st.l * sc + ((p[0] + p[1]) + (p[2] + p[3])) + ((p[4] + p[5]) + (p[6] + p[7]));
#pragma unroll
    for (int dt = 0; dt < 4; ++dt) st.o[dt] = st.o[dt] * sc;
    const u32x4 pw = pack8(p); pf = __builtin_bit_cast(bf16x8, pw);
}
constexpr int NA_SLOT = 2 * 64 * LDP * 2;
template <bool MASKED, bool FENCE>
__device__ __forceinline__ void na3_chunk(NaState& st, const bf16x8 (&qf)[2], const bf16_t* Ks, const bf16_t* Vs, int tok, int kperm, int q16, int g4, bool rowok, unsigned cmask, int bcol, const float* brow) {
    f32x4 a[2];
#pragma unroll
    for (int tile = 0; tile < 2; ++tile) {
        const bf16_t* kp = Ks + (tok + kperm + 4 * tile) * LDP + g4 * 8;
        const bf16x8 k0 = *(const bf16x8*)kp, k1 = *(const bf16x8*)(kp + 32);
        const f32x4 x = __builtin_amdgcn_mfma_f32_16x16x32_bf16(k0, qf[0], (f32x4){0.f, 0.f, 0.f, 0.f}, 0, 0, 0);
        a[tile] = __builtin_amdgcn_mfma_f32_16x16x32_bf16(k1, qf[1], x, 0, 0, 0);
    }
    if (MASKED) {
        const int jq = (int)cmask, c0 = min(max(jq - 8, 0), 48), kc0 = tok + 8 * g4;
        const float* bq = brow + (kc0 - jq + 15);
#pragma unroll
        for (int tile = 0; tile < 2; ++tile)
#pragma unroll
            for (int e = 0; e < 4; ++e) { const int kc = kc0 + 4 * tile + e; const bool ok = (unsigned)(kc - c0) < 16u; const float bv = bq[4 * tile + e]; a[tile][e] = ok ? a[tile][e] + bv : -1.0e30f; }
    }
    bf16x8 vf[4];
#pragma unroll
    for (int dt = 0; dt < 4; ++dt) vf[dt] = *(const bf16x8*)(Vs + (16 * dt + q16) * LDP + tok + 8 * g4);
    bf16x8 pf; na2_update(st, a[0], a[1], pf);
#pragma unroll
    for (int dt = 0; dt < 4; ++dt) st.o[dt] = __builtin_amdgcn_mfma_f32_16x16x32_bf16(vf[dt], pf, st.o[dt], 0, 0, 0);
    if (FENCE) asm volatile("" ::: "memory");
}
__device__ __forceinline__ void na3_store(const Ctx& c, const NaState& st, int qrow, int h, int g4) {
    const float l = xadd32(xadd16(st.l));
    const float inv = __builtin_amdgcn_rcpf(l);
    bf16_t* yr = WSP(bf16_t, WS_H) + (size_t)qrow * D + 512 + h * 64 + 4 * g4;
#pragma unroll
    for (int dt = 0; dt < 4; ++dt) { const f32x4 o = st.o[dt]; u32x2 w; w.x = pk2(o[0] * inv, o[1] * inv); w.y = pk2(o[2] * inv, o[3] * inv); *(u32x2*)(yr + 16 * dt) = w; }
}
__device__ __forceinline__ void na3_block(const Ctx& c, int l) {
    const int bh = c.bid >> 4, b = bh >> 3, h = bh & 7, rg = c.bid & 15;
    unsigned char* ring = c.lds; float* rpbh = (float*)(c.lds + 3 * NA_SLOT);
    const int q16 = c.lane & 15, g4 = c.lane >> 4;
    const int rq = 8 * rg + c.wave, r0q = min(max(rq - 4, 0), 120);
    const int klo = min(max(8 * rg - 4, 0), 120), khi = min(max(8 * rg + 3, 0), 120) + 7, nsteps = 4 + (khi - klo + 1);
    const bf16_t* P = WSP(bf16_t, WS_P);
    const bf16_t* VT = WSP(bf16_t, WS_VT) + (size_t)(b * 8 + h) * 64 * VT_LD;
    for (int i = c.tid; i < 465; i += 512) rpbh[i] = INP(18)[(size_t)(l * 8 + h) * 465 + i] * 1.4426950408889634f;
    const int sj = c.tid >> 3, sc8 = c.tid & 7;
    u32x4 kreg, vreg;
#define NA3_LOAD(s_) do { const int s__ = (s_); const bool cx_ = s__ < 4; const int kr_ = klo + s__ - 4; \
        const size_t prow_ = cx_ ? (size_t)(NLAT + b * CTXL + 64 * s__ + sj) : (size_t)(b * SEQ + kr_ * 64 + sj); const int tk_ = cx_ ? SEQ + 64 * s__ : kr_ * 64; \
        kreg = *(const u32x4*)(P + prow_ * NP + C_NK + h * 64 + sc8 * 8); vreg = *(const u32x4*)(VT + (size_t)sj * VT_LD + tk_ + sc8 * 8); } while (0)
#define NA3_STORE(s_) do { unsigned char* sl_ = ring + ((s_) % 3) * NA_SLOT; *(u32x4*)(sl_ + (sj * LDP + sc8 * 8) * 2) = kreg; *(u32x4*)(sl_ + 64 * LDP * 2 + (sj * LDP + sc8 * 8) * 2) = vreg; } while (0)
    NA3_LOAD(0); NA3_STORE(0); NA3_LOAD(1);
    bf16x8 qf[4][2]; NaState st[4];
    const int kperm = 8 * (q16 >> 2) + (q16 & 3);
#pragma unroll
    for (int m = 0; m < 4; ++m) {
        const size_t qrow = (size_t)(b * SEQ + rq * 64 + 16 * m + q16);
#pragma unroll
        for (int kk = 0; kk < 2; ++kk) qf[m][kk] = *(const bf16x8*)(P + qrow * NP + C_NQ + h * 64 + kk * 32 + g4 * 8);
        st[m].m = -1.0e30f; st[m].l = 0.f;
#pragma unroll
        for (int dt = 0; dt < 4; ++dt) st[m].o[dt] = (f32x4){0.f, 0.f, 0.f, 0.f};
    }
    __syncthreads();
    for (int s = 0; s < nsteps; ++s) {
        if (s + 1 < nsteps) NA3_STORE(s + 1);
        if (s + 2 < nsteps) NA3_LOAD(s + 2);
        const bf16_t* Ks = (const bf16_t*)(ring + (s % 3) * NA_SLOT); const bf16_t* Vs = Ks + 64 * LDP;
        if (s < 4) {
#pragma unroll
            for (int m = 0; m < 4; ++m) { na3_chunk<false, false>(st[m], qf[m], Ks, Vs, 0, kperm, q16, g4, true, 0u, 0, rpbh); na3_chunk<false, true>(st[m], qf[m], Ks, Vs, 32, kperm, q16, g4, true, 0u, 0, rpbh); }
        } else {
            const int kr = klo + s - 4;
            if (kr >= r0q && kr < r0q + 8) {
                const float* brow = rpbh + (kr - rq + 7) * 31;
#pragma unroll
                for (int m = 0; m < 4; ++m) { if (m & 1) na3_chunk<true, true>(st[m], qf[m], Ks, Vs, m == 1 ? 8 : 32, kperm, q16, g4, true, (unsigned)(16 * m + q16), 0, brow); else na3_chunk<true, false>(st[m], qf[m], Ks, Vs, m == 0 ? 0 : 24, kperm, q16, g4, true, (unsigned)(16 * m + q16), 0, brow); }
            }
        }
        __syncthreads();
    }
#undef NA3_LOAD
#undef NA3_STORE
#pragma unroll
    for (int m = 0; m < 4; ++m) na3_store(c, st[m], b * SEQ + rq * 64 + 16 * m + q16, h, g4);
}
__device__ __forceinline__ void na_ctx_item(const Ctx& c, int b, int h, int m2) {
    int lane = c.lane; asm volatile("" : "+v"(lane));
    const int q16 = lane & 15, g4 = lane >> 4, kperm = 8 * (q16 >> 2) + (q16 & 3);
    const bf16_t* P = WSP(bf16_t, WS_P);
    const bf16_t* VT = WSP(bf16_t, WS_VT) + (size_t)(b * 8 + h) * 64 * VT_LD + SEQ;
    bf16x8 qf[2][2]; NaState st[2];
#pragma unroll
    for (int t = 0; t < 2; ++t) { const size_t qrow = (size_t)(NLAT + b * CTXL + (2 * m2 + t) * 16 + q16);
#pragma unroll
        for (int kk = 0; kk < 2; ++kk) qf[t][kk] = *(const bf16x8*)(P + qrow * NP + C_NQ + h * 64 + kk * 32 + g4 * 8);
        st[t].m = -1.0e30f; st[t].l = 0.f;
#pragma unroll
        for (int dt = 0; dt < 4; ++dt) st[t].o[dt] = (f32x4){0.f, 0.f, 0.f, 0.f}; }
    bf16x8 kA[2][2], vA[4], kB[2][2], vB[4];
#define NCX_LOAD(kf_, vf_, sp_) do { const int tok_ = 32 * (sp_); \
        _Pragma("unroll") for (int tile = 0; tile < 2; ++tile) { const bf16_t* kp = P + (size_t)(NLAT + b * CTXL + tok_ + kperm + 4 * tile) * NP + C_NK + h * 64 + g4 * 8; kf_[tile][0] = *(const bf16x8*)kp; kf_[tile][1] = *(const bf16x8*)(kp + 32); } \
        _Pragma("unroll") for (int dt = 0; dt < 4; ++dt) vf_[dt] = *(const bf16x8*)(VT + (size_t)(16 * dt + q16) * VT_LD + tok_ + 8 * g4); } while (0)
#define NCX_STEP(kf_, vf_) do { f32x4 a[2][2]; \
        _Pragma("unroll") for (int tile = 0; tile < 2; ++tile) \
            _Pragma("unroll") for (int t = 0; t < 2; ++t) { const f32x4 x = __builtin_amdgcn_mfma_f32_16x16x32_bf16(kf_[tile][0], qf[t][0], (f32x4){0.f, 0.f, 0.f, 0.f}, 0, 0, 0); a[t][tile] = __builtin_amdgcn_mfma_f32_16x16x32_bf16(kf_[tile][1], qf[t][1], x, 0, 0, 0); } \
        _Pragma("unroll") for (int t = 0; t < 2; ++t) { bf16x8 pf; na2_update(st[t], a[t][0], a[t][1], pf); \
            _Pragma("unroll") for (int dt = 0; dt < 4; ++dt) st[t].o[dt] = __builtin_amdgcn_mfma_f32_16x16x32_bf16(vf_[dt], pf, st[t].o[dt], 0, 0, 0); } } while (0)
    NCX_LOAD(kA, vA, 0);
#pragma unroll 1
    for (int sp = 0; sp < 8; sp += 2) {
        NCX_LOAD(kB, vB, sp + 1);
        NCX_STEP(kA, vA);
        if (sp + 2 < 8) NCX_LOAD(kA, vA, sp + 2);
        NCX_STEP(kB, vB);
    }
#undef NCX_LOAD
#undef NCX_STEP
#pragma unroll
    for (int t = 0; t < 2; ++t) na3_store(c, st[t], NLAT + b * CTXL + (2 * m2 + t) * 16 + q16, h, g4);
}

__device__ __forceinline__ void phase_m2(const Ctx& c0, int l) {
    unsigned* cnt1 = (unsigned*)(c0.ws + WS_CTL) + CW_TQ + l * 64;
    const int cs = c0.bid, chain = cs / NSEG, seg = cs % NSEG;
    { RELANE(c, c0); AMP_T0();
      if (cs < 16 * NSEG) { if (c.wave < 4) gdn_wtask<0>(c, chain, seg, c.wave); else gdn_wtask<1>(c, chain, seg, c.wave);
          wave_arrive(cnt1 + chain, c.lane); AMP_SPIN(5); }
      else { const int t = (cs - 16 * NSEG) * 8 + c.wave; if (t < 512) { m2_hgrn_wscan(c, t); AMP_SPIN(6); } } }
    __syncthreads();
    { RELANE(c, c0); AMP_T0(); na3_block(c, l); AMP_SPIN(7); }
    { RELANE(c, c0); AMP_T0();
        if (cs < 16 * NSEG) { if (c.wave < 4) { wave_wait_ge(cnt1 + chain, (unsigned)(NSEG * 8)); gdn_wtask<3>(c, chain, seg, c.wave); AMP_SPIN(13); } }
        else if (l == 0) { const int j = (cs - 16 * NSEG) * 8 + c.wave; if (j < 128) na_ctx_item(c, j >> 6, (j >> 3) & 7, j & 7); } }
}
__device__ __forceinline__ void gated_norm_store(const Ctx& c, const float* OUT, const float* gw, int base, const u32x4 gtv, int ycol) {
    const int t = c.tid >> 3, sub = c.tid & 7;
    float o[8], gt[8]; float ss = 0.f;
#pragma unroll
    for (int e = 0; e < 8; ++e) { o[e] = OUT[t * 65 + sub * 8 + e]; ss += o[e] * o[e]; }
    ss = sum8(ss);
    const float r = rsqrtf(ss * (1.f / 64.f) + EPS);
    unpack8(gtv, gt);
#pragma unroll
    for (int e = 0; e < 8; ++e) o[e] = o[e] * r * gw[sub * 8 + e] * siluf_(gt[e]);
    *(u32x4*)(WSP(bf16_t, WS_H) + (size_t)(base + t) * D + ycol + sub * 8) = pack8(o);
}

struct M3G { u32x4 q[2], o[2], s[2], gt; };
__device__ __forceinline__ void m3_gdn_load(const Ctx& c, int b, int h, int cid, M3G& r) {
    const int t = c.tid >> 3, sub = c.tid & 7;
#pragma unroll
    for (int dir = 0; dir < 2; ++dir) { const size_t idx = (size_t)(((b * 4 + h) * 2 + dir) * NCH + cid);
        r.q[dir] = *(const u32x4*)(WSP(bf16_t, WS_GW) + idx * 4096 + t * 64 + sub * 8);
        r.o[dir] = *(const u32x4*)(WSP(bf16_t, WS_GU) + idx * 4096 + t * 64 + sub * 8);
        r.s[dir] = *(const u32x4*)(WSP(bf16_t, WS_GS) + idx * 4096 + c.tid * 8); }
    r.gt = *(const u32x4*)(WSP(bf16_t, WS_P) + (size_t)(chunk_row(b, cid) + t) * NP + C_GG + h * 64 + sub * 8);
}
__device__ __forceinline__ void m3_gdn_item(const Ctx& c, int l, int b, int h, int cid, const M3G& rg) {
    unsigned char* L0 = c.lds;
    bf16_t* Ql = (bf16_t*)L0;
    bf16_t* Ol = Ql + 2 * 64 * LDP;
    bf16_t* Sl = Ol + 2 * 64 * LDP;
    float* OUT = (float*)(Sl + 2 * 64 * LDP);
    const int base = chunk_row(b, cid);
    {
        const int t = c.tid >> 3, sub = c.tid & 7;
#pragma unroll
        for (int dir = 0; dir < 2; ++dir) {
            *(u32x4*)(Ql + dir * 64 * LDP + t * LDP + sub * 8) = rg.q[dir];
            *(u32x4*)(Ol + dir * 64 * LDP + t * LDP + sub * 8) = rg.o[dir];
            {
                const u32x4 sv = rg.s[dir];
                const int vt_ = c.tid >> 7, hf_ = (c.tid >> 6) & 1, r16_ = c.tid & 15, g4_ = (c.tid >> 4) & 3;
                bf16_t* srow = Sl + dir * 64 * LDP + (16 * vt_ + r16_) * LDP + 32 * hf_ + 4 * g4_;
                *(u32x2*)srow = (u32x2){sv.x, sv.y}; *(u32x2*)(srow + 16) = (u32x2){sv.z, sv.w}; } }
    }
    __syncthreads();
    const int dir = c.wave >> 2, tt = c.wave & 3, r16 = c.lane & 15, g4 = c.lane >> 4;
    f32x4 o[4];
#pragma unroll
    for (int vt = 0; vt < 4; ++vt) {
        const u32x2 ov = *(const u32x2*)(Ol + dir * 64 * LDP + (16 * vt + r16) * LDP + 16 * tt + 4 * g4);
        f32x4 a = (f32x4){__uint_as_float(ov.x << 16), __uint_as_float(ov.x & 0xffff0000u), __uint_as_float(ov.y << 16), __uint_as_float(ov.y & 0xffff0000u)};
        o[vt] = mm16(Ql + dir * 64 * LDP + tt * 16 * LDP, LDP, Sl + dir * 64 * LDP + vt * 16 * LDP, LDP, a, c.lane);
    }
    if (dir == 0) {
#pragma unroll
        for (int vt = 0; vt < 4; ++vt)
#pragma unroll
            for (int e = 0; e < 4; ++e) OUT[(16 * tt + 4 * g4 + e) * 65 + 16 * vt + r16] = o[vt][e];
    }
    __syncthreads();
    if (dir == 1) {
#pragma unroll
        for (int vt = 0; vt < 4; ++vt)
#pragma unroll
            for (int e = 0; e < 4; ++e) OUT[(63 - (16 * tt + 4 * g4 + e)) * 65 + 16 * vt + r16] += o[vt][e];
    }
    __syncthreads();
    gated_norm_store(c, OUT, (const float*)(c.lds + LDS_HLB) + 64, base, rg.gt, 256 + h * 64);
    __syncthreads();
}

struct M3H { u32x4 o; u32x4 q[2], s[2]; u32x4 gt; };
__device__ __forceinline__ void m3_hgrn_load(const Ctx& c, int b, int h, int cid, M3H& r) {
    const int t = c.tid >> 3, sub = c.tid & 7;
    r.o = *(const u32x4*)(WSP(bf16_t, WS_HO) + (size_t)((b * 4 + h) * NCH + cid) * 4096 + t * 64 + sub * 8);
#pragma unroll
    for (int dir = 0; dir < 2; ++dir) { const size_t idx = (size_t)(((b * 4 + h) * 2 + dir) * NCH + cid);
        r.q[dir] = *(const u32x4*)(WSP(bf16_t, WS_HQ) + idx * 4096 + t * 64 + sub * 8);
        r.s[dir] = *(const u32x4*)(WSP(bf16_t, WS_HB) + idx * 4096 + t * 64 + sub * 8); }
    r.gt = *(const u32x4*)(WSP(bf16_t, WS_P) + (size_t)(chunk_row(b, cid) + t) * NP + C_HG + h * 64 + sub * 8);
}
__device__ __forceinline__ void m3_hgrn_item(const Ctx& c, int l, int b, int h, int cid, const M3H& rh) {
    unsigned char* L0 = c.lds;
    float* OUT = (float*)L0;
    bf16_t* Ql = (bf16_t*)(OUT + 64 * 65);
    bf16_t* Sl = Ql + 2 * 64 * LDP;
    const int base = chunk_row(b, cid);
    const int t = c.tid >> 3, sub = c.tid & 7, r16 = c.lane & 15, g4 = c.lane >> 4;
    {
        float of[8]; unpack8(rh.o, of);
#pragma unroll
        for (int e = 0; e < 8; ++e) OUT[t * 65 + sub * 8 + e] = of[e];
#pragma unroll
        for (int dir = 0; dir < 2; ++dir) {
            *(u32x4*)(Ql + dir * 64 * LDP + t * LDP + sub * 8) = rh.q[dir];
            *(u32x4*)(Sl + dir * 64 * LDP + t * LDP + sub * 8) = rh.s[dir]; }
    }
    __syncthreads();
    const int dir = c.wave >> 2, tt = c.wave & 3;
    f32x4 o[4];
#pragma unroll
    for (int vt = 0; vt < 4; ++vt) o[vt] = mm16(Ql + dir * 64 * LDP + tt * 16 * LDP, LDP, Sl + dir * 64 * LDP + vt * 16 * LDP, LDP, (f32x4){0.f, 0.f, 0.f, 0.f}, c.lane);
    if (dir == 0) {
#pragma unroll
        for (int vt = 0; vt < 4; ++vt)
#pragma unroll
            for (int e = 0; e < 4; ++e) OUT[(16 * tt + 4 * g4 + e) * 65 + 16 * vt + r16] += o[vt][e];
    }
    __syncthreads();
    if (dir == 1) {
#pragma unroll
        for (int vt = 0; vt < 4; ++vt)
#pragma unroll
            for (int e = 0; e < 4; ++e) OUT[(63 - (16 * tt + 4 * g4 + e)) * 65 + 16 * vt + r16] += o[vt][e];
    }
    __syncthreads();
    gated_norm_store(c, OUT, (const float*)(c.lds + LDS_HLB), base, rh.gt, h * 64);
    __syncthreads();
}

__device__ __forceinline__ void phase_m3(const Ctx& c0, int l) {
    const int ncid = l == 0 ? NCH : 128;
    { const Ctx& c = c0; if (c.tid < 128) ((float*)(c.lds + LDS_HLB))[c.tid] = INP(c.tid < 64 ? 11 : 15)[l * 64 + (c.tid & 63)]; __syncthreads(); }
    unsigned* ctrh = (unsigned*)(c0.ws + WS_CTL) + CW_BQ + l * 2 + 1;
    unsigned* ctrg = (unsigned*)(c0.ws + WS_CTL) + CW_BQ + 8 + l;
    QLOOP2(M3H, m3_hgrn_load, m3_hgrn_item, ctrh, 4, ncid, 4);
    QLOOP2(M3G, m3_gdn_load, m3_gdn_item, ctrg, 4, ncid, 3);
}
__device__ __forceinline__ void phase_moe_assign(const Ctx& c) {
    if (c.tid == 0) { unsigned* rt = WSP(unsigned, WS_CTL) + CW_RT; unsigned sp = 0;
        while (__hip_atomic_load(rt, __ATOMIC_RELAXED, __HIP_MEMORY_SCOPE_AGENT) < (unsigned)c.G) { __builtin_amdgcn_s_sleep(2); if (++sp > (1u << 22)) break; } }
    __syncthreads();
    __builtin_amdgcn_fence(__ATOMIC_ACQUIRE, "agent");
    int* sh = (int*)c.lds;
    if (c.tid == 0) { int acc = 0; for (int e = 0; e < NEXP; ++e) { const int cnt = (int)__hip_atomic_load(WSP(unsigned, WS_CTL) + CW_CNT + e, __ATOMIC_RELAXED, __HIP_MEMORY_SCOPE_AGENT); sh[e] = acc; acc += (cnt + 255) / 256 * 256; sh[8 + e] = acc; } }
    __syncthreads();
    if (c.bid == 0 && c.tid <= NSLOT_TILES) {
        if (c.tid == NSLOT_TILES) WSP(int, WS_TILEE)[NSLOT_TILES] = sh[15] / 256;
        else { int e = 0; while (e < NEXP - 1 && sh[8 + e] <= c.tid * 256) ++e; WSP(int, WS_TILEE)[c.tid] = e; }
    }
    if (c.bid == 1) {
        const int nt = sh[15] / 256, nleft = nt * 4 - MOE2_MAIN;
        for (int i = c.tid; i < NSLOT_TILES * 4; i += 512) WSP(int, WS_TILEP)[i] = -1;
        __syncthreads();
        if (c.tid < nleft) { pg8::Unit u; pg8::tile_of(nt, 4, MOE2_MAIN + c.tid, u); WSP(int, WS_TILEP)[u.pm * 4 + u.pn] = c.tid; }
    }
    if (c.wave == 0) {
        for (int ch = c.bid; ch < NLAT / 64; ch += c.G) {
            const int tok = ch * 64 + c.lane;
            const int e0 = WSP(int, WS_TOKE)[tok * 2], e1 = WSP(int, WS_TOKE)[tok * 2 + 1];
            unsigned mycnt = 0u; int rank0 = 0, rank1 = 0;
#pragma unroll
            for (int k = 0; k < 2; ++k)
#pragma unroll
                for (int ee = 0; ee < NEXP; ++ee) { const int e = k ? e1 : e0; const unsigned long long m = __ballot(e == ee);
                    if (c.lane == k * 8 + ee) mycnt = (unsigned)__popcll(m);
                    if (e == ee) { const int rk = __popcll(m & ((1ull << c.lane) - 1ull)); if (k) rank1 = rk; else rank0 = rk; } }
            unsigned base = 0u;
            if (c.lane < 16) base = atomicAdd(WSP(unsigned, WS_CTL) + CW_CUR + (c.lane & 7), mycnt);
            const int s0 = sh[e0] + (int)__shfl(base, e0) + rank0, s1 = sh[e1] + (int)__shfl(base, 8 + e1) + rank1;
            WSP(int, WS_TOKS)[tok * 2] = s0; WSP(int, WS_TOKS)[tok * 2 + 1] = s1;
            WSP(int, WS_SLOTTOK)[s0] = tok; WSP(int, WS_SLOTTOK)[s1] = tok;
        }
    }
    __syncthreads();
}
struct CmbRow { u32x4 ya[2], yb[2], xv[2]; };
__device__ __forceinline__ void phase_moe_combine(const Ctx& c) {
    const float* mod = WSP(float, WS_MOD) + (size_t)1 * 3 * 6144 + 5120;
    const bf16_t* YP = WSP(bf16_t, WS_YP);
    int* tilep = (int*)c.lds;
    for (int i = c.tid; i < NSLOT_TILES * 4; i += 512) tilep[i] = WSP(int, WS_TILEP)[i];
    const int stride = c.G * 8, row0 = c.bid * 8 + c.wave;
    int msa = 0, msb = 0; float mga = 0.f, mgb = 0.f;
    { const int rk = row0 + (c.lane & 7) * stride; if (rk < NLAT) { msa = WSP(int, WS_TOKS)[rk * 2]; msb = WSP(int, WS_TOKS)[rk * 2 + 1]; mga = WSP(float, WS_TOKG)[rk * 2]; mgb = WSP(float, WS_TOKG)[rk * 2 + 1]; } }
    f32x4 gm[2][2][2];
#pragma unroll
    for (int s = 0; s < 2; ++s)
#pragma unroll
        for (int j = 0; j < 2; ++j) { const int col = 8 * c.lane + 512 * j; gm[s][j][0] = *(const f32x4*)(mod + s * 6144 + col); gm[s][j][1] = *(const f32x4*)(mod + s * 6144 + col + 4); }
    __syncthreads();
#define CMB_LOAD(dst_, k_) do { const int rw_ = row0 + (k_) * stride; const int sa_ = __shfl(msa, (k_)), sb_ = __shfl(msb, (k_)); \
        _Pragma("unroll") for (int j = 0; j < 2; ++j) { const int col = 8 * c.lane + 512 * j; \
            dst_.ya[j] = *(const u32x4*)(YP + (size_t)sa_ * D + col); dst_.yb[j] = *(const u32x4*)(YP + (size_t)sb_ * D + col); \
            dst_.xv[j] = *(const u32x4*)(WSP(bf16_t, WS_XB) + (size_t)rw_ * D + col); } } while (0)
    CmbRow cur, nxt;
    if (row0 < NLAT) CMB_LOAD(cur, 0);
    nxt = cur;
#pragma unroll 1
    for (int k = 0; k < 8; ++k) {
        const int row = row0 + k * stride; if (row >= NLAT) break;
        if (k + 1 < 8 && row + stride < NLAT) CMB_LOAD(nxt, k + 1);
        const int s = row < SEQ ? 0 : 1;
        const int sa = __shfl(msa, k), sb = __shfl(msb, k); const float ga = __shfl(mga, k), gb = __shfl(mgb, k);
        float* xr = c.p->out + (size_t)row * D;
#pragma unroll
        for (int j = 0; j < 2; ++j) { const int col = 8 * c.lane + 512 * j, pn = col >> 8;
            float ya[8], yb[8];
#pragma unroll
            for (int q = 0; q < 2; ++q) { const int sl = q ? sb : sa; float (&y)[8] = q ? yb : ya;
                const int uid = tilep[(sl >> 8) * 4 + pn];
                if (uid < 0) unpack8(q ? cur.yb[j] : cur.ya[j], y);
                else { const bf16_t* pp = WSP(bf16_t, WS_PART2) + (size_t)uid * MOE2_SPLIT * 65536 + (size_t)(sl & 255) * 256 + (col & 255);
                    u32x4 pw[MOE2_SPLIT];
#pragma unroll
                    for (int ks = 0; ks < MOE2_SPLIT; ++ks) pw[ks] = *(const u32x4*)(pp + (size_t)ks * 65536);
#pragma unroll
                    for (int e = 0; e < 8; ++e) y[e] = 0.f;
#pragma unroll
                    for (int ks = 0; ks < MOE2_SPLIT; ++ks) { float t8[8]; unpack8(pw[ks], t8);
#pragma unroll
                        for (int e = 0; e < 8; ++e) y[e] += t8[e]; } } }
            float xv[8]; unpack8(cur.xv[j], xv);
            f32x4 x0 = (f32x4){xv[0], xv[1], xv[2], xv[3]}, x1 = (f32x4){xv[4], xv[5], xv[6], xv[7]};
            const f32x4 g0 = s ? gm[1][j][0] : gm[0][j][0], g1 = s ? gm[1][j][1] : gm[0][j][1];
#pragma unroll
            for (int e = 0; e < 4; ++e) { x0[e] += g0[e] * (ga * ya[e] + gb * yb[e]); x1[e] += g1[e] * (ga * ya[4 + e] + gb * yb[4 + e]); }
            *(f32x4*)(xr + col) = x0; *(f32x4*)(xr + col + 4) = x1; }
        cur = nxt;
    }
#undef CMB_LOAD
}

constexpr int FFN1_WGM = 4;
constexpr int MOE1_WGM = 4;
constexpr int G_INPROJ = 248, G_FFN1 = 232;
__device__ __forceinline__ void phase_inproj(const Ctx& c, int l) {
    pg8::Gemm g{WSP(bf16_t, WS_H), WSP(bf16_t, WS_WIN) + (size_t)l * NP * D, D, MTOK / 256, NP / 256, nullptr, 0, nullptr, 0, 0, 1, D, 1 << 30, -1, G_INPROJ};
    pg8::EpiBf16 E{WSP(bf16_t, WS_P), NP, 0};
    pg8::gemm_phase((LAS unsigned char*)c.lds, g, E, c.tid, c.wave);
    early_cvt(c, l, G_INPROJ, (MTOK / 256) * (NP / 256));
}
__device__ __forceinline__ void phase_outproj(const Ctx& c, int l) {
    pg8::Gemm g{WSP(bf16_t, WS_H), WSP(bf16_t, WS_WOUT) + (size_t)l * D * D, D, NLAT / 256, D / 256, nullptr, 0, nullptr, 0, 0, 1, D, 1 << 30, -1};
    if (l == 0) { pg8::EpiResid<true> E{INP(0), WSP(bf16_t, WS_XB), WSP(float, WS_MOD) + 2048}; pg8::gemm_phase((LAS unsigned char*)c.lds, g, E, c.tid, c.wave); }
    else { pg8::EpiResid<false> E{nullptr, WSP(bf16_t, WS_XB), WSP(float, WS_MOD) + (size_t)3 * 6144 + 2048}; pg8::gemm_phase((LAS unsigned char*)c.lds, g, E, c.tid, c.wave); }
    if (l == 0) {
        pg8::Gemm gc{WSP(bf16_t, WS_H), WSP(bf16_t, WS_WOUT), D, 2, D / 256, nullptr, NLAT, nullptr, 0, 0, CTX_SPLIT_O, D / CTX_SPLIT_O, 1 << 30, -1};
        pg8::EpiPartial Ec{WSP(float, WS_PARTO), D, NCTX};
        pg8::gemm_phase((LAS unsigned char*)c.lds, gc, Ec, c.tid, c.wave);
    }
}
__device__ __forceinline__ void phase_ffn1(const Ctx& c) {
    pg8::Gemm g{WSP(bf16_t, WS_H), WSP(bf16_t, WS_W13), D, MTOK / 256, 7168 / 256, nullptr, 0, nullptr, 0, 0, 1, D, 1 << 30, -1, G_FFN1, nullptr, 0, FFN1_WGM};
    pg8::EpiSwiGLU E{WSP(bf16_t, WS_P), DFF};
    pg8::gemm_phase((LAS unsigned char*)c.lds, g, E, c.tid, c.wave);
    early_cvt(c, 2, G_FFN1, (MTOK / 256) * (7168 / 256));
}
__device__ __forceinline__ void phase_ffn2(const Ctx& c) {
    pg8::Gemm g{WSP(bf16_t, WS_P), WSP(bf16_t, WS_W2), DFF, NLAT / 256, D / 256, nullptr, 0, nullptr, 0, 0, 1, DFF, 1 << 30, -1};
    pg8::EpiResid<false> E{nullptr, WSP(bf16_t, WS_XB), WSP(float, WS_MOD) + 5120};
    pg8::gemm_phase((LAS unsigned char*)c.lds, g, E, c.tid, c.wave);
    {
        pg8::Gemm gc{WSP(bf16_t, WS_P), WSP(bf16_t, WS_W2), DFF, 2, D / 256, nullptr, NLAT, nullptr, 0, 0, CTX_SPLIT_F, DFF / CTX_SPLIT_F, 1 << 30, -1};
        pg8::EpiPartial Ec{WSP(float, WS_PARTF), D, NCTX};
        pg8::gemm_phase((LAS unsigned char*)c.lds, gc, Ec, c.tid, c.wave);
    }
}
__device__ __forceinline__ void phase_moe1(const Ctx& c) {
    const int nt = WSP(int, WS_TILEE)[NSLOT_TILES];
    pg8::Gemm g{WSP(bf16_t, WS_H), WSP(bf16_t, WS_MOEW13), D, nt, 7168 / 256, WSP(int, WS_SLOTTOK), 0, WSP(int, WS_TILEE), 0, (size_t)7168 * D, 1, D, 1 << 30, -1, 0, WSP(bf16_t, WS_MOEW13E), NE13, MOE1_WGM};
    pg8::EpiSwiGLU E{WSP(bf16_t, WS_ACTP), DFF};
    pg8::gemm_phase((LAS unsigned char*)c.lds, g, E, c.tid, c.wave);
}
__device__ __forceinline__ void phase_moe2(const Ctx& c) {
    const int nt = WSP(int, WS_TILEE)[NSLOT_TILES];
    pg8::Gemm g{WSP(bf16_t, WS_ACTP), (const bf16_t*)c.p->out, DFF, nt, D / 256, nullptr, 0, WSP(int, WS_TILEE), 0, (size_t)D * DFF, 1, DFF, MOE2_MAIN, -1};
    pg8::EpiBf16 E{WSP(bf16_t, WS_YP), D, 0};
    pg8::gemm_phase((LAS unsigned char*)c.lds, g, E, c.tid, c.wave);
    if (nt * 4 > MOE2_MAIN) {
        pg8::Gemm gl{WSP(bf16_t, WS_ACTP), (const bf16_t*)c.p->out, DFF, nt, D / 256, nullptr, 0, WSP(int, WS_TILEE), 0, (size_t)D * DFF, MOE2_SPLIT, DFF / MOE2_SPLIT, 1 << 30, MOE2_MAIN};
        pg8::EpiPartialTile El{WSP(bf16_t, WS_PART2), MOE2_SPLIT};
        pg8::gemm_phase((LAS unsigned char*)c.lds, gl, El, c.tid, c.wave);
    }
}

constexpr int N_PHASES = 20;
__device__ __forceinline__ void run_phase(const Ctx& c, int ph) {
    switch (ph) {
        case 0: phase_prologue(c); break;
        case 1: phase_norm(c, 0, 1); break;
        case 2: phase_inproj(c, 0); break;
        case 3: phase_m1(c, 0); break;
        case 4: phase_m2(c, 0); break;
        case 5: phase_m3(c, 0); break;
        case 6: phase_outproj(c, 0); break;
        case 7: phase_norm(c, 0, 2); break;
        case 8: phase_ffn1(c); break;
        case 9: phase_ffn2(c); break;
        case 10: phase_norm(c, 1, 1); break;
        case 11: phase_inproj(c, 1); break;
        case 12: phase_m1(c, 1); break;
        case 13: phase_m2(c, 1); break;
        case 14: phase_m3(c, 1); break;
        case 15: phase_outproj(c, 1); break;
        case 16: phase_norm(c, 1, 2); late_cvt(c); phase_moe_assign(c); break;
        case 17: phase_moe1(c); break;
        case 18: phase_moe2(c); break;
        case 19: phase_moe_combine(c); break;
        default: break;
    }
}

#define XB_TMO      128
#define XB_XCNT(j)  (256  + 64 * (j))
#define XB_XSUB(j)  (1280 + 64 * (j))
#define XB_XGEN(j)  (2304 + 64 * (j))
#define XB_TOP      3328
#define XB_TOPGEN   3392
#define XCD_BAR_WORDS 3456
#define XB_SPIN_CAP (1u << 18)
__device__ __forceinline__ unsigned xb_ld(unsigned* p)              { return __hip_atomic_load(p, __ATOMIC_RELAXED, __HIP_MEMORY_SCOPE_AGENT); }
__device__ __forceinline__ unsigned xb_add(unsigned* p, unsigned v) { return __hip_atomic_fetch_add(p, v, __ATOMIC_RELAXED, __HIP_MEMORY_SCOPE_AGENT); }
__device__ __forceinline__ unsigned xb_xcc_id() { return (unsigned)__builtin_amdgcn_s_getreg((3 << 11) | 20) & 0xFu; }
#define XB_SPIN(cond, bar) do { unsigned _sp = 0; while (cond) { __builtin_amdgcn_s_sleep(1); \
    if ((++_sp & 255u) == 0u) { if (xb_ld(&(bar)[XB_TMO])) break; if (_sp > XB_SPIN_CAP) { atomicAdd(&(bar)[XB_TMO], 1u); break; } } } } while (0)
struct XcdBarrier { unsigned* bar; unsigned x; volatile LAS unsigned* st; };
__device__ __forceinline__ XcdBarrier xcd_barrier_post(unsigned* bar, volatile LAS unsigned* st) {
    XcdBarrier b; b.bar = bar; b.x = xb_xcc_id(); b.st = st;
    if (threadIdx.x == 0) (void)xb_add(&bar[XB_XCNT(b.x)], 1u);
    return b;
}
__device__ __forceinline__ void xcd_barrier_complete(unsigned* bar, unsigned x, unsigned& nloc, unsigned& nx) {
    const unsigned G = gridDim.x * gridDim.y * gridDim.z;
    unsigned sum, cnt, mine, sp = 0u;
    for (;;) {
        sum = 0u; cnt = 0u; mine = 0u;
#pragma unroll
        for (unsigned j = 0; j < 16; ++j) { const unsigned c = xb_ld(&bar[XB_XCNT(j)]); sum += c; cnt += (c > 0u) ? 1u : 0u; mine = (j == x) ? c : mine; }
        if (sum == G) break;
        __builtin_amdgcn_s_sleep(1);
        if ((++sp & 255u) == 0u) { if (xb_ld(&bar[XB_TMO])) break; if (sp > XB_SPIN_CAP) { atomicAdd(&bar[XB_TMO], 1u); break; } }
    }
    nloc = mine > 0u ? mine : 1u; nx = cnt > 0u ? cnt : 1u;
}
__device__ __forceinline__ void xcd_barrier(const XcdBarrier& b, int wave_id) {
    asm volatile("s_waitcnt vmcnt(0)" ::: "memory");
    __syncthreads();
    if (wave_id == 0 && __builtin_amdgcn_mbcnt_lo(~0u, 0u) == 0u) {
        unsigned* bar = b.bar;
        __builtin_amdgcn_s_waitcnt(0);
        unsigned nloc = b.st[0], nx = b.st[1];
        if (nloc == 0u) { xcd_barrier_complete(bar, b.x, nloc, nx); b.st[0] = nloc; b.st[1] = nx; }
        const unsigned old = xb_add(&bar[XB_XSUB(b.x)], 1u);
        const unsigned gen = old / nloc;
        if (old + 1u == (gen + 1u) * nloc) {
            __builtin_amdgcn_fence(__ATOMIC_RELEASE, "agent");
            asm volatile("s_waitcnt vmcnt(0)" ::: "memory");
            const unsigned og = xb_add(&bar[XB_TOP], 1u);
            const unsigned tg = og / nx;
            if (og + 1u == (tg + 1u) * nx) xb_add(&bar[XB_TOPGEN], 1u);
            else XB_SPIN(xb_ld(&bar[XB_TOPGEN]) == tg, bar);
            __builtin_amdgcn_fence(__ATOMIC_ACQUIRE, "agent");
            xb_add(&bar[XB_XGEN(b.x)], 1u);
            asm volatile("s_waitcnt vmcnt(0)" ::: "memory");
        } else {
            XB_SPIN(xb_ld(&bar[XB_XGEN(b.x)]) == gen, bar);
            __builtin_amdgcn_fence(__ATOMIC_ACQUIRE, "agent");
            asm volatile("s_waitcnt vmcnt(0)" ::: "memory");
        }
    }
    __syncthreads();
}

#ifndef MK_CG_SEAM
#define MK_CG_SEAM 1
#endif
#ifndef MK_MEGA
#define MK_MEGA 1
#endif
__global__ void __launch_bounds__(512, 2) fwd_kernel(Params p) {
    extern __shared__ __attribute__((aligned(16))) unsigned char lds[];
    const int wave_ = __builtin_amdgcn_readfirstlane(threadIdx.x >> 6);
#define MKCTX() Ctx c; c.p = &p; c.lds = lds; c.ws = p.ws; c.wave = wave_; c.bid = blockIdx.x; c.G = gridDim.x; \
    { int ln_ = (int)__builtin_amdgcn_mbcnt_hi(~0u, __builtin_amdgcn_mbcnt_lo(~0u, 0u)); asm volatile("" : "+v"(ln_)); c.lane = ln_; c.tid = wave_ * 64 + ln_; }
#if MK_MEGA
#if MK_CG_SEAM
    cg::grid_group grid = cg::this_grid();
#endif
    volatile LAS unsigned* MISC = (volatile LAS unsigned*)((LAS unsigned char*)lds + LDS_CTLOFF);
    if (threadIdx.x < 64) MISC[threadIdx.x] = 0u;
    __syncthreads();
    const XcdBarrier bar = xcd_barrier_post((unsigned*)(p.ws + WS_CTL) + CW_BAR, MISC + 8);
#if MK_CG_SEAM
    if (p.cg_seams) grid.sync();
#define SEAM() xcd_barrier(bar, wave_)
#else
#define SEAM() xcd_barrier(bar, wave_)
#endif
#ifndef AMP_MASK
#define AMP_MASK 0x0
#endif
#if AMP_MASK
#define PH(k) if (p.ph_lo <= (k) && (k) < p.ph_hi) { MKCTX(); const unsigned long long t0_ = __builtin_amdgcn_s_memrealtime(); run_phase(c, (k)); if ((k) + 1 < p.ph_hi) { SEAM(); } \
        if ((AMP_MASK >> (k)) & 1) { const unsigned long long t1_ = __builtin_amdgcn_s_memrealtime(); while (__builtin_amdgcn_s_memrealtime() < t1_ + (t1_ - t0_)) __builtin_amdgcn_s_sleep(8); } }
#else
#define PH(k) if (p.ph_lo <= (k) && (k) < p.ph_hi) { MKCTX(); run_phase(c, (k)); if ((k) + 1 < p.ph_hi) { SEAM(); } }
#endif
#else
#define PH(k) if (p.ph_lo <= (k) && (k) < p.ph_hi) { MKCTX(); run_phase(c, (k)); }
#endif
#ifdef ONLY_PHASE
    PH(ONLY_PHASE)
#else
    PH(0) PH(1) PH(2) PH(3) PH(4) PH(5) PH(6) PH(7) PH(8) PH(9) PH(10) PH(11) PH(12) PH(13) PH(14) PH(15) PH(16) PH(17) PH(18) PH(19)
#endif
#undef PH
}

extern "C" void kernel_launch(void* const* d_in, const int* in_sizes, int n_in, void* d_out, int out_size, void* d_ws, size_t ws_size, hipStream_t stream) {
    static int grid = 0;
    if (grid == 0) {
        if (n_in != 27 || out_size != NLAT * D || ws_size < WS_END) { fprintf(stderr, "kernel_launch: unexpected sizes (n_in %d, out %d, ws %zu, need %zu)\n", n_in, out_size, ws_size, (size_t)WS_END); grid = -1; return; }
        int dev = 0, cus = 0, per_cu = 0;
        hipGetDevice(&dev); hipDeviceGetAttribute(&cus, hipDeviceAttributeMultiprocessorCount, dev);
        hipFuncSetAttribute((const void*)fwd_kernel, hipFuncAttributeMaxDynamicSharedMemorySize, LDS_BYTES);
        hipOccupancyMaxActiveBlocksPerMultiprocessor(&per_cu, (const void*)fwd_kernel, 512, LDS_BYTES);
        if (per_cu < 1) { fprintf(stderr, "kernel_launch: occupancy query says %d blocks/CU\n", per_cu); per_cu = 1; }
        grid = cus;
        if (grid != 256) { fprintf(stderr, "kernel_launch: built for a 256-CU device (the mixer phases deal their work over exactly 256 workgroups); found %d CUs, nothing launched\n", cus); grid = -1; return; }
        (void)hipGetLastError();
    }
    if (grid < 0) return;
    hipMemsetAsync((char*)d_ws + WS_CTL, 0, CTL_BYTES, stream);
    Params p{};
    for (int i = 0; i < 27; ++i) p.in[i] = (const float*)d_in[i];
    p.out = (float*)d_out; p.ws = (unsigned char*)d_ws;
#if MK_MEGA
    p.ph_lo = 0; p.ph_hi = N_PHASES;
    void* args[] = {&p};
    hipError_t e = hipLaunchCooperativeKernel((const void*)fwd_kernel, dim3(grid), dim3(512), args, LDS_BYTES, stream);
    if (e != hipSuccess) fprintf(stderr, "cooperative launch failed: %s (grid %d)\n", hipGetErrorString(e), grid);
#else
    for (int ph = 0; ph < N_PHASES; ++ph) { p.ph_lo = ph; p.ph_hi = ph + 1; hipLaunchKernelGGL(fwd_kernel, dim3(grid), dim3(512), LDS_BYTES, stream, p); }
#endif
}
```
